# Optimizing an MI355X kernel written in HIP

```python
import math
import jax, jax.numpy as jnp
from jax import lax
import numpy as np

D_MODEL = 4096
BATCH = 8
SEQ = 2048
DEPTH = 2

HEAD_DIM = 128
DIL_WINDOWS = (128, 512, 2048)
DIL_RATES = (1, 4, 16)
N_DIL_GROUPS = 3
DIL_HEADS = D_MODEL // HEAD_DIM // 2
DIL_WIDTH = DIL_HEADS * HEAD_DIM
A_IN_COLS = N_DIL_GROUPS * 3 * DIL_WIDTH
FOX_HEADS = D_MODEL // HEAD_DIM
FOX_WIDTH = FOX_HEADS * HEAD_DIM
B_IN_COLS = 3 * FOX_WIDTH + FOX_HEADS
Q_BLOCK = 128
PEER_HEADS = 8
PEER_NKEYS = 128
PEER_EXPERTS = PEER_NKEYS * PEER_NKEYS
PEER_QDIM = 256
PEER_TOPK = 16
PEER_CHUNK = 128
DN_ALPHA = (2 * DEPTH) ** 0.25
DN_BETA = (8 * DEPTH) ** -0.25
LN_EPS = 1e-5
N_A_LAYERS = (DEPTH + 1) // 2
N_B_LAYERS = DEPTH // 2
NEG = -1e30

kernel_name = "hybrid_dilated_fox_peer_deepnorm"


def alibi_slopes(n_heads):
    return jnp.exp2(-8.0 * (jnp.arange(n_heads, dtype=jnp.float32) + 1.0) / n_heads)


def layer_norm(x, g, b):
    xf = x.astype(jnp.float32)
    mu = jnp.mean(xf, axis=-1, keepdims=True)
    var = jnp.mean(jnp.square(xf - mu), axis=-1, keepdims=True)
    return ((xf - mu) * lax.rsqrt(var + LN_EPS) * g.astype(jnp.float32) + b.astype(jnp.float32)).astype(x.dtype)


def dilated_window_attention(q, k, v, dil, window, slopes):
    B, S, H, Dh = q.shape
    n = window // dil
    L = S // dil
    nb = -(-L // n)
    Lp = nb * n

    def strided(t):
        t = t.reshape(B, L, dil, H, Dh).transpose(0, 2, 3, 1, 4)
        return jnp.pad(t, ((0, 0), (0, 0), (0, 0), (0, Lp - L), (0, 0)))

    def banded(t):
        t = jnp.pad(t, ((0, 0), (0, 0), (0, 0), (n, 0), (0, 0))).reshape(B, dil, H, nb + 1, n, Dh)
        return jnp.concatenate([t[:, :, :, :-1], t[:, :, :, 1:]], axis=4)

    qb = strided(q).reshape(B, dil, H, nb, n, Dh)
    kb = banded(strided(k))
    vb = banded(strided(v))
    logits = jnp.einsum('brhnqc,brhnkc->brhnqk', qb, kb).astype(jnp.float32) / math.sqrt(Dh)
    i = jnp.arange(n)[:, None]
    j = jnp.arange(2 * n)[None, :]
    dist = n + i - j
    blk = jnp.arange(nb)[:, None, None]
    valid = (dist >= 0) & (dist <= n) & (blk * n + j - n >= 0)
    bias = -slopes[:, None, None, None] * (dil * dist).astype(jnp.float32)[None, None]
    logits = jnp.where(valid, logits + bias, NEG)
    mx = jnp.max(logits, axis=-1, keepdims=True)
    p = jnp.exp(logits - mx)
    den = jnp.sum(p, axis=-1, keepdims=True)
    o = jnp.einsum('brhnqk,brhnkc->brhnqc', p, vb.astype(jnp.float32)) / den
    lse = (mx + jnp.log(den))[..., 0]
    o = o.reshape(B, dil, H, Lp, Dh)[:, :, :, :L].transpose(0, 3, 1, 2, 4).reshape(B, S, H, Dh)
    lse = lse.reshape(B, dil, H, Lp)[:, :, :, :L].transpose(0, 3, 1, 2).reshape(B, S, H)
    return o, lse


def dilated_mixer(x, w_in, w_out):
    B, S, _ = x.shape
    proj = (x @ w_in).reshape(B, S, N_DIL_GROUPS, 3, DIL_HEADS, HEAD_DIM)
    slopes = alibi_slopes(DIL_HEADS)
    outs, lses = [], []
    for g in range(N_DIL_GROUPS):
        o, lse = dilated_window_attention(proj[:, :, g, 0], proj[:, :, g, 1], proj[:, :, g, 2],
                                          DIL_RATES[g], DIL_WINDOWS[g], slopes)
        outs.append(o)
        lses.append(lse)
    wgt = jax.nn.softmax(jnp.stack(lses), axis=0)
    o = jnp.einsum('gbsh,gbshc->bshc', wgt, jnp.stack(outs))
    return o.reshape(B, S, DIL_WIDTH).astype(x.dtype) @ w_out


def forgetting_mixer(x, w_in, f_bias, w_out):
    B, S, _ = x.shape
    proj = x @ w_in
    qkv = proj[..., :3 * FOX_WIDTH].reshape(B, S, 3, FOX_HEADS, HEAD_DIM)
    q = qkv[:, :, 0].transpose(0, 2, 1, 3)
    k = qkv[:, :, 1].transpose(0, 2, 1, 3)
    v = qkv[:, :, 2].transpose(0, 2, 1, 3).astype(jnp.float32)
    log_f = jax.nn.log_sigmoid((proj[..., 3 * FOX_WIDTH:] + f_bias).astype(jnp.float32))
    c = jnp.cumsum(log_f, axis=1).transpose(0, 2, 1)
    nb = S // Q_BLOCK
    qb = q.reshape(B, FOX_HEADS, nb, Q_BLOCK, HEAD_DIM).transpose(2, 0, 1, 3, 4)
    cb = c.reshape(B, FOX_HEADS, nb, Q_BLOCK).transpose(2, 0, 1, 3)
    kpos = jnp.arange(S)
    scale = 1.0 / math.sqrt(HEAD_DIM)

    def block(args):
        qi, ci, start = args
        logits = jnp.einsum('bhqc,bhkc->bhqk', qi, k).astype(jnp.float32) * scale
        logits = logits + ci[..., None] - c[:, :, None, :]
        qpos = start + jnp.arange(Q_BLOCK)
        logits = jnp.where(kpos[None, :] <= qpos[:, None], logits, NEG)
        p = jax.nn.softmax(logits, axis=-1)
        return jnp.einsum('bhqk,bhkc->bhqc', p, v)

    o = lax.map(block, (qb, cb, jnp.arange(nb) * Q_BLOCK))
    o = o.transpose(1, 0, 3, 2, 4).reshape(B, S, FOX_WIDTH)
    return o.astype(x.dtype) @ w_out


def peer_ffn(x, w_q, sub_keys, u, v):
    B, S, D = x.shape
    T = B * S
    xt = x.reshape(T, D)
    q = (xt @ w_q).reshape(T, PEER_HEADS, 2, PEER_QDIM // 2)
    s = jnp.einsum('thpc,pnc->thpn', q, sub_keys).astype(jnp.float32)
    sv, si = lax.top_k(s, PEER_TOPK)
    cand = (sv[:, :, 0, :, None] + sv[:, :, 1, None, :]).reshape(T, PEER_HEADS, PEER_TOPK * PEER_TOPK)
    cidx = (si[:, :, 0, :, None] * PEER_NKEYS + si[:, :, 1, None, :]).reshape(T, PEER_HEADS, PEER_TOPK * PEER_TOPK)
    top_s, pos = lax.top_k(cand, PEER_TOPK)
    eidx = jnp.take_along_axis(cidx, pos, axis=-1)
    gate = jax.nn.softmax(top_s, axis=-1)
    nc = T // PEER_CHUNK

    def chunk(args):
        xc, ec, gc = args
        act = jax.nn.gelu(jnp.einsum('cd,chkd->chk', xc, u[ec]).astype(jnp.float32), approximate=False)
        return jnp.einsum('chk,chkd->cd', (gc * act).astype(x.dtype), v[ec])

    out = lax.map(chunk, (xt.reshape(nc, PEER_CHUNK, D),
                          eidx.reshape(nc, PEER_CHUNK, PEER_HEADS, PEER_TOPK),
                          gate.reshape(nc, PEER_CHUNK, PEER_HEADS, PEER_TOPK)))
    return out.reshape(B, S, D)


def setup_inputs(seed: int = 0) -> dict:
    key = jax.random.key(seed)
    ks = jax.random.split(key, 20)
    D = D_MODEL
    nrm = lambda k, shape, scale: jax.random.normal(k, shape, jnp.float32) * scale
    x = nrm(ks[0], (BATCH, SEQ, D), 1.0)
    a_qk = nrm(ks[1], (N_A_LAYERS, D, N_DIL_GROUPS, 2, DIL_WIDTH), D ** -0.5)
    a_v = nrm(ks[2], (N_A_LAYERS, D, N_DIL_GROUPS, 1, DIL_WIDTH), D ** -0.5 * DN_BETA)
    a_w_in = jnp.concatenate([a_qk, a_v], axis=3).reshape(N_A_LAYERS, D, A_IN_COLS)
    a_w_out = nrm(ks[3], (N_A_LAYERS, DIL_WIDTH, D), DIL_WIDTH ** -0.5 * DN_BETA)
    b_qk = nrm(ks[4], (N_B_LAYERS, D, 2 * FOX_WIDTH), D ** -0.5)
    b_v = nrm(ks[5], (N_B_LAYERS, D, FOX_WIDTH), D ** -0.5 * DN_BETA)
    b_fw = nrm(ks[6], (N_B_LAYERS, D, FOX_HEADS), D ** -0.5)
    b_w_in = jnp.concatenate([b_qk, b_v, b_fw], axis=-1)
    b_f_bias = 1.0 + 2.0 * jax.random.uniform(ks[7], (N_B_LAYERS, FOX_HEADS), jnp.float32)
    b_w_out = nrm(ks[8], (N_B_LAYERS, FOX_WIDTH, D), FOX_WIDTH ** -0.5 * DN_BETA)
    peer_w_q = nrm(ks[9], (DEPTH, D, PEER_HEADS * PEER_QDIM), D ** -0.5)
    peer_sub_keys = nrm(ks[10], (DEPTH, 2, PEER_NKEYS, PEER_QDIM // 2), (PEER_QDIM // 2) ** -0.5)
    peer_u = nrm(ks[11], (DEPTH, PEER_EXPERTS, D), D ** -0.5)
    peer_v = nrm(ks[12], (DEPTH, PEER_EXPERTS, D), DN_BETA * PEER_HEADS ** -0.5)
    ln_mix_g = 1.0 + nrm(ks[13], (DEPTH, D), 0.02)
    ln_mix_b = nrm(ks[14], (DEPTH, D), 0.02)
    ln_ffn_g = 1.0 + nrm(ks[15], (DEPTH, D), 0.02)
    ln_ffn_b = nrm(ks[16], (DEPTH, D), 0.02)
    return {"x": x, "a_w_in": a_w_in, "a_w_out": a_w_out, "b_w_in": b_w_in, "b_f_bias": b_f_bias,
            "b_w_out": b_w_out, "peer_w_q": peer_w_q, "peer_sub_keys": peer_sub_keys,
            "peer_u": peer_u, "peer_v": peer_v, "ln_mix_g": ln_mix_g, "ln_mix_b": ln_mix_b,
            "ln_ffn_g": ln_ffn_g, "ln_ffn_b": ln_ffn_b}


def reference(x, a_w_in, a_w_out, b_w_in, b_f_bias, b_w_out, peer_w_q, peer_sub_keys,
              peer_u, peer_v, ln_mix_g, ln_mix_b, ln_ffn_g, ln_ffn_b):
    h = x
    for i in range(DEPTH):
        j = i // 2
        if i % 2 == 0:
            mix = dilated_mixer(h, a_w_in[j], a_w_out[j])
        else:
            mix = forgetting_mixer(h, b_w_in[j], b_f_bias[j], b_w_out[j])
        h = layer_norm(DN_ALPHA * h + mix, ln_mix_g[i], ln_mix_b[i])
        ffn = peer_ffn(h, peer_w_q[i], peer_sub_keys[i], peer_u[i], peer_v[i])
        h = layer_norm(DN_ALPHA * h + ffn, ln_ffn_g[i], ln_ffn_b[i])
    return h
```

```cpp
#include <hip/hip_runtime.h>
#include <cstdio>
#include <cstdint>
#ifndef MK_N_LAUNCHES
#define MK_N_LAUNCHES 16
#endif

#define XB_TMO      128
#define XB_XCNT(j)  (256  + 64 * (j))
#define XB_XSUB(j)  (1280 + 64 * (j))
#define XB_XGEN(j)  (2304 + 64 * (j))
#define XB_TOP      3328
#define XB_TOPGEN   3392
#define XCD_BAR_WORDS 3456
#define XB_SPIN_CAP (1u << 18)
#define LAS __attribute__((address_space(3)))

__device__ __forceinline__ unsigned xb_ld(unsigned* p)              { return __hip_atomic_load(p, __ATOMIC_RELAXED, __HIP_MEMORY_SCOPE_AGENT); }
__device__ __forceinline__ unsigned xb_add(unsigned* p, unsigned v) { return __hip_atomic_fetch_add(p, v, __ATOMIC_RELAXED, __HIP_MEMORY_SCOPE_AGENT); }
__device__ __forceinline__ unsigned xb_xcc_id() { return (unsigned)__builtin_amdgcn_s_getreg((3 << 11) | 20) & 0xFu; }
#define XB_SPIN(cond, bar) do { unsigned _sp = 0; while (cond) { __builtin_amdgcn_s_sleep(1); \
    if ((++_sp & 255u) == 0u) { if (xb_ld(&(bar)[XB_TMO])) break; if (_sp > XB_SPIN_CAP) { atomicAdd(&(bar)[XB_TMO], 1u); break; } } } } while (0)

struct XcdBarrier {
    unsigned* bar; unsigned x;
    volatile LAS unsigned* st;
};

__device__ __forceinline__ XcdBarrier xcd_barrier_post(unsigned* bar, volatile LAS unsigned* st) {
    XcdBarrier b; b.bar = bar; b.x = xb_xcc_id(); b.st = st;
    if (threadIdx.x == 0) (void)xb_add(&bar[XB_XCNT(b.x)], 1u);
    return b;
}
__device__ __forceinline__ void xcd_barrier_complete(unsigned* bar, unsigned x, unsigned& nloc, unsigned& nx) {
    const unsigned G = gridDim.x * gridDim.y * gridDim.z;
    unsigned sum, cnt, mine, sp = 0u;
    for (;;) {
        sum = 0u; cnt = 0u; mine = 0u;
#pragma unroll
        for (unsigned j = 0; j < 16; ++j) { const unsigned c = xb_ld(&bar[XB_XCNT(j)]); sum += c; cnt += (c > 0u) ? 1u : 0u; mine = (j == x) ? c : mine; }
        if (sum == G) break;
        __builtin_amdgcn_s_sleep(1);
        if ((++sp & 255u) == 0u) { if (xb_ld(&bar[XB_TMO])) break; if (sp > XB_SPIN_CAP) { atomicAdd(&bar[XB_TMO], 1u); break; } }
    }
    nloc = mine > 0u ? mine : 1u; nx = cnt > 0u ? cnt : 1u;
}

__device__ __forceinline__ void xcd_barrier(const XcdBarrier& b) {
    asm volatile("s_waitcnt vmcnt(0)" ::: "memory");
    __syncthreads();
    if (threadIdx.x == 0) {
        unsigned* bar = b.bar;
        __builtin_amdgcn_s_waitcnt(0);
        unsigned nloc = b.st[0], nx = b.st[1];
        if (nloc == 0u) { xcd_barrier_complete(bar, b.x, nloc, nx); b.st[0] = nloc; b.st[1] = nx; }
        const unsigned old = xb_add(&bar[XB_XSUB(b.x)], 1u);
        const unsigned gen = old / nloc;
        if (old + 1u == (gen + 1u) * nloc) {
            __builtin_amdgcn_fence(__ATOMIC_RELEASE, "agent");
            asm volatile("s_waitcnt vmcnt(0)" ::: "memory");
            const unsigned og = xb_add(&bar[XB_TOP], 1u);
            const unsigned tg = og / nx;
            if (og + 1u == (tg + 1u) * nx) xb_add(&bar[XB_TOPGEN], 1u);
            else XB_SPIN(xb_ld(&bar[XB_TOPGEN]) == tg, bar);
            __builtin_amdgcn_fence(__ATOMIC_ACQUIRE, "agent");
            xb_add(&bar[XB_XGEN(b.x)], 1u);
            asm volatile("s_waitcnt vmcnt(0)" ::: "memory");
        } else {
            XB_SPIN(xb_ld(&bar[XB_XGEN(b.x)]) == gen, bar);
            __builtin_amdgcn_fence(__ATOMIC_ACQUIRE, "agent");
            asm volatile("s_waitcnt vmcnt(0)" ::: "memory");
        }
    }
    __syncthreads();
}

namespace pg8 {
#define PG8_LAS __attribute__((address_space(3)))
typedef unsigned short bf16_t;
typedef short bf16x8 __attribute__((ext_vector_type(8)));
typedef float f32x4 __attribute__((ext_vector_type(4)));
typedef unsigned u32x4 __attribute__((ext_vector_type(4)));
constexpr int BM = 256, BK = 64, HALF = 128, HTB = HALF * BK * 2  , STAGE_BYTES = 8 * HTB, NXCD = 8, WGM = 8;

__host__ __device__ __forceinline__ int lds_byte(int r, int c) { const int st = (r >> 4) * 2 + (c >> 5), rr = r & 15, cc = c & 31, ob = rr * 64 + cc * 2; return st * 1024 + (ob ^ (((ob >> 9) & 1) << 5)); }
__host__ __device__ __forceinline__ void stage_rc(int b, int& R, int& C) { const int st = b / 1024, sb = b % 1024, swz = sb ^ (((sb >> 9) & 1) << 5); R = (st >> 1) * 16 + swz / 64; C = (st & 1) * 32 + (swz % 64) / 2; }
__host__ __device__ __forceinline__ int perm32(int rho) { const int n = rho >> 4, i = rho & 15; return 8 * (i >> 2) + 4 * n + (i & 3); }

struct Unit { int pm, pn; };
struct Gemm { const bf16_t* A; const bf16_t* Bt; int M, N, K; };

struct StaticOrder {
    int nM, nN, nwg, G, c;
    __host__ __device__ void init(int M, int N, int G_, int c_) { nM = M / BM; nN = N / BM; nwg = nM * nN; G = G_; c = c_; }
    __host__ __device__ bool next(int i, Unit& u) const {
        const long L = (long)i * G + c; if (L >= nwg) return false;
        int wgid = (int)L; { const int q = nwg / NXCD, r = nwg % NXCD, xcd = wgid % NXCD, off = wgid / NXCD; wgid = (xcd < r ? xcd * (q + 1) : r * (q + 1) + (xcd - r) * q) + off; }
        const int nig = WGM * nN, gid = wgid / nig, fm = gid * WGM, gsz = (nM - fm) < WGM ? (nM - fm) : WGM;
        u.pm = fm + ((wgid % nig) % gsz); u.pn = (wgid % nig) / gsz; return true;
    }
    __device__ __forceinline__ void a_ready(const Unit&) const {}
    __device__ __forceinline__ void done(const Unit&) const {}
};
struct CountedOrder : StaticOrder {
    const unsigned* ready; unsigned need; unsigned* tmo;
    __device__ __forceinline__ void a_ready(const Unit& u) const {
        if (threadIdx.x < 64) {
            const unsigned long long t0 = __builtin_amdgcn_s_memrealtime(); unsigned polls = 0;
            while ((unsigned)__builtin_amdgcn_readfirstlane(__hip_atomic_load(ready + 64 * u.pm, __ATOMIC_RELAXED, __HIP_MEMORY_SCOPE_AGENT)) < need) {
                if ((++polls & 255u) == 0u && __builtin_amdgcn_readfirstlane(__hip_atomic_load(tmo, __ATOMIC_RELAXED, __HIP_MEMORY_SCOPE_AGENT)) != 0u) break;
                if (__builtin_amdgcn_s_memrealtime() - t0 > 2000000ull) {
                    if (threadIdx.x == 0) { unsigned expect = 0u; __hip_atomic_compare_exchange_strong(tmo + 1, &expect, 0x600u | (unsigned)(u.pm & 0xff), __ATOMIC_RELAXED, __ATOMIC_RELAXED, __HIP_MEMORY_SCOPE_AGENT); __hip_atomic_store(tmo, 1u, __ATOMIC_RELAXED, __HIP_MEMORY_SCOPE_AGENT); }
                    break; }
                __builtin_amdgcn_s_sleep(2); }
            __builtin_amdgcn_fence(__ATOMIC_ACQUIRE, "agent");
            asm volatile("s_waitcnt vmcnt(0)" ::: "memory");
        }
#if !defined(BROKEN_HOOK_NO_BARRIER)
        asm volatile("" ::: "memory"); __builtin_amdgcn_s_barrier(); asm volatile("" ::: "memory");
#endif
    }
};

__device__ __forceinline__ unsigned cvt_pk_bf16(float lo, float hi) { unsigned r; asm volatile("v_cvt_pk_bf16_f32 %0, %1, %2" : "=v"(r) : "v"(lo), "v"(hi)); return r; }
typedef float f32x2 __attribute__((ext_vector_type(2)));
__device__ __forceinline__ f32x2 gelu_pk(f32x2 v) {
    const f32x2 av = __builtin_elementwise_abs(v), d = av * 0.2316418882f + 1.0f;
    f32x2 t; t.x = __builtin_amdgcn_rcpf(d.x); t.y = __builtin_amdgcn_rcpf(d.y);
    f32x2 q = t * 0.5307027145f + (-0.7265760135f); q = q * t + 0.7107068705f; q = q * t + (-0.142248368f); q = q * t + 0.127414796f; q = q * t;
    const f32x2 s = (v * v) * (-0.72134752044f);
    f32x2 e; e.x = __builtin_amdgcn_exp2f(s.x); e.y = __builtin_amdgcn_exp2f(s.y);
    const f32x2 m = v * (q * e), r = v - m;
    f32x2 o; o.x = v.x < 0.f ? m.x : r.x; o.y = v.y < 0.f ? m.y : r.y; return o;
}

struct EpiF32 {
    static constexpr bool PERM = false, AFTER_DRAIN = false;
    float* C; int ldc; const float* bias;
    __device__ __forceinline__ void operator()(const f32x4 (&acc)[2][2][4][2], const Unit& u, int wr, int wc, int fr, int fq) const {
        const int row0 = u.pm * BM + wr * 64 + fr, col0 = u.pn * BM + wc * 32 + 4 * fq;
        f32x4 bv[2][2];
#pragma unroll
        for (int bj = 0; bj < 2; ++bj)
#pragma unroll
            for (int n = 0; n < 2; ++n) bv[bj][n] = bias ? *(const f32x4*)(bias + col0 + bj * HALF + n * 16) : (f32x4){0.f, 0.f, 0.f, 0.f};
#pragma unroll
        for (int ai = 0; ai < 2; ++ai)
#pragma unroll
            for (int m = 0; m < 4; ++m) { float* rowp = C + (size_t)(row0 + ai * HALF + m * 16) * ldc + col0;
#pragma unroll
                for (int bj = 0; bj < 2; ++bj)
#pragma unroll
                    for (int n = 0; n < 2; ++n) *(f32x4*)(rowp + bj * HALF + n * 16) = acc[ai][bj][m][n] + bv[bj][n]; }
    }
};
template <int ACT  > struct EpiBf16 {
    static constexpr bool PERM = true, AFTER_DRAIN = false;
    bf16_t* O; int ldc; const float* bias; int split_cols; size_t split_stride;
    __device__ __forceinline__ void operator()(const f32x4 (&acc)[2][2][4][2], const Unit& u, int wr, int wc, int fr, int fq) const {
        const int row0 = u.pm * BM + wr * 64 + fr; int colt = u.pn * BM; bf16_t* base = O;
        if (split_cols) { const int t = colt / split_cols; base += (size_t)t * split_stride; colt -= t * split_cols; }
        const int col0 = colt + wc * 32 + 8 * fq, bcol0 = u.pn * BM + wc * 32 + 8 * fq;
        f32x4 bv[2][2];
#pragma unroll
        for (int bj = 0; bj < 2; ++bj)
#pragma unroll
            for (int n = 0; n < 2; ++n) bv[bj][n] = bias ? *(const f32x4*)(bias + bcol0 + bj * HALF + 4 * n) : (f32x4){0.f, 0.f, 0.f, 0.f};
#pragma unroll
        for (int ai = 0; ai < 2; ++ai)
#pragma unroll
            for (int m = 0; m < 4; ++m) { bf16_t* rowp = base + (size_t)(row0 + ai * HALF + m * 16) * ldc + col0;
#pragma unroll
                for (int bj = 0; bj < 2; ++bj) { f32x4 v0 = acc[ai][bj][m][0] + bv[bj][0], v1 = acc[ai][bj][m][1] + bv[bj][1];
                    if (ACT == 1) { f32x2 a = gelu_pk((f32x2){v0[0], v0[1]}), b = gelu_pk((f32x2){v0[2], v0[3]}), c = gelu_pk((f32x2){v1[0], v1[1]}), d = gelu_pk((f32x2){v1[2], v1[3]});
                        v0 = (f32x4){a.x, a.y, b.x, b.y}; v1 = (f32x4){c.x, c.y, d.x, d.y}; }
                    if (ACT == 2) {
#pragma unroll
                        for (int j = 0; j < 4; ++j) { v0[j] = 0.5f * v0[j] * (1.0f + erff(v0[j] * 0.70710678f)); v1[j] = 0.5f * v1[j] * (1.0f + erff(v1[j] * 0.70710678f)); } }
                    u32x4 w; w.x = cvt_pk_bf16(v0[0], v0[1]); w.y = cvt_pk_bf16(v0[2], v0[3]); w.z = cvt_pk_bf16(v1[0], v1[1]); w.w = cvt_pk_bf16(v1[2], v1[3]);
                    *(u32x4*)(rowp + bj * HALF) = w; } }
    }
};

struct PanelStats {
    unsigned* xbuf;
    unsigned* cnt;
    unsigned* tmo;
    int ntn; float eps;
    unsigned code;
    __device__ __forceinline__ bool run(const f32x4 (&v)[2][2][4][2], const Unit& u, int wr, int wc, int fr, int fq, PG8_LAS unsigned char* lds, int wid, int lane) const {
        typedef float f32x2v __attribute__((ext_vector_type(2)));
        PG8_LAS f32x2v* P = (PG8_LAS f32x2v*)lds;
        PG8_LAS f32x2v* S = (PG8_LAS f32x2v*)(lds + 8192);
        PG8_LAS unsigned* flag = (PG8_LAS unsigned*)(lds + 8192 + 2048);
#pragma unroll
        for (int ai = 0; ai < 2; ++ai)
#pragma unroll
            for (int m = 0; m < 4; ++m) {
                float s = 0.f;
#pragma unroll
                for (int bj = 0; bj < 2; ++bj)
#pragma unroll
                    for (int n = 0; n < 2; ++n) { const f32x4 x = v[ai][bj][m][n]; s += (x[0] + x[1]) + (x[2] + x[3]); }
                s += __shfl_xor(s, 16); s += __shfl_xor(s, 32);
                const float mw = s * (1.0f / 64.0f); float q = 0.f;
#pragma unroll
                for (int bj = 0; bj < 2; ++bj)
#pragma unroll
                    for (int n = 0; n < 2; ++n) { const f32x4 d = v[ai][bj][m][n] - mw; q += (d[0] * d[0] + d[1] * d[1]) + (d[2] * d[2] + d[3] * d[3]); }
                q += __shfl_xor(q, 16); q += __shfl_xor(q, 32);
                if (fq == 0) P[(ai * HALF + wr * 64 + m * 16 + fr) * 4 + wc] = (f32x2v){mw, q};
            }
        asm volatile("s_waitcnt lgkmcnt(0)" ::: "memory"); __builtin_amdgcn_s_barrier(); asm volatile("" ::: "memory");
#if defined(BROKEN_NO_WAIT)
        if (blockIdx.x >= 64) { const long long t0 = clock64(); while (clock64() - t0 < 60000) __builtin_amdgcn_s_sleep(8); }
#endif
        const int row = wid * 32 + (lane & 31);
        if (lane < 32) {
            const f32x2v a = P[row * 4 + 0], b = P[row * 4 + 1], c = P[row * 4 + 2], d = P[row * 4 + 3];
            const float mt = (a.x + b.x + c.x + d.x) * 0.25f;
            const float da = a.x - mt, db = b.x - mt, dc = c.x - mt, dd = d.x - mt;
            const float m2 = (a.y + b.y) + (c.y + d.y) + 64.0f * ((da * da + db * db) + (dc * dc + dd * dd));
            unsigned long long* slot = (unsigned long long*)xbuf + ((size_t)(u.pm * BM + row) * 4 + u.pn);
            __hip_atomic_store(slot, ((unsigned long long)__float_as_uint(m2) << 32) | __float_as_uint(mt), __ATOMIC_RELAXED, __HIP_MEMORY_SCOPE_AGENT);
        }
        asm volatile("s_waitcnt vmcnt(0)" ::: "memory");
        if (lane == 0) __hip_atomic_fetch_add(cnt + 64 * u.pm, 1u, __ATOMIC_RELAXED, __HIP_MEMORY_SCOPE_AGENT);
        if (wid == 0) {
            bool dead = false; const unsigned long long t0 = __builtin_amdgcn_s_memrealtime(); const unsigned want = 8u * (unsigned)ntn;
            for (;;) {
#if defined(BROKEN_NO_WAIT)
                break;
#endif
                if ((unsigned)__builtin_amdgcn_readfirstlane(__hip_atomic_load(cnt + 64 * u.pm, __ATOMIC_RELAXED, __HIP_MEMORY_SCOPE_AGENT)) >= want) break;
                if (__builtin_amdgcn_s_memrealtime() - t0 > 2000000ull) {
                    if (lane == 0) { unsigned expect = 0u; __hip_atomic_compare_exchange_strong(tmo + 1, &expect, code | (unsigned)(u.pm & 0xff), __ATOMIC_RELAXED, __ATOMIC_RELAXED, __HIP_MEMORY_SCOPE_AGENT);
                                     __hip_atomic_store(tmo, 1u, __ATOMIC_RELAXED, __HIP_MEMORY_SCOPE_AGENT); }
                    dead = true; break; }
                __builtin_amdgcn_s_sleep(2);
            }
            __builtin_amdgcn_fence(__ATOMIC_ACQUIRE, "agent");
            if (lane == 0) flag[0] = dead ? 1u : 0u;
        }
        asm volatile("s_waitcnt vmcnt(0) lgkmcnt(0)" ::: "memory"); __builtin_amdgcn_s_barrier(); asm volatile("" ::: "memory");
        const bool bad = flag[0] != 0u;
        if (lane < 32) {
            const unsigned long long* slot = (const unsigned long long*)xbuf + (size_t)(u.pm * BM + row) * 4; float mt[4], m2[4]; float ms = 0.f;
#pragma unroll
            for (int t = 0; t < 4; ++t) { if (t < ntn) { const unsigned long long w = __hip_atomic_load(slot + t, __ATOMIC_RELAXED, __HIP_MEMORY_SCOPE_AGENT); mt[t] = __uint_as_float((unsigned)w); m2[t] = __uint_as_float((unsigned)(w >> 32)); } else { mt[t] = 0.f; m2[t] = 0.f; } ms += mt[t]; }
            const float mean = ms / (float)ntn; float q = 0.f;
#pragma unroll
            for (int t = 0; t < 4; ++t) if (t < ntn) { const float dm = mt[t] - mean; q += m2[t] + 256.0f * dm * dm; }
            S[row] = (f32x2v){mean, 1.0f / sqrtf(q / (256.0f * (float)ntn) + eps)};
        }
        asm volatile("s_waitcnt lgkmcnt(0)" ::: "memory"); __builtin_amdgcn_s_barrier(); asm volatile("" ::: "memory");
        return bad;
    }
};
struct EpiLnRes {
    static constexpr bool PERM = false, AFTER_DRAIN = true;
    const float* base; float* out; int ldc; const float* bias; PanelStats st; unsigned poison;
    __device__ __forceinline__ void refuse(size_t i0, size_t stride, int M, int N) const { const float q = __builtin_nanf(""); for (size_t i = i0; i < (size_t)M * N; i += stride) out[(i / N) * ldc + i % N] = q;
        if (i0 == 0) { unsigned expect = 0u; __hip_atomic_compare_exchange_strong(st.tmo + 1, &expect, 0x7f0u, __ATOMIC_RELAXED, __ATOMIC_RELAXED, __HIP_MEMORY_SCOPE_AGENT); __hip_atomic_store(st.tmo, 1u, __ATOMIC_RELAXED, __HIP_MEMORY_SCOPE_AGENT); } }
    __device__ __forceinline__ void fused(f32x4 (&acc)[2][2][4][2], const Unit& u, int wr, int wc, int fr, int fq, PG8_LAS unsigned char* lds, int wid, int lane) const {
        typedef float f32x2v __attribute__((ext_vector_type(2)));
        const PG8_LAS f32x2v* S = (const PG8_LAS f32x2v*)(lds + 8192);
        const int col0 = u.pn * BM + wc * 32 + 4 * fq;
#pragma unroll
        for (int bj = 0; bj < 2; ++bj)
#pragma unroll
            for (int n = 0; n < 2; ++n) { const f32x4 bv = bias ? *(const f32x4*)(bias + col0 + bj * HALF + n * 16) : (f32x4){0.f, 0.f, 0.f, 0.f};
#pragma unroll
                for (int ai = 0; ai < 2; ++ai)
#pragma unroll
                    for (int m = 0; m < 4; ++m) acc[ai][bj][m][n] += bv; }
        const bool bad = st.run(acc, u, wr, wc, fr, fq, lds, wid, lane) || poison != 0u;
        const float qnan = __builtin_nanf("");
#pragma unroll
        for (int ai = 0; ai < 2; ++ai)
#pragma unroll
            for (int m = 0; m < 4; ++m) { const int r = ai * HALF + wr * 64 + m * 16 + fr; const f32x2v sr = S[r]; const size_t off = (size_t)(u.pm * BM + r) * ldc + col0;
#pragma unroll
                for (int bj = 0; bj < 2; ++bj)
#pragma unroll
                    for (int n = 0; n < 2; ++n) { const f32x4 bs = *(const f32x4*)(base + off + bj * HALF + n * 16); f32x4 o = bs + (acc[ai][bj][m][n] - sr.x) * sr.y;
                        if (bad) o = (f32x4){qnan, qnan, qnan, qnan}; *(f32x4*)(out + off + bj * HALF + n * 16) = o; }
                asm volatile("" ::: "memory"); }
    }
};
struct EpiLnResLn {
    static constexpr bool PERM = false, AFTER_DRAIN = true;
    const float* base; float* out; bf16_t* xn; int ldc; const float* bias; PanelStats st1, st2; unsigned poison;
    __device__ __forceinline__ void refuse(size_t i0, size_t stride, int M, int N) const { const float q = __builtin_nanf(""); for (size_t i = i0; i < (size_t)M * N; i += stride) { const size_t o = (i / N) * ldc + i % N; out[o] = q; xn[o] = (bf16_t)0x7fc0u; }
        if (i0 == 0) { unsigned expect = 0u; __hip_atomic_compare_exchange_strong(st1.tmo + 1, &expect, 0x7f0u, __ATOMIC_RELAXED, __ATOMIC_RELAXED, __HIP_MEMORY_SCOPE_AGENT); __hip_atomic_store(st1.tmo, 1u, __ATOMIC_RELAXED, __HIP_MEMORY_SCOPE_AGENT); } }
    __device__ __forceinline__ void fused(f32x4 (&acc)[2][2][4][2], const Unit& u, int wr, int wc, int fr, int fq, PG8_LAS unsigned char* lds, int wid, int lane) const {
        typedef float f32x2v __attribute__((ext_vector_type(2))); typedef unsigned u32x2v __attribute__((ext_vector_type(2)));
        const PG8_LAS f32x2v* S = (const PG8_LAS f32x2v*)(lds + 8192);
        const int col0 = u.pn * BM + wc * 32 + 4 * fq;
#pragma unroll
        for (int bj = 0; bj < 2; ++bj)
#pragma unroll
            for (int n = 0; n < 2; ++n) { const f32x4 bv = bias ? *(const f32x4*)(bias + col0 + bj * HALF + n * 16) : (f32x4){0.f, 0.f, 0.f, 0.f};
#pragma unroll
                for (int ai = 0; ai < 2; ++ai)
#pragma unroll
                    for (int m = 0; m < 4; ++m) acc[ai][bj][m][n] += bv; }
        bool bad = st1.run(acc, u, wr, wc, fr, fq, lds, wid, lane) || poison != 0u;
        const float qnan = __builtin_nanf("");
#pragma unroll
        for (int ai = 0; ai < 2; ++ai)
#pragma unroll
            for (int m = 0; m < 4; ++m) { const int r = ai * HALF + wr * 64 + m * 16 + fr; const f32x2v sr = S[r]; const size_t off = (size_t)(u.pm * BM + r) * ldc + col0;
#pragma unroll
                for (int bj = 0; bj < 2; ++bj)
#pragma unroll
                    for (int n = 0; n < 2; ++n) { const f32x4 bs = *(const f32x4*)(base + off + bj * HALF + n * 16); acc[ai][bj][m][n] = bs + (acc[ai][bj][m][n] - sr.x) * sr.y; }
                asm volatile("" : "+v"(acc[ai][0][m][0]), "+v"(acc[ai][0][m][1]), "+v"(acc[ai][1][m][0]), "+v"(acc[ai][1][m][1]));
                if (m & 1) asm volatile("" ::: "memory"); }
        const bool bad1 = bad;
        bad = st2.run(acc, u, wr, wc, fr, fq, lds, wid, lane) || bad;
#pragma unroll
        for (int ai = 0; ai < 2; ++ai)
#pragma unroll
            for (int m = 0; m < 4; ++m) { const int r = ai * HALF + wr * 64 + m * 16 + fr; const f32x2v sr = S[r]; const size_t off = (size_t)(u.pm * BM + r) * ldc + col0;
#pragma unroll
                for (int bj = 0; bj < 2; ++bj)
#pragma unroll
                    for (int n = 0; n < 2; ++n) { const f32x4 x1 = acc[ai][bj][m][n]; *(f32x4*)(out + off + bj * HALF + n * 16) = bad1 ? (f32x4){qnan, qnan, qnan, qnan} : x1;
                        const f32x4 o = (x1 - sr.x) * sr.y; u32x2v w; w.x = cvt_pk_bf16(o[0], o[1]); w.y = cvt_pk_bf16(o[2], o[3]);
                        if (bad) { w.x = 0x7fc07fc0u; w.y = 0x7fc07fc0u; } *(u32x2v*)(xn + off + bj * HALF + n * 16) = w; }
                asm volatile("" ::: "memory"); }
    }
};

template <class Epi, class Sched, bool STAMP = false>
__device__ __forceinline__ void gemm_phase(PG8_LAS unsigned char* lds, const Gemm g, const Sched& S, const Epi& E, unsigned long long* stamps) {
    const int tid = threadIdx.x, wid = __builtin_amdgcn_readfirstlane(tid >> 6), lane = tid & 63, wr = wid >> 2, wc = wid & 3, fr = lane & 15, fq = lane >> 4;
    const int K = g.K, nt = K / BK;
    int ts_lo = 0, ts_hi = 0, nts = 0; const unsigned long long rt_entry = STAMP ? (unsigned long long)wall_clock64() : 0ull;
#define PG8_STAMP() do { if (STAMP && wid == 0 && nts < 64) { const unsigned long long _c = (unsigned long long)clock64(); \
        ts_lo = (lane == nts) ? (int)(unsigned)_c : ts_lo; ts_hi = (lane == nts) ? (int)(unsigned)(_c >> 32) : ts_hi; ++nts; } } while (0)
    PG8_STAMP();
    unsigned voffA[2], voffB[2];
#pragma unroll
    for (int i = 0; i < 2; ++i) { int R, C; stage_rc(tid * 16 + i * 8192, R, C); const int Rb = Epi::PERM ? ((R & ~31) + perm32(R & 31)) : R;
        voffA[i] = (unsigned)(R * K + C) * 2u; voffB[i] = (unsigned)(Rb * K + C) * 2u; }
    const size_t kstep = (size_t)(BK * 2);
    const size_t hstep = (size_t)HALF * K * 2;
    const size_t tstep = 2 * hstep;
    const unsigned ldsw = (unsigned)wid * 1024u;
    const int aoff = lds_byte(wr * 64 + fr, fq * 8), boff = lds_byte(wc * 32 + fr, fq * 8);
#define PG8_SA(b, h) (((b) * 2 + (h)) * HTB)
#define PG8_SB(b, h) ((4 + (b) * 2 + (h)) * HTB)
#define PG8_STAGE(bufoff, gbase, voff) do { _Pragma("unroll") for (int _i = 0; _i < 2; ++_i) \
        __builtin_amdgcn_global_load_lds((const unsigned*)((const char*)(gbase) + (voff)[_i]), (PG8_LAS unsigned*)(lds + (bufoff) + ldsw + _i * 8192), 16, 0, 0); } while (0)
#define PG8_LDA(dst, b, h) do { _Pragma("unroll") for (int m = 0; m < 4; ++m) _Pragma("unroll") for (int k = 0; k < 2; ++k) dst[m][k] = *(const PG8_LAS bf16x8*)(lds + PG8_SA(b, h) + aoff + m * 2048 + k * 1024); } while (0)
#define PG8_LDB(dst, b, h) do { _Pragma("unroll") for (int n = 0; n < 2; ++n) _Pragma("unroll") for (int k = 0; k < 2; ++k) dst[n][k] = *(const PG8_LAS bf16x8*)(lds + PG8_SB(b, h) + boff + n * 2048 + k * 1024); } while (0)
#define PG8_MMA(ai, bj, At, Bt) do { __builtin_amdgcn_s_setprio(1); _Pragma("unroll") for (int m = 0; m < 4; ++m) _Pragma("unroll") for (int n = 0; n < 2; ++n) _Pragma("unroll") for (int k = 0; k < 2; ++k) \
        acc[ai][bj][m][n] = __builtin_amdgcn_mfma_f32_16x16x32_bf16(Bt[n][k], At[m][k], acc[ai][bj][m][n], 0, 0, 0); __builtin_amdgcn_s_setprio(0); } while (0)
#define PG8_WAIT_V(n) asm volatile("s_waitcnt vmcnt(" #n ")" ::: "memory")
#define PG8_WAIT_L(n) asm volatile("s_waitcnt lgkmcnt(" #n ")" ::: "memory")
#define PG8_BAR __builtin_amdgcn_s_barrier()
#define PG8_SCHED __builtin_amdgcn_sched_barrier(0)
    Unit cur, nxt; int ui = 0;
    if (!S.next(0, cur)) return;
    f32x4 acc[2][2][4][2];
#pragma unroll
    for (int a = 0; a < 2; ++a)
#pragma unroll
        for (int b = 0; b < 2; ++b)
#pragma unroll
            for (int m = 0; m < 4; ++m)
#pragma unroll
                for (int n = 0; n < 2; ++n) acc[a][b][m][n] = (f32x4){0.f, 0.f, 0.f, 0.f};
    bf16x8 At[4][2], B0[2][2], B1[2][2];
    const char* cA = (const char*)g.A + (size_t)cur.pm * tstep; const char* cB = (const char*)g.Bt + (size_t)cur.pn * tstep;
    S.a_ready(cur);
    PG8_STAGE(PG8_SB(0, 0), cB, voffB); PG8_STAGE(PG8_SA(0, 0), cA, voffA); PG8_STAGE(PG8_SB(0, 1), cB + hstep, voffB); PG8_STAGE(PG8_SA(0, 1), cA + hstep, voffA);
    if (wr == 1) PG8_BAR;
    PG8_WAIT_V(4); PG8_BAR;
    PG8_STAGE(PG8_SB(1, 0), cB + kstep, voffB); PG8_STAGE(PG8_SA(1, 0), cA + kstep, voffA); PG8_STAGE(PG8_SB(1, 1), cB + hstep + kstep, voffB);
    PG8_WAIT_V(6); PG8_BAR;
    PG8_STAMP();
    for (;;) {
        const bool has_next = S.next(ui + 1, nxt);
        const char* nA = has_next ? (const char*)g.A + (size_t)nxt.pm * tstep : cA; const char* nB = has_next ? (const char*)g.Bt + (size_t)nxt.pn * tstep : cB;
        for (int t = 0; t < nt; t += 2) {
            const bool last = (t == nt - 2);
            const char* a1 = cA + (size_t)(t + 1) * kstep;
            const char* a2 = last ? nA : cA + (size_t)(t + 2) * kstep; const char* b2 = last ? nB : cB + (size_t)(t + 2) * kstep;
            const char* a3 = a2 + kstep; const char* b3 = b2 + kstep;
            if (last && has_next) S.a_ready(nxt);
            PG8_LDB(B0, 0, 0); PG8_SCHED; PG8_LDA(At, 0, 0); PG8_STAGE(PG8_SA(1, 1), a1 + hstep, voffA);
            PG8_WAIT_L(8); PG8_BAR; PG8_WAIT_L(0); PG8_MMA(0, 0, At, B0); PG8_BAR; PG8_SCHED;
            PG8_LDB(B1, 0, 1); PG8_STAGE(PG8_SB(0, 0), b2, voffB);
            PG8_BAR; PG8_WAIT_L(0); PG8_MMA(0, 1, At, B1); PG8_BAR;
            PG8_LDA(At, 0, 1); PG8_STAGE(PG8_SA(0, 0), a2, voffA);
            PG8_BAR; PG8_WAIT_L(0); PG8_MMA(1, 0, At, B0); PG8_BAR; PG8_SCHED;
            PG8_STAGE(PG8_SB(0, 1), b2 + hstep, voffB);
            PG8_WAIT_V(6); PG8_BAR; PG8_MMA(1, 1, At, B1); PG8_BAR;
            PG8_LDB(B0, 1, 0); PG8_SCHED; PG8_LDA(At, 1, 0); PG8_STAGE(PG8_SA(0, 1), a2 + hstep, voffA);
            PG8_WAIT_L(8); PG8_BAR; PG8_WAIT_L(0); PG8_MMA(0, 0, At, B0); PG8_BAR; PG8_SCHED;
            PG8_LDB(B1, 1, 1); PG8_STAGE(PG8_SB(1, 0), b3, voffB);
            PG8_BAR; PG8_WAIT_L(0); PG8_MMA(0, 1, At, B1); PG8_BAR;
            PG8_LDA(At, 1, 1); PG8_STAGE(PG8_SA(1, 0), a3, voffA);
            PG8_BAR; PG8_WAIT_L(0); PG8_MMA(1, 0, At, B0); PG8_BAR; PG8_SCHED;
            PG8_STAGE(PG8_SB(1, 1), b3 + hstep, voffB);
            PG8_WAIT_V(6); PG8_BAR; PG8_MMA(1, 1, At, B1); PG8_BAR;
        }
        PG8_STAMP();
        if constexpr (!Epi::AFTER_DRAIN) { E(acc, cur, wr, wc, fr, fq); S.done(cur); }
        PG8_STAMP();
        if (!has_next) break;
#pragma unroll
        for (int a = 0; a < 2; ++a)
#pragma unroll
            for (int b = 0; b < 2; ++b)
#pragma unroll
                for (int m = 0; m < 4; ++m)
#pragma unroll
                    for (int n = 0; n < 2; ++n) acc[a][b][m][n] = (f32x4){0.f, 0.f, 0.f, 0.f};
        cur = nxt; cA = nA; cB = nB; ++ui;
    }
    PG8_WAIT_V(0);
    if (wr == 0) PG8_BAR;
    PG8_BAR;
    if constexpr (Epi::AFTER_DRAIN) { E.fused(acc, cur, wr, wc, fr, fq, lds, wid, lane); S.done(cur); }
    PG8_STAMP();
    if (STAMP && wid == 0) { stamps[lane] = lane < nts ? (((unsigned long long)(unsigned)ts_hi << 32) | (unsigned)ts_lo) : 0ull;
        if (lane == 62) stamps[62] = rt_entry; if (lane == 63) stamps[63] = (unsigned long long)wall_clock64(); }
#undef PG8_STAMP
#undef PG8_SA
#undef PG8_SB
#undef PG8_STAGE
#undef PG8_LDA
#undef PG8_LDB
#undef PG8_MMA
#undef PG8_WAIT_V
#undef PG8_WAIT_L
#undef PG8_BAR
#undef PG8_SCHED
}
}

namespace mk {
using pg8::bf16_t; using pg8::bf16x8; using pg8::f32x4; using pg8::u32x4;
typedef float f32x16 __attribute__((ext_vector_type(16)));
typedef unsigned u32x2 __attribute__((ext_vector_type(2)));
typedef __bf16 bf16x2 __attribute__((ext_vector_type(2)));

constexpr int T = 16384, DM = 4096, SEQ = 2048, NBATCH = 8;
constexpr int A_COLS = 18432, B_COLS = 12320, B_COLS_PAD = 12544, FOXW = 12288;
constexpr float DN_ALPHA = 1.4142135623730951f;
constexpr float LN_EPS = 1e-5f;
constexpr float LOG2E = 1.4426950408889634f, LN2 = 0.6931471805599453f;
constexpr float QSCALE2 = 0.08838834764831845f * 1.4426950408889634f;

constexpr size_t MB = (size_t)1 << 20;
constexpr size_t WS_CTL = 0;
constexpr size_t WS_WIN = 1 * MB;
constexpr size_t WS_WOUT = WS_WIN + 144 * MB;
constexpr size_t WS_WQ = WS_WOUT + 32 * MB;
constexpr size_t WS_U = WS_WQ + 16 * MB;
constexpr size_t WS_V = WS_U + 128 * MB;
constexpr size_t WS_HF = WS_V + 128 * MB;
constexpr size_t WS_HB = WS_HF + 256 * MB;
constexpr size_t WS_QKV = WS_HB + 128 * MB;
constexpr size_t WS_OG = WS_QKV + 576 * MB;
constexpr size_t WS_LSE = WS_OG + 192 * MB;
constexpr size_t WS_FG = WS_LSE + 3 * MB;
constexpr size_t WS_C2 = WS_FG + 2 * MB;
constexpr size_t WS_END = WS_C2 + 2 * MB;
constexpr size_t WS_A2 = WS_QKV;
constexpr size_t WS_QP = WS_QKV + 128 * MB;
constexpr int BAR_REGION_WORDS = 4096;
constexpr int MAX_LAUNCHES = 32;

constexpr int NTHREADS = 512;
constexpr int LDS_BYTES = 147456;
constexpr int LDS_BARW = LDS_BYTES - 16;

struct Ctx { LAS unsigned char* lds; int tid, lane, wave, G, bid; };

__device__ __forceinline__ unsigned pk2(float lo, float hi) { unsigned r; asm("v_cvt_pk_bf16_f32 %0, %1, %2" : "=v"(r) : "v"(lo), "v"(hi)); return r; }
__device__ __forceinline__ float bf_lo(unsigned w) { return __uint_as_float(w << 16); }
__device__ __forceinline__ float bf_hi(unsigned w) { return __uint_as_float(w & 0xffff0000u); }
template <int CTRL> __device__ __forceinline__ float dppf(float x) { return __builtin_bit_cast(float, __builtin_amdgcn_mov_dpp(__builtin_bit_cast(int, x), CTRL, 0xf, 0xf, true)); }
__device__ __forceinline__ float wave_sum(float x) {
    x += dppf<0xB1>(x); x += dppf<0x4E>(x); x += dppf<0x141>(x); x += dppf<0x128>(x);
    auto s = __builtin_amdgcn_permlane16_swap(__float_as_uint(x), __float_as_uint(x), false, false);
    x = __uint_as_float(s[0]) + __uint_as_float(s[1]);
    auto t = __builtin_amdgcn_permlane32_swap(__float_as_uint(x), __float_as_uint(x), false, false);
    return __uint_as_float(t[0]) + __uint_as_float(t[1]);
}
__device__ __forceinline__ float pair_max(float x) { auto t = __builtin_amdgcn_permlane32_swap(__float_as_uint(x), __float_as_uint(x), false, false); return fmaxf(__uint_as_float(t[0]), __uint_as_float(t[1])); }
__device__ __forceinline__ float pair_sum(float x) { auto t = __builtin_amdgcn_permlane32_swap(__float_as_uint(x), __float_as_uint(x), false, false); return __uint_as_float(t[0]) + __uint_as_float(t[1]); }
__device__ __forceinline__ int pair_maxi(int x) { auto t = __builtin_amdgcn_permlane32_swap((unsigned)x, (unsigned)x, false, false); const int a = (int)t[0], b = (int)t[1]; return a > b ? a : b; }
__device__ __forceinline__ bf16x8 pack8(float a0, float a1, float a2, float a3, float b0, float b1, float b2, float b3) {
    u32x4 w = {pk2(a0, a1), pk2(a2, a3), pk2(b0, b1), pk2(b2, b3)}; return __builtin_bit_cast(bf16x8, w);
}
__device__ __forceinline__ float dot2(unsigned a, unsigned b, float acc) { return __builtin_amdgcn_fdot2_f32_bf16(__builtin_bit_cast(bf16x2, a), __builtin_bit_cast(bf16x2, b), acc, false); }
#define MK_LDS_WAIT() asm volatile("s_waitcnt lgkmcnt(0)" ::: "memory")

__device__ __forceinline__ void transpose_weights(const Ctx& c, const float* __restrict__ W, int K, int N, bf16_t* __restrict__ WT) {
    LAS float* scr = (LAS float*)(c.lds + c.wave * 8704);
    const int lane = c.lane, nblk = N / 32, nitems = (K / 64) * nblk;
    for (int item = c.bid * 8 + c.wave; item < nitems; item += c.G * 8) {
        const int kb = item / nblk, nb = item - kb * nblk, k0 = 64 * kb, n0 = 32 * nb;
#pragma unroll 8
        for (int i = 0; i < 32; ++i) { const int kk = 2 * i + (lane >> 5); scr[kk * 33 + (lane & 31)] = W[(size_t)(k0 + kk) * N + n0 + (lane & 31)]; }
        MK_LDS_WAIT();
        const int cch = lane & 7;
#pragma unroll
        for (int j = 0; j < 4; ++j) { const int n = (lane >> 3) + 8 * j; const LAS float* s = scr + (8 * cch) * 33 + n;
            u32x4 o; o.x = pk2(s[0 * 33], s[1 * 33]); o.y = pk2(s[2 * 33], s[3 * 33]); o.z = pk2(s[4 * 33], s[5 * 33]); o.w = pk2(s[6 * 33], s[7 * 33]);
            *(u32x4*)(WT + (size_t)(n0 + n) * K + k0 + 8 * cch) = o; }
        MK_LDS_WAIT();
    }
}
__device__ __forceinline__ void convert_flat(const Ctx& c, const float* __restrict__ src, bf16_t* __restrict__ dst, size_t n) {
    const size_t n8 = n / 8, stride = (size_t)c.G * NTHREADS;
    for (size_t i = (size_t)c.bid * NTHREADS + c.tid; i < n8; i += stride) {
        const f32x4 a = *(const f32x4*)(src + i * 8), b = *(const f32x4*)(src + i * 8 + 4);
        u32x4 o = {pk2(a[0], a[1]), pk2(a[2], a[3]), pk2(b[0], b[1]), pk2(b[2], b[3])};
        *(u32x4*)(dst + i * 8) = o;
    }
}
__device__ __forceinline__ void zero_flat16(const Ctx& c, void* dst, size_t bytes) {
    const size_t n = bytes / 16, stride = (size_t)c.G * NTHREADS; const u32x4 z = {0u, 0u, 0u, 0u};
    for (size_t i = (size_t)c.bid * NTHREADS + c.tid; i < n; i += stride) ((u32x4*)dst)[i] = z;
}

__device__ __forceinline__ void ln_phase(const Ctx& c, float* Hf, bf16_t* Hb, const float* __restrict__ g, const float* __restrict__ b) {
    for (int row = c.bid * 8 + c.wave; row < T; row += c.G * 8) {
        float* xr = Hf + (size_t)row * DM + 4 * c.lane;
        f32x4 v[16]; float s = 0.f;
#pragma unroll
        for (int j = 0; j < 16; ++j) { v[j] = *(const f32x4*)(xr + 256 * j); s += (v[j][0] + v[j][1]) + (v[j][2] + v[j][3]); }
        const float mean = wave_sum(s) * (1.f / DM); float q = 0.f;
#pragma unroll
        for (int j = 0; j < 16; ++j) { v[j] = v[j] - mean; q += (v[j][0] * v[j][0] + v[j][1] * v[j][1]) + (v[j][2] * v[j][2] + v[j][3] * v[j][3]); }
        const float rstd = 1.0f / sqrtf(wave_sum(q) * (1.f / DM) + LN_EPS);
        bf16_t* ob = Hb + (size_t)row * DM + 4 * c.lane;
#pragma unroll
        for (int j = 0; j < 16; ++j) { const f32x4 gg = *(const f32x4*)(g + 4 * c.lane + 256 * j), bb = *(const f32x4*)(b + 4 * c.lane + 256 * j);
            const f32x4 o = v[j] * rstd * gg + bb; *(f32x4*)(xr + 256 * j) = o;
            u32x2 w = {pk2(o[0], o[1]), pk2(o[2], o[3])}; *(u32x2*)(ob + 256 * j) = w; }
    }
}

__device__ __forceinline__ void merge_phase(const Ctx& c, const bf16_t* __restrict__ OG, const float* __restrict__ LSE, bf16_t* __restrict__ A2) {
    const size_t n = (size_t)T * 256, stride = (size_t)c.G * NTHREADS;
    for (size_t id = (size_t)c.bid * NTHREADS + c.tid; id < n; id += stride) {
        const size_t tok = id >> 8; const int col = (int)(id & 255) * 8, head = col >> 7;
        const float l0 = LSE[(0 * (size_t)T + tok) * 16 + head], l1 = LSE[(1 * (size_t)T + tok) * 16 + head], l2 = LSE[(2 * (size_t)T + tok) * 16 + head];
        const float mx = fmaxf(l0, fmaxf(l1, l2));
        float e0 = __expf(l0 - mx), e1 = __expf(l1 - mx), e2 = __expf(l2 - mx); const float inv = 1.0f / (e0 + e1 + e2); e0 *= inv; e1 *= inv; e2 *= inv;
        const u32x4 a = *(const u32x4*)(OG + (0 * (size_t)T + tok) * 2048 + col), b = *(const u32x4*)(OG + (1 * (size_t)T + tok) * 2048 + col), d = *(const u32x4*)(OG + (2 * (size_t)T + tok) * 2048 + col);
        u32x4 o;
#pragma unroll
        for (int j = 0; j < 4; ++j) { const float lo = e0 * bf_lo(a[j]) + e1 * bf_lo(b[j]) + e2 * bf_lo(d[j]), hi = e0 * bf_hi(a[j]) + e1 * bf_hi(b[j]) + e2 * bf_hi(d[j]); o[j] = pk2(lo, hi); }
        *(u32x4*)(A2 + tok * 2048 + col) = o;
    }
}

__device__ __forceinline__ void cumsum_phase(const Ctx& c, const float* __restrict__ FG, const float* __restrict__ fbias, float* __restrict__ C2) {
    LAS float* wtot = (LAS float*)c.lds;
    for (int seq = c.bid; seq < NBATCH * 32; seq += c.G) {
        const int b = seq >> 5, hd = seq & 31; const float bias = fbias[hd];
        float p[4]; float run = 0.f;
#pragma unroll
        for (int i = 0; i < 4; ++i) { const float z = FG[((size_t)b * SEQ + 4 * c.tid + i) * 32 + hd] + bias; const float lf = fminf(z, 0.f) - log1pf(__expf(-fabsf(z))); run += lf; p[i] = run; }
        float v = run;
#pragma unroll
        for (int o = 1; o < 64; o <<= 1) { const float nb = __shfl_up(v, o); if (c.lane >= o) v += nb; }
        if (c.lane == 63) wtot[c.wave] = v;
        __syncthreads();
        float woff = 0.f;
        for (int w = 0; w < c.wave; ++w) woff += wtot[w];
        const float excl = woff + v - run;
        f32x4 o = {(excl + p[0]) * LOG2E, (excl + p[1]) * LOG2E, (excl + p[2]) * LOG2E, (excl + p[3]) * LOG2E};
        *(f32x4*)(C2 + (size_t)seq * SEQ + 4 * c.tid) = o;
        __syncthreads();
    }
}

constexpr int KT_PITCH = 272, KT_BYTES = 64 * KT_PITCH;
constexpr int VT_PITCH = 144, VT_BYTES = 128 * VT_PITCH;
constexpr int ABUF_BYTES = KT_BYTES + VT_BYTES;
constexpr int AHALF_BYTES = 2 * ABUF_BYTES + 512;
static_assert(2 * AHALF_BYTES <= LDS_BARW, "attention LDS");

struct AttnHalf { const bf16_t* q; const bf16_t* k; const bf16_t* v; bf16_t* o; float* lse; const float* c2; float sd2; };
struct AttnTile { size_t rstride, ostride, lstride; int q0, kt_lo, kt_hi; unsigned Wn; };

template <int MODE>
__device__ __forceinline__ void attn_tile(const Ctx& c, const AttnHalf& H, const AttnTile& A) {
    int lane = c.lane; asm volatile("" : "+v"(lane));
    const int hw = c.wave & 3, ht = (c.wave & 3) * 64 + lane, h = lane >> 5, cc = lane & 31;
    LAS unsigned char* base = c.lds + (c.wave >> 2) * AHALF_BYTES;
    const int qlo = A.q0 + 32 * hw, qm = qlo + cc;
    bf16x8 qf[8];
    { const bf16_t* qp = H.q + (size_t)qm * A.rstride + 8 * h;
#pragma unroll
      for (int ks = 0; ks < 8; ++ks) qf[ks] = *(const bf16x8*)(qp + 16 * ks); }
    const float rowterm = MODE ? H.c2[qm] : -H.sd2 * (float)qm;
    f32x16 oacc[4];
#pragma unroll
    for (int d = 0; d < 4; ++d)
#pragma unroll
        for (int r = 0; r < 16; ++r) oacc[d][r] = 0.f;
    float m_run = -1e30f, l_run = 0.f;

    u32x4 kst[4], vst[4]; float ctv = 0.f;
    const int s_key = ht >> 4, s_c16 = ht & 15;
    const int v_kq = ht & 15, v_do = ht >> 4;
    const int v_kqs = (v_kq & ~3) | ((v_kq & 1) << 1) | ((v_kq >> 1) & 1);
#define MK_ATT_LOAD(kt) do { const int k0_ = 64 * (kt); \
        _Pragma("unroll") for (int i_ = 0; i_ < 4; ++i_) kst[i_] = *(const u32x4*)(H.k + (size_t)(k0_ + s_key + 16 * i_) * A.rstride + s_c16 * 8); \
        _Pragma("unroll") for (int i_ = 0; i_ < 4; ++i_) vst[i_] = *(const u32x4*)(H.v + (size_t)(k0_ + 4 * v_kq + i_) * A.rstride + v_do * 8); \
        if (ht < 64) ctv = MODE ? -H.c2[k0_ + ht] : H.sd2 * (float)(k0_ + ht); } while (0)
#define MK_ATT_WRITE(b) do { LAS unsigned char* kb_ = base + (b) * ABUF_BYTES; LAS unsigned char* vb_ = kb_ + KT_BYTES; \
        _Pragma("unroll") for (int i_ = 0; i_ < 4; ++i_) *(LAS u32x4*)(kb_ + (s_key + 16 * i_) * KT_PITCH + s_c16 * 16) = kst[i_]; \
        _Pragma("unroll") for (int w_ = 0; w_ < 4; ++w_) { \
            u32x2 e_ = {(vst[0][w_] & 0xffffu) | (vst[1][w_] << 16), (vst[2][w_] & 0xffffu) | (vst[3][w_] << 16)}; \
            u32x2 o_ = {(vst[0][w_] >> 16) | (vst[1][w_] & 0xffff0000u), (vst[2][w_] >> 16) | (vst[3][w_] & 0xffff0000u)}; \
            *(LAS u32x2*)(vb_ + (v_do * 8 + 2 * w_) * VT_PITCH + v_kqs * 8) = e_; \
            *(LAS u32x2*)(vb_ + (v_do * 8 + 2 * w_ + 1) * VT_PITCH + v_kqs * 8) = o_; } \
        if (ht < 64) ((LAS float*)(base + 2 * ABUF_BYTES + (b) * 256))[ht] = ctv; } while (0)

    const int nt = A.kt_hi - A.kt_lo;
    MK_ATT_LOAD(A.kt_lo); MK_ATT_WRITE(0);
    __syncthreads();
    for (int t = 0; t < nt; ++t) {
        const bool more = (t + 1 < nt);
        if (more) MK_ATT_LOAD(A.kt_lo + t + 1);
        const int k0 = 64 * (A.kt_lo + t), qhi = qlo + 31;
        const bool need = (k0 <= qhi) && (MODE || (k0 + 63 + (int)A.Wn >= qlo));
        if (need) {
            const LAS unsigned char* kb = base + (t & 1) * ABUF_BYTES; const LAS unsigned char* vb = kb + KT_BYTES;
            const LAS float* ctp = (const LAS float*)(base + 2 * ABUF_BYTES + (t & 1) * 256) + 4 * h;
            f32x16 s0, s1;
#pragma unroll
            for (int r = 0; r < 16; ++r) { s0[r] = 0.f; s1[r] = 0.f; }
            const LAS unsigned char* ka = kb + cc * KT_PITCH + 16 * h;
#pragma unroll
            for (int ks = 0; ks < 8; ++ks) {
                const bf16x8 a0 = *(const LAS bf16x8*)(ka + 32 * ks), a1 = *(const LAS bf16x8*)(ka + 32 * KT_PITCH + 32 * ks);
                s0 = __builtin_amdgcn_mfma_f32_32x32x16_bf16(a0, qf[ks], s0, 0, 0, 0);
                s1 = __builtin_amdgcn_mfma_f32_32x32x16_bf16(a1, qf[ks], s1, 0, 0, 0);
            }
#pragma unroll
            for (int q4 = 0; q4 < 4; ++q4) { const f32x4 c0 = *(const LAS f32x4*)(ctp + 8 * q4), c1 = *(const LAS f32x4*)(ctp + 32 + 8 * q4);
#pragma unroll
                for (int i = 0; i < 4; ++i) { s0[4 * q4 + i] = fmaf(s0[4 * q4 + i], QSCALE2, rowterm + c0[i]); s1[4 * q4 + i] = fmaf(s1[4 * q4 + i], QSCALE2, rowterm + c1[i]); } }
            const bool full = (k0 + 63 <= qlo) && (MODE || (k0 + (int)A.Wn >= qhi));
            if (!full) { const int dq = qm - k0 - 4 * h; const float NEG = -__builtin_inff();
#pragma unroll
                for (int r = 0; r < 16; ++r) { const int ko = (r & 3) + 8 * (r >> 2);
                    if ((unsigned)(dq - ko) > A.Wn) s0[r] = NEG;
                    if ((unsigned)(dq - ko - 32) > A.Wn) s1[r] = NEG; } }
            float mx = fmaxf(s0[0], s1[0]);
#pragma unroll
            for (int r = 1; r < 16; ++r) mx = fmaxf(mx, fmaxf(s0[r], s1[r]));
            mx = pair_max(mx);
            const float mn = fmaxf(m_run, mx), alpha = __builtin_amdgcn_exp2f(m_run - mn);
            m_run = mn;
            float ps = 0.f;
#pragma unroll
            for (int r = 0; r < 16; ++r) { s0[r] = __builtin_amdgcn_exp2f(s0[r] - mn); s1[r] = __builtin_amdgcn_exp2f(s1[r] - mn); ps += s0[r] + s1[r]; }
            l_run = l_run * alpha + ps;
            if (!__all(alpha == 1.0f)) {
#pragma unroll
                for (int d = 0; d < 4; ++d)
#pragma unroll
                    for (int r = 0; r < 16; ++r) oacc[d][r] *= alpha;
            }
            bf16x8 pb[4];
            pb[0] = pack8(s0[0], s0[1], s0[2], s0[3], s0[4], s0[5], s0[6], s0[7]);
            pb[1] = pack8(s0[8], s0[9], s0[10], s0[11], s0[12], s0[13], s0[14], s0[15]);
            pb[2] = pack8(s1[0], s1[1], s1[2], s1[3], s1[4], s1[5], s1[6], s1[7]);
            pb[3] = pack8(s1[8], s1[9], s1[10], s1[11], s1[12], s1[13], s1[14], s1[15]);
            const LAS unsigned char* va = vb + cc * VT_PITCH + 16 * h;
#pragma unroll
            for (int d = 0; d < 4; ++d)
#pragma unroll
                for (int kk = 0; kk < 4; ++kk) {
                    const bf16x8 a = *(const LAS bf16x8*)(va + d * 32 * VT_PITCH + kk * 32);
                    oacc[d] = __builtin_amdgcn_mfma_f32_32x32x16_bf16(a, pb[kk], oacc[d], 0, 0, 0);
                }
        }
        if (more) MK_ATT_WRITE((t + 1) & 1);
        __syncthreads();
    }
#undef MK_ATT_LOAD
#undef MK_ATT_WRITE
    const float lt = pair_sum(l_run), inv = 1.0f / lt;
    bf16_t* op = H.o + (size_t)qm * A.ostride + 4 * h;
#pragma unroll
    for (int d = 0; d < 4; ++d)
#pragma unroll
        for (int rq = 0; rq < 4; ++rq) {
            u32x2 w = {pk2(oacc[d][4 * rq] * inv, oacc[d][4 * rq + 1] * inv), pk2(oacc[d][4 * rq + 2] * inv, oacc[d][4 * rq + 3] * inv)};
            *(u32x2*)(op + 32 * d + 8 * rq) = w;
        }
    if (MODE == 0 && h == 0) H.lse[(size_t)qm * A.lstride] = (m_run + log2f(lt)) * LN2;
}

__device__ __forceinline__ void dil_attn_phase(const Ctx& c, const bf16_t* QKV, bf16_t* OG, float* LSE) {
    const int hf = c.wave >> 2;
#pragma unroll 1
    for (int it = c.bid; it < NBATCH * 3 * 8 * 16; it += c.G) {
        const int rq = it & 15, hp = (it >> 4) & 7, rest = it >> 7, g = rest % 3, b = rest / 3;
        const int dil = (g == 0) ? 1 : (g == 1 ? 4 : 16), ntile = 16 / dil, r = rq / ntile, qt = rq - r * ntile;
        const int head = 2 * hp + hf;
        const size_t row0 = (size_t)b * SEQ + r;
        AttnHalf H; AttnTile A;
        const bf16_t* base = QKV + row0 * A_COLS + g * 6144 + head * 128;
        H.q = base; H.k = base + 2048; H.v = base + 4096;
        H.o = OG + ((size_t)g * T + row0) * 2048 + head * 128;
        H.lse = LSE + ((size_t)g * T + row0) * 16 + head;
        H.c2 = nullptr;
        H.sd2 = exp2f(-0.5f * (float)(head + 1)) * (float)dil * LOG2E;
        A.rstride = (size_t)dil * A_COLS; A.ostride = (size_t)dil * 2048; A.lstride = (size_t)dil * 16;
        A.q0 = 128 * qt; A.kt_lo = qt ? (2 * qt - 2) : 0; A.kt_hi = 2 * qt + 2; A.Wn = 128u;
        attn_tile<0>(c, H, A);
    }
}
__device__ __forceinline__ void fox_attn_phase(const Ctx& c, const bf16_t* QKV, const float* C2, bf16_t* O) {
    const int hf = c.wave >> 2;
#pragma unroll 1
    for (int it2 = 2 * c.bid; it2 < NBATCH * 16 * 8 * 2; it2 += ((it2 & 1) ? 2 * c.G - 1 : 1)) {
        const int it = it2 >> 1, x0 = it & 7, hp = (it >> 3) & 15, b = it >> 7;
        const int x = (it2 & 1) ? 15 - x0 : x0;
        const int head = 2 * hp + hf;
        const size_t row0 = (size_t)b * SEQ;
        AttnHalf H; AttnTile A;
        const bf16_t* base = QKV + row0 * FOXW + head * 128;
        H.q = base; H.k = base + 4096; H.v = base + 8192;
        H.o = O + row0 * 4096 + head * 128; H.lse = nullptr; H.c2 = C2 + ((size_t)b * 32 + head) * SEQ; H.sd2 = 0.f;
        A.rstride = FOXW; A.ostride = 4096; A.lstride = 0; A.Wn = 0x7fffffffu; A.kt_lo = 0;
        A.q0 = 128 * x; A.kt_hi = 2 * x + 2;
        attn_tile<1>(c, H, A);
    }
}

struct EpiRes {
    static constexpr bool PERM = false, AFTER_DRAIN = false;
    const float* base; float* C; int ldc; float alpha;
    __device__ __forceinline__ void operator()(const f32x4 (&acc)[2][2][4][2], const pg8::Unit& u, int wr, int wc, int fr, int fq) const {
        const int row0 = u.pm * 256 + wr * 64 + fr, col0 = u.pn * 256 + wc * 32 + 4 * fq;
#pragma unroll
        for (int ai = 0; ai < 2; ++ai)
#pragma unroll
            for (int m = 0; m < 4; ++m) { const size_t off = (size_t)(row0 + ai * 128 + m * 16) * ldc + col0;
#pragma unroll
                for (int bj = 0; bj < 2; ++bj)
#pragma unroll
                    for (int n = 0; n < 2; ++n) { const f32x4 bs = *(const f32x4*)(base + off + bj * 128 + n * 16); *(f32x4*)(C + off + bj * 128 + n * 16) = bs * alpha + acc[ai][bj][m][n]; } }
    }
};
struct EpiFox {
    static constexpr bool PERM = true, AFTER_DRAIN = false;
    bf16_t* O; float* FG;
    __device__ __forceinline__ void operator()(const f32x4 (&acc)[2][2][4][2], const pg8::Unit& u, int wr, int wc, int fr, int fq) const {
        const int row0 = u.pm * 256 + wr * 64 + fr;
        if (u.pn < 48) {
            const int col0 = u.pn * 256 + wc * 32 + 8 * fq;
#pragma unroll
            for (int ai = 0; ai < 2; ++ai)
#pragma unroll
                for (int m = 0; m < 4; ++m) { bf16_t* rowp = O + (size_t)(row0 + ai * 128 + m * 16) * FOXW + col0;
#pragma unroll
                    for (int bj = 0; bj < 2; ++bj) { const f32x4 v0 = acc[ai][bj][m][0], v1 = acc[ai][bj][m][1];
                        u32x4 w = {pk2(v0[0], v0[1]), pk2(v0[2], v0[3]), pk2(v1[0], v1[1]), pk2(v1[2], v1[3])};
                        *(u32x4*)(rowp + bj * 128) = w; } }
        } else if (wc == 0) {
#pragma unroll
            for (int ai = 0; ai < 2; ++ai)
#pragma unroll
                for (int m = 0; m < 4; ++m) { float* rowp = FG + (size_t)(row0 + ai * 128 + m * 16) * 32 + 8 * fq;
                    *(f32x4*)(rowp) = acc[ai][0][m][0]; *(f32x4*)(rowp + 4) = acc[ai][0][m][1]; }
        }
    }
};

constexpr int SK_PITCH = 272, SK_BYTES = 2 * 128 * SK_PITCH;
constexpr int SEL_IDX_OFF = SK_BYTES, SEL_GATE_OFF = SEL_IDX_OFF + 32 * 128 * 4, WBUF_OFF = SEL_GATE_OFF + 32 * 128 * 4, PEER_LDS_END = WBUF_OFF + 8 * 128 * 4;
static_assert(PEER_LDS_END <= LDS_BARW, "peer LDS");
struct CandTab { int i[50], j[50]; };
__host__ __device__ constexpr CandTab make_cand() { CandTab t{}; int s = 0; for (int i = 0; i < 16; ++i) for (int j = 0; j < 16; ++j) if ((i + 1) * (j + 1) <= 16) { t.i[s] = i; t.j[s] = j; ++s; } return t; }
__device__ __forceinline__ int f2ord(float f) { const int b = __float_as_int(f); return b ^ ((b >> 31) & 0x7fffffff); }
__device__ __forceinline__ float ord2f(int o) { return __int_as_float(o ^ ((o >> 31) & 0x7fffffff)); }
__device__ __forceinline__ float gelu_exact(float v) { return 0.5f * v * (1.0f + erff(v * 0.70710678118654752f)); }

#define MK_CE(a, b) do { const int hi_ = (a) > (b) ? (a) : (b), lo_ = (a) > (b) ? (b) : (a); (a) = hi_; (b) = lo_; } while (0)
template <int BASE> __device__ __forceinline__ void sort16_desc(int (&v)[64]) {
#pragma unroll
    for (int k = 2; k <= 16; k <<= 1)
#pragma unroll
        for (int j = k >> 1; j > 0; j >>= 1)
#pragma unroll
            for (int i = 0; i < 16; ++i) { const int l = i ^ j; if (l > i) { if ((i & k) == 0) MK_CE(v[BASE + i], v[BASE + l]); else MK_CE(v[BASE + l], v[BASE + i]); } }
}
template <int A, int B> __device__ __forceinline__ void merge_top16(int (&v)[64]) {
#pragma unroll
    for (int i = 0; i < 16; ++i) v[A + i] = v[A + i] > v[B + 15 - i] ? v[A + i] : v[B + 15 - i];
#pragma unroll
    for (int j = 8; j > 0; j >>= 1)
#pragma unroll
        for (int i = 0; i < 16; ++i) { const int l = i ^ j; if (l > i) MK_CE(v[A + i], v[A + l]); }
}
__device__ __forceinline__ void top16_of_64(int (&v)[64]) {
    sort16_desc<0>(v); sort16_desc<16>(v); sort16_desc<32>(v); sort16_desc<48>(v);
    merge_top16<0, 16>(v); merge_top16<32, 48>(v); merge_top16<0, 32>(v);
}
constexpr int LTAB_OFF = WBUF_OFF + 8 * 128 * 4, PEER_LDS_END2 = LTAB_OFF + 8 * 32 * 32;
static_assert(PEER_LDS_END2 <= LDS_BARW, "peer LDS 2");

__device__ __forceinline__ void peer_select(const Ctx& c, const bf16_t* __restrict__ QP, int tok0) {
    int lane = c.lane; asm volatile("" : "+v"(lane));
    const int h = lane >> 5, cc = lane & 31, head = c.wave;
    const bf16_t* qrow = QP + (size_t)(tok0 + cc) * 2048 + head * 256 + 8 * h;
    int L[2][16];
#pragma unroll
    for (int p = 0; p < 2; ++p) {
        bf16x8 qf[8];
#pragma unroll
        for (int ks = 0; ks < 8; ++ks) qf[ks] = *(const bf16x8*)(qrow + p * 128 + 16 * ks);
        f32x16 acc[4];
#pragma unroll
        for (int kb = 0; kb < 4; ++kb)
#pragma unroll
            for (int r = 0; r < 16; ++r) acc[kb][r] = 0.f;
        const LAS unsigned char* ska = c.lds + p * (128 * SK_PITCH) + cc * SK_PITCH + 16 * h;
#pragma unroll
        for (int kb = 0; kb < 4; ++kb)
#pragma unroll
            for (int ks = 0; ks < 8; ++ks) { const bf16x8 a = *(const LAS bf16x8*)(ska + kb * 32 * SK_PITCH + 32 * ks); acc[kb] = __builtin_amdgcn_mfma_f32_32x32x16_bf16(a, qf[ks], acc[kb], 0, 0, 0); }
        int pk[64];
#pragma unroll
        for (int kb = 0; kb < 4; ++kb)
#pragma unroll
            for (int r = 0; r < 16; ++r) { const int n = 32 * kb + (r & 3) + 8 * (r >> 2); pk[16 * kb + r] = (f2ord(acc[kb][r]) & ~127) | (127 - n - 4 * h); }
        top16_of_64(pk);
        int lo16[16], up16[16];
#pragma unroll
        for (int i = 0; i < 16; ++i) { auto t = __builtin_amdgcn_permlane32_swap((unsigned)pk[i], (unsigned)pk[i], false, false); lo16[i] = (int)t[0]; up16[i] = (int)t[1]; }
#pragma unroll
        for (int i = 0; i < 16; ++i) L[p][i] = lo16[i] > up16[15 - i] ? lo16[i] : up16[15 - i];
#pragma unroll
        for (int j = 8; j > 0; j >>= 1)
#pragma unroll
            for (int i = 0; i < 16; ++i) { const int l = i ^ j; if (l > i) MK_CE(L[p][i], L[p][l]); }
    }
    LAS unsigned char* tab = c.lds + LTAB_OFF + (c.wave * 32 + cc) * 32;
    if (h == 0) {
        u32x4 w0, w1;
#pragma unroll
        for (int q4 = 0; q4 < 4; ++q4) {
            w0[q4] = (unsigned)(127 - (L[0][4 * q4] & 127)) | ((unsigned)(127 - (L[0][4 * q4 + 1] & 127)) << 8) | ((unsigned)(127 - (L[0][4 * q4 + 2] & 127)) << 16) | ((unsigned)(127 - (L[0][4 * q4 + 3] & 127)) << 24);
            w1[q4] = (unsigned)(127 - (L[1][4 * q4] & 127)) | ((unsigned)(127 - (L[1][4 * q4 + 1] & 127)) << 8) | ((unsigned)(127 - (L[1][4 * q4 + 2] & 127)) << 16) | ((unsigned)(127 - (L[1][4 * q4 + 3] & 127)) << 24); }
        *(LAS u32x4*)(tab) = w0; *(LAS u32x4*)(tab + 16) = w1;
    }
    constexpr CandTab CT = make_cand();
    int pk2v[64];
#pragma unroll
    for (int s = 0; s < 64; ++s) {
        if (s < 50) { const int i = CT.i[s], j = CT.j[s];
            const float sum = ord2f(L[0][i] & ~127) + ord2f(L[1][j] & ~127);
            pk2v[s] = (f2ord(sum) & ~255) | (255 - (16 * i + j)); }
        else pk2v[s] = (int)0x80000000;
    }
    top16_of_64(pk2v);
    MK_LDS_WAIT();
    float tops[16]; int eidx[16];
#pragma unroll
    for (int it = 0; it < 16; ++it) { const int code = 255 - (pk2v[it] & 255); tops[it] = ord2f(pk2v[it] & ~255);
        eidx[it] = (int)tab[code >> 4] * 128 + (int)tab[16 + (code & 15)]; }
    { const float t0 = tops[0]; float den = 0.f;
#pragma unroll
      for (int it = 0; it < 16; ++it) { tops[it] = __expf(tops[it] - t0); den += tops[it]; }
      const float rden = 1.0f / den;
#pragma unroll
      for (int it = 0; it < 16; ++it) tops[it] *= rden; }
    LAS unsigned* si = (LAS unsigned*)(c.lds + SEL_IDX_OFF) + cc * 128 + head * 16;
    LAS float* sg = (LAS float*)(c.lds + SEL_GATE_OFF) + cc * 128 + head * 16;
    if (h == 0) {
#pragma unroll
        for (int q4 = 0; q4 < 4; ++q4) { u32x4 w = {(unsigned)eidx[4 * q4], (unsigned)eidx[4 * q4 + 1], (unsigned)eidx[4 * q4 + 2], (unsigned)eidx[4 * q4 + 3]}; *(LAS u32x4*)(si + 4 * q4) = w; }
    } else {
#pragma unroll
        for (int q4 = 0; q4 < 4; ++q4) { f32x4 w = {tops[4 * q4], tops[4 * q4 + 1], tops[4 * q4 + 2], tops[4 * q4 + 3]}; *(LAS f32x4*)(sg + 4 * q4) = w; }
    }
}

#define MK_ROW_LOAD(R, P, e) do { const bf16_t* rp_ = (P) + (size_t)(e) * DM + lane * 8; \
        _Pragma("unroll") for (int i_ = 0; i_ < 8; ++i_) R[i_] = *(const u32x4*)(rp_ + i_ * 512); } while (0)
__device__ __forceinline__ void peer_token(const Ctx& c, int tl, int tok, const bf16_t* __restrict__ U, const bf16_t* __restrict__ V,
                                           float* Hf, bf16_t* Hb, float* dst, bool write_hb, const float* __restrict__ g, const float* __restrict__ b) {
    int lane = c.lane; asm volatile("" : "+v"(lane));
    const LAS unsigned* sidx = (const LAS unsigned*)(c.lds + SEL_IDX_OFF) + tl * 128;
    const LAS float* sgate = (const LAS float*)(c.lds + SEL_GATE_OFF) + tl * 128;
    LAS float* wb = (LAS float*)(c.lds + WBUF_OFF) + c.wave * 128;
    float sv0 = 0.f, sv1 = 0.f;
    {
        u32x4 xr[8];
        { const bf16_t* xp = Hb + (size_t)tok * DM + lane * 8;
#pragma unroll
          for (int i = 0; i < 8; ++i) xr[i] = *(const u32x4*)(xp + i * 512); }
        u32x4 R0[8], R1[8];
        { const unsigned e0 = __builtin_amdgcn_readfirstlane(sidx[0]), e1 = __builtin_amdgcn_readfirstlane(sidx[1]); MK_ROW_LOAD(R0, U, e0); MK_ROW_LOAD(R1, U, e1); }
#pragma unroll 1
        for (int k = 0; k < 128; k += 2) {
            float a0 = 0.f, a1 = 0.f, a2 = 0.f, a3 = 0.f;
#pragma unroll
            for (int i = 0; i < 8; ++i) { a0 = dot2(R0[i][0], xr[i][0], a0); a1 = dot2(R0[i][1], xr[i][1], a1); a2 = dot2(R0[i][2], xr[i][2], a2); a3 = dot2(R0[i][3], xr[i][3], a3); }
            if (k + 2 < 128) { const unsigned e = __builtin_amdgcn_readfirstlane(sidx[k + 2]); MK_ROW_LOAD(R0, U, e); }
            const float s0 = wave_sum((a0 + a1) + (a2 + a3));
            sv0 = (lane == k) ? s0 : sv0; sv1 = (lane + 64 == k) ? s0 : sv1;
            a0 = 0.f; a1 = 0.f; a2 = 0.f; a3 = 0.f;
#pragma unroll
            for (int i = 0; i < 8; ++i) { a0 = dot2(R1[i][0], xr[i][0], a0); a1 = dot2(R1[i][1], xr[i][1], a1); a2 = dot2(R1[i][2], xr[i][2], a2); a3 = dot2(R1[i][3], xr[i][3], a3); }
            if (k + 3 < 128) { const unsigned e = __builtin_amdgcn_readfirstlane(sidx[k + 3]); MK_ROW_LOAD(R1, U, e); }
            const float s1 = wave_sum((a0 + a1) + (a2 + a3));
            sv0 = (lane == k + 1) ? s1 : sv0; sv1 = (lane + 64 == k + 1) ? s1 : sv1;
        }
    }
    wb[lane] = sgate[lane] * gelu_exact(sv0); wb[lane + 64] = sgate[lane + 64] * gelu_exact(sv1);
    MK_LDS_WAIT();
    float out[64];
#pragma unroll
    for (int i = 0; i < 64; ++i) out[i] = 0.f;
    {
        u32x4 R0[8], R1[8];
        { const unsigned e0 = __builtin_amdgcn_readfirstlane(sidx[0]), e1 = __builtin_amdgcn_readfirstlane(sidx[1]); MK_ROW_LOAD(R0, V, e0); MK_ROW_LOAD(R1, V, e1); }
#pragma unroll 1
        for (int k = 0; k < 128; k += 2) {
            const float w0 = wb[k], w1 = wb[k + 1];
#pragma unroll
            for (int i = 0; i < 8; ++i)
#pragma unroll
                for (int j = 0; j < 4; ++j) { out[8 * i + 2 * j] = fmaf(w0, bf_lo(R0[i][j]), out[8 * i + 2 * j]); out[8 * i + 2 * j + 1] = fmaf(w0, bf_hi(R0[i][j]), out[8 * i + 2 * j + 1]); }
            if (k + 2 < 128) { const unsigned e = __builtin_amdgcn_readfirstlane(sidx[k + 2]); MK_ROW_LOAD(R0, V, e); }
#pragma unroll
            for (int i = 0; i < 8; ++i)
#pragma unroll
                for (int j = 0; j < 4; ++j) { out[8 * i + 2 * j] = fmaf(w1, bf_lo(R1[i][j]), out[8 * i + 2 * j]); out[8 * i + 2 * j + 1] = fmaf(w1, bf_hi(R1[i][j]), out[8 * i + 2 * j + 1]); }
            if (k + 3 < 128) { const unsigned e = __builtin_amdgcn_readfirstlane(sidx[k + 3]); MK_ROW_LOAD(R1, V, e); }
        }
    }
    const size_t rbase = (size_t)tok * DM + lane * 8;
    float s = 0.f;
#pragma unroll
    for (int i = 0; i < 8; ++i) { const f32x4 a = *(const f32x4*)(Hf + rbase + i * 512), bq = *(const f32x4*)(Hf + rbase + i * 512 + 4);
#pragma unroll
        for (int j = 0; j < 4; ++j) { out[8 * i + j] = fmaf(DN_ALPHA, a[j], out[8 * i + j]); out[8 * i + 4 + j] = fmaf(DN_ALPHA, bq[j], out[8 * i + 4 + j]); s += out[8 * i + j] + out[8 * i + 4 + j]; } }
    const float mean = wave_sum(s) * (1.f / DM); float q = 0.f;
#pragma unroll
    for (int i = 0; i < 64; ++i) { out[i] -= mean; q = fmaf(out[i], out[i], q); }
    const float rstd = 1.0f / sqrtf(wave_sum(q) * (1.f / DM) + LN_EPS);
#pragma unroll
    for (int i = 0; i < 8; ++i) {
        const f32x4 g0 = *(const f32x4*)(g + lane * 8 + i * 512), g1 = *(const f32x4*)(g + lane * 8 + i * 512 + 4), b0 = *(const f32x4*)(b + lane * 8 + i * 512), b1 = *(const f32x4*)(b + lane * 8 + i * 512 + 4);
        f32x4 o0, o1;
#pragma unroll
        for (int j = 0; j < 4; ++j) { o0[j] = out[8 * i + j] * rstd * g0[j] + b0[j]; o1[j] = out[8 * i + 4 + j] * rstd * g1[j] + b1[j]; }
        *(f32x4*)(dst + rbase + i * 512) = o0; *(f32x4*)(dst + rbase + i * 512 + 4) = o1;
        if (write_hb) { u32x4 w = {pk2(o0[0], o0[1]), pk2(o0[2], o0[3]), pk2(o1[0], o1[1]), pk2(o1[2], o1[3])}; *(u32x4*)(Hb + rbase + i * 512) = w; }
    }
}
#undef MK_ROW_LOAD

__device__ __forceinline__ void peer_phase(const Ctx& c, const bf16_t* QP, const float* __restrict__ subk, const bf16_t* U, const bf16_t* V,
                                           float* Hf, bf16_t* Hb, float* dst, bool write_hb, const float* g, const float* b) {
    for (int i = c.tid; i < 2 * 128 * 16; i += NTHREADS) { const int row = i >> 4, ch = i & 15;
        const f32x4 a = *(const f32x4*)(subk + row * 128 + ch * 8), bq = *(const f32x4*)(subk + row * 128 + ch * 8 + 4);
        u32x4 w = {pk2(a[0], a[1]), pk2(a[2], a[3]), pk2(bq[0], bq[1]), pk2(bq[2], bq[3])};
        *(LAS u32x4*)(c.lds + row * SK_PITCH + ch * 16) = w; }
    __syncthreads();
#pragma unroll 1
    for (int unit = c.bid; unit < T / 32; unit += c.G) {
        const int tok0 = unit * 32;
#ifndef MK_NO_SELECT
        peer_select(c, QP, tok0);
#endif
        __syncthreads();
#ifndef MK_NO_TOKEN
#pragma unroll 1
        for (int j = 0; j < 4; ++j) { const int tl = 4 * c.wave + j; peer_token(c, tl, tok0 + tl, U, V, Hf, Hb, dst, write_hb, g, b); }
#endif
        __syncthreads();
    }
}

constexpr int NPHASES = 16;
struct Args { const float* in[14]; float* out; unsigned char* ws; int ph_lo, ph_hi, li, pad; };

__global__ void __launch_bounds__(NTHREADS, 2) mk_fwd(Args args) {
    extern __shared__ __attribute__((aligned(16))) unsigned char lds_raw[];
    Ctx c; c.lds = (LAS unsigned char*)lds_raw; c.tid = threadIdx.x; c.lane = c.tid & 63; c.wave = __builtin_amdgcn_readfirstlane(c.tid >> 6); c.G = gridDim.x; c.bid = blockIdx.x;
    if (c.tid < 4) ((LAS unsigned*)(c.lds + LDS_BARW))[c.tid] = 0u;
    __syncthreads();
    unsigned char* ws = args.ws;
    XcdBarrier bar = xcd_barrier_post((unsigned*)(ws + WS_CTL) + (size_t)args.li * BAR_REGION_WORDS, (volatile LAS unsigned*)(c.lds + LDS_BARW));
    const int lo = args.ph_lo, hi = args.ph_hi;
#ifndef MK_ONLY
#define MK_ONLY -1
#endif
#define IN(k) ((MK_ONLY < 0 || MK_ONLY == (k)) && lo <= (k) && (k) < hi)
#define SEAM(k) do { if (IN((k) + 1)) xcd_barrier(bar); } while (0)
    const float* x = args.in[0]; const float* a_w_in = args.in[1]; const float* a_w_out = args.in[2]; const float* b_w_in = args.in[3]; const float* b_f_bias = args.in[4];
    const float* b_w_out = args.in[5]; const float* peer_w_q = args.in[6]; const float* peer_sk = args.in[7]; const float* peer_u = args.in[8]; const float* peer_v = args.in[9];
    const float* ln_mix_g = args.in[10]; const float* ln_mix_b = args.in[11]; const float* ln_ffn_g = args.in[12]; const float* ln_ffn_b = args.in[13];
    bf16_t* W_IN = (bf16_t*)(ws + WS_WIN); bf16_t* W_OUT = (bf16_t*)(ws + WS_WOUT); bf16_t* W_Q = (bf16_t*)(ws + WS_WQ); bf16_t* UB = (bf16_t*)(ws + WS_U); bf16_t* VB = (bf16_t*)(ws + WS_V);
    float* HF = (float*)(ws + WS_HF); bf16_t* HB = (bf16_t*)(ws + WS_HB); bf16_t* QKV = (bf16_t*)(ws + WS_QKV); bf16_t* OG = (bf16_t*)(ws + WS_OG);
    float* LSE = (float*)(ws + WS_LSE); float* FG = (float*)(ws + WS_FG); float* C2 = (float*)(ws + WS_C2); bf16_t* A2 = (bf16_t*)(ws + WS_A2); bf16_t* QP = (bf16_t*)(ws + WS_QP);
    const size_t EU = (size_t)16384 * DM;

    if (IN(0)) {
        transpose_weights(c, a_w_in, DM, A_COLS, W_IN); transpose_weights(c, a_w_out, 2048, DM, W_OUT); transpose_weights(c, peer_w_q, DM, 2048, W_Q);
        convert_flat(c, peer_u, UB, EU); convert_flat(c, peer_v, VB, EU); convert_flat(c, x, HB, (size_t)T * DM);
        SEAM(0);
    }
    if (IN(1)) {
        pg8::Gemm g{HB, W_IN, T, A_COLS, DM}; pg8::StaticOrder S; S.init(T, A_COLS, c.G, c.bid);
        pg8::EpiBf16<0> E{QKV, A_COLS, nullptr, 0, 0};
        pg8::gemm_phase<pg8::EpiBf16<0>, pg8::StaticOrder, false>(c.lds, g, S, E, nullptr);
        SEAM(1);
    }
    if (IN(2)) { dil_attn_phase(c, QKV, OG, LSE); SEAM(2); }
    if (IN(3)) { merge_phase(c, OG, LSE, A2); SEAM(3); }
    if (IN(4)) {
        pg8::Gemm g{A2, W_OUT, T, DM, 2048}; pg8::StaticOrder S; S.init(T, DM, c.G, c.bid);
        EpiRes E{x, HF, DM, DN_ALPHA};
        pg8::gemm_phase<EpiRes, pg8::StaticOrder, false>(c.lds, g, S, E, nullptr);
        SEAM(4);
    }
    if (IN(5)) { ln_phase(c, HF, HB, ln_mix_g, ln_mix_b); SEAM(5); }
    if (IN(6)) {
        pg8::Gemm g{HB, W_Q, T, 2048, DM}; pg8::StaticOrder S; S.init(T, 2048, c.G, c.bid);
        pg8::EpiBf16<0> E{QP, 2048, nullptr, 0, 0};
        pg8::gemm_phase<pg8::EpiBf16<0>, pg8::StaticOrder, false>(c.lds, g, S, E, nullptr);
        SEAM(6);
    }
    if (IN(7)) { peer_phase(c, QP, peer_sk, UB, VB, HF, HB, HF, true, ln_ffn_g, ln_ffn_b); SEAM(7); }
    if (IN(8)) {
        transpose_weights(c, b_w_in, DM, B_COLS, W_IN); zero_flat16(c, W_IN + (size_t)B_COLS * DM, (size_t)(B_COLS_PAD - B_COLS) * DM * 2);
        transpose_weights(c, b_w_out, DM, DM, W_OUT); transpose_weights(c, peer_w_q + (size_t)DM * 2048, DM, 2048, W_Q);
        convert_flat(c, peer_u + EU, UB, EU); convert_flat(c, peer_v + EU, VB, EU);
        SEAM(8);
    }
    if (IN(9)) {
        pg8::Gemm g{HB, W_IN, T, B_COLS_PAD, DM}; pg8::StaticOrder S; S.init(T, B_COLS_PAD, c.G, c.bid);
        EpiFox E{QKV, FG};
        pg8::gemm_phase<EpiFox, pg8::StaticOrder, false>(c.lds, g, S, E, nullptr);
        SEAM(9);
    }
    if (IN(10)) { cumsum_phase(c, FG, b_f_bias, C2); SEAM(10); }
    if (IN(11)) { fox_attn_phase(c, QKV, C2, OG); SEAM(11); }
    if (IN(12)) {
        pg8::Gemm g{OG, W_OUT, T, DM, DM}; pg8::StaticOrder S; S.init(T, DM, c.G, c.bid);
        EpiRes E{HF, HF, DM, DN_ALPHA};
        pg8::gemm_phase<EpiRes, pg8::StaticOrder, false>(c.lds, g, S, E, nullptr);
        SEAM(12);
    }
    if (IN(13)) { ln_phase(c, HF, HB, ln_mix_g + DM, ln_mix_b + DM); SEAM(13); }
    if (IN(14)) {
        pg8::Gemm g{HB, W_Q, T, 2048, DM}; pg8::StaticOrder S; S.init(T, 2048, c.G, c.bid);
        pg8::EpiBf16<0> E{QP, 2048, nullptr, 0, 0};
        pg8::gemm_phase<pg8::EpiBf16<0>, pg8::StaticOrder, false>(c.lds, g, S, E, nullptr);
        SEAM(14);
    }
    if (IN(15)) { peer_phase(c, QP, peer_sk + 2 * 128 * 128, UB, VB, HF, HB, args.out, false, ln_ffn_g + DM, ln_ffn_b + DM); }
#undef IN
#undef SEAM
}
}

extern "C" void kernel_launch(void* const* d_in, const int* in_sizes, int n_in, void* d_out, int out_size, void* d_ws, size_t ws_size, hipStream_t stream) {
    using namespace mk;
    static int grid = 0;
    if (grid == 0) {
        if (n_in != 14 || out_size != T * DM || ws_size < WS_END) { fprintf(stderr, "kernel_launch: unexpected shapes (n_in %d out %d ws %zu need %zu); nothing launched\n", n_in, out_size, ws_size, (size_t)WS_END); grid = -1; return; }
        int dev = 0, cus = 0, per_cu = 0;
        if (hipGetDevice(&dev) != hipSuccess || hipDeviceGetAttribute(&cus, hipDeviceAttributeMultiprocessorCount, dev) != hipSuccess) { grid = -1; return; }
        if (hipFuncSetAttribute((const void*)mk_fwd, hipFuncAttributeMaxDynamicSharedMemorySize, LDS_BYTES) != hipSuccess) { fprintf(stderr, "kernel_launch: hipFuncSetAttribute failed\n"); grid = -1; return; }
        if (hipOccupancyMaxActiveBlocksPerMultiprocessor(&per_cu, (const void*)mk_fwd, NTHREADS, LDS_BYTES) != hipSuccess || per_cu < 1) { fprintf(stderr, "kernel_launch: occupancy query says %d\n", per_cu); per_cu = 1; }
        (void)hipGetLastError();
        grid = cus;
    }
    if (grid < 0) return;
    if (hipMemsetAsync((char*)d_ws + WS_CTL, 0, (size_t)MAX_LAUNCHES * BAR_REGION_WORDS * 4, stream) != hipSuccess) return;
    Args a{};
    for (int i = 0; i < 14; ++i) a.in[i] = (const float*)d_in[i];
    a.out = (float*)d_out; a.ws = (unsigned char*)d_ws; a.pad = 0;
#if MK_N_LAUNCHES == 1
    a.ph_lo = 0; a.ph_hi = NPHASES; a.li = 0;
    hipLaunchKernelGGL(mk_fwd, dim3(grid), dim3(NTHREADS), LDS_BYTES, stream, a);
#else
    for (int p = 0; p < NPHASES; ++p) { a.ph_lo = p; a.ph_hi = p + 1; a.li = p; hipLaunchKernelGGL(mk_fwd, dim3(grid), dim3(NTHREADS), LDS_BYTES, stream, a); }
#endif
}
```

```cpp
#include <hip/hip_runtime.h>
#include <cstdio>
#include <cstdint>
#ifndef MK_N_LAUNCHES
#define MK_N_LAUNCHES 1
#endif
__device__ __forceinline__ int mk_hw_lane() { int l; asm volatile("v_mbcnt_lo_u32_b32 %0, -1, 0\n\tv_mbcnt_hi_u32_b32 %0, -1, %0" : "=v"(l)); return l; }

#define XB_TMO      128
#define XB_XCNT(j)  (256  + 64 * (j))
#define XB_XSUB(j)  (1280 + 64 * (j))
#define XB_XGEN(j)  (2304 + 64 * (j))
#define XB_TOP      3328
#define XB_TOPGEN   3392
#define XCD_BAR_WORDS 3456
#define XB_SPIN_CAP (1u << 18)
#define LAS __attribute__((address_space(3)))

__device__ __forceinline__ unsigned xb_ld(unsigned* p)              { return __hip_atomic_load(p, __ATOMIC_RELAXED, __HIP_MEMORY_SCOPE_AGENT); }
__device__ __forceinline__ unsigned xb_add(unsigned* p, unsigned v) { return __hip_atomic_fetch_add(p, v, __ATOMIC_RELAXED, __HIP_MEMORY_SCOPE_AGENT); }
__device__ __forceinline__ unsigned xb_xcc_id() { return (unsigned)__builtin_amdgcn_s_getreg((3 << 11) | 20) & 0xFu; }
#define XB_SPIN(cond, bar) do { unsigned _sp = 0; while (cond) { __builtin_amdgcn_s_sleep(1); \
    if ((++_sp & 255u) == 0u) { if (xb_ld(&(bar)[XB_TMO])) break; if (_sp > XB_SPIN_CAP) { atomicAdd(&(bar)[XB_TMO], 1u); break; } } } } while (0)

struct XcdBarrier {
    unsigned* bar; unsigned x; int wave;
    volatile LAS unsigned* st;
};

__device__ __forceinline__ XcdBarrier xcd_barrier_post(unsigned* bar, volatile LAS unsigned* st, int wave) {
    XcdBarrier b; b.bar = bar; b.x = xb_xcc_id(); b.st = st; b.wave = wave;
    if (wave == 0 && mk_hw_lane() == 0) (void)xb_add(&bar[XB_XCNT(b.x)], 1u);
    return b;
}
__device__ __forceinline__ void xcd_barrier_complete(unsigned* bar, unsigned x, unsigned& nloc, unsigned& nx) {
    const unsigned G = gridDim.x * gridDim.y * gridDim.z;
    unsigned sum, cnt, mine, sp = 0u;
    for (;;) {
        sum = 0u; cnt = 0u; mine = 0u;
#pragma unroll
        for (unsigned j = 0; j < 16; ++j) { const unsigned c = xb_ld(&bar[XB_XCNT(j)]); sum += c; cnt += (c > 0u) ? 1u : 0u; mine = (j == x) ? c : mine; }
        if (sum == G) break;
        __builtin_amdgcn_s_sleep(1);
        if ((++sp & 255u) == 0u) { if (xb_ld(&bar[XB_TMO])) break; if (sp > XB_SPIN_CAP) { atomicAdd(&bar[XB_TMO], 1u); break; } }
    }
    nloc = mine > 0u ? mine : 1u; nx = cnt > 0u ? cnt : 1u;
}

__device__ __forceinline__ void xcd_barrier(const XcdBarrier& b) {
    asm volatile("s_waitcnt vmcnt(0)" ::: "memory");
    __syncthreads();
    if (b.wave == 0 && mk_hw_lane() == 0) {
        unsigned* bar = b.bar;
        __builtin_amdgcn_s_waitcnt(0);
        unsigned nloc = b.st[0], nx = b.st[1];
        if (nloc == 0u) { xcd_barrier_complete(bar, b.x, nloc, nx); b.st[0] = nloc; b.st[1] = nx; }
        const unsigned old = xb_add(&bar[XB_XSUB(b.x)], 1u);
        const unsigned gen = old / nloc;
        if (old + 1u == (gen + 1u) * nloc) {
            __builtin_amdgcn_fence(__ATOMIC_RELEASE, "agent");
            asm volatile("s_waitcnt vmcnt(0)" ::: "memory");
            const unsigned og = xb_add(&bar[XB_TOP], 1u);
            const unsigned tg = og / nx;
            if (og + 1u == (tg + 1u) * nx) xb_add(&bar[XB_TOPGEN], 1u);
            else XB_SPIN(xb_ld(&bar[XB_TOPGEN]) == tg, bar);
            __builtin_amdgcn_fence(__ATOMIC_ACQUIRE, "agent");
            xb_add(&bar[XB_XGEN(b.x)], 1u);
            asm volatile("s_waitcnt vmcnt(0)" ::: "memory");
        } else {
            XB_SPIN(xb_ld(&bar[XB_XGEN(b.x)]) == gen, bar);
            __builtin_amdgcn_fence(__ATOMIC_ACQUIRE, "agent");
            asm volatile("s_waitcnt vmcnt(0)" ::: "memory");
        }
    }
    __syncthreads();
}

namespace pg8 {
#define PG8_LAS __attribute__((address_space(3)))
typedef unsigned short bf16_t;
typedef short bf16x8 __attribute__((ext_vector_type(8)));
typedef float f32x4 __attribute__((ext_vector_type(4)));
typedef unsigned u32x4 __attribute__((ext_vector_type(4)));
constexpr int BM = 256, BK = 64, HALF = 128, HTB = HALF * BK * 2  , STAGE_BYTES = 8 * HTB, NXCD = 8, WGM = 8;

__host__ __device__ __forceinline__ int lds_byte(int r, int c) { const int st = (r >> 4) * 2 + (c >> 5), rr = r & 15, cc = c & 31, ob = rr * 64 + cc * 2; return st * 1024 + (ob ^ (((ob >> 9) & 1) << 5)); }
__host__ __device__ __forceinline__ void stage_rc(int b, int& R, int& C) { const int st = b / 1024, sb = b % 1024, swz = sb ^ (((sb >> 9) & 1) << 5); R = (st >> 1) * 16 + swz / 64; C = (st & 1) * 32 + (swz % 64) / 2; }
__host__ __device__ __forceinline__ int perm32(int rho) { const int n = rho >> 4, i = rho & 15; return 8 * (i >> 2) + 4 * n + (i & 3); }

struct Unit { int pm, pn; };
struct Gemm { const bf16_t* A; const bf16_t* Bt; int M, N, K, wave; const float* sa; const float* sb; };

struct StaticOrder {
    int nM, nN, nwg, G, c;
    __host__ __device__ void init(int M, int N, int G_, int c_) { nM = M / BM; nN = N / BM; nwg = nM * nN; G = G_; c = c_; }
    __host__ __device__ bool next(int i, Unit& u) const {
        const long L = (long)i * G + c; if (L >= nwg) return false;
        int wgid = (int)L; { const int q = nwg / NXCD, r = nwg % NXCD, xcd = wgid % NXCD, off = wgid / NXCD; wgid = (xcd < r ? xcd * (q + 1) : r * (q + 1) + (xcd - r) * q) + off; }
        const int nig = WGM * nN, gid = wgid / nig, fm = gid * WGM, gsz = (nM - fm) < WGM ? (nM - fm) : WGM;
        u.pm = fm + ((wgid % nig) % gsz); u.pn = (wgid % nig) / gsz; return true;
    }
    __device__ __forceinline__ void a_ready(const Unit&) const {}
    __device__ __forceinline__ void done(const Unit&) const {}
};
struct CountedOrder : StaticOrder {
    const unsigned* ready; unsigned need; unsigned* tmo;
    __device__ __forceinline__ void a_ready(const Unit& u) const {
        if (threadIdx.x < 64) {
            const unsigned long long t0 = __builtin_amdgcn_s_memrealtime(); unsigned polls = 0;
            while ((unsigned)__builtin_amdgcn_readfirstlane(__hip_atomic_load(ready + 64 * u.pm, __ATOMIC_RELAXED, __HIP_MEMORY_SCOPE_AGENT)) < need) {
                if ((++polls & 255u) == 0u && __builtin_amdgcn_readfirstlane(__hip_atomic_load(tmo, __ATOMIC_RELAXED, __HIP_MEMORY_SCOPE_AGENT)) != 0u) break;
                if (__builtin_amdgcn_s_memrealtime() - t0 > 2000000ull) {
                    if (threadIdx.x == 0) { unsigned expect = 0u; __hip_atomic_compare_exchange_strong(tmo + 1, &expect, 0x600u | (unsigned)(u.pm & 0xff), __ATOMIC_RELAXED, __ATOMIC_RELAXED, __HIP_MEMORY_SCOPE_AGENT); __hip_atomic_store(tmo, 1u, __ATOMIC_RELAXED, __HIP_MEMORY_SCOPE_AGENT); }
                    break; }
                __builtin_amdgcn_s_sleep(2); }
            __builtin_amdgcn_fence(__ATOMIC_ACQUIRE, "agent");
            asm volatile("s_waitcnt vmcnt(0)" ::: "memory");
        }
#if !defined(BROKEN_HOOK_NO_BARRIER)
        asm volatile("" ::: "memory"); __builtin_amdgcn_s_barrier(); asm volatile("" ::: "memory");
#endif
    }
};

__device__ __forceinline__ unsigned cvt_pk_bf16(float lo, float hi) { unsigned r; asm volatile("v_cvt_pk_bf16_f32 %0, %1, %2" : "=v"(r) : "v"(lo), "v"(hi)); return r; }
typedef float f32x2 __attribute__((ext_vector_type(2)));
__device__ __forceinline__ f32x2 gelu_pk(f32x2 v) {
    const f32x2 av = __builtin_elementwise_abs(v), d = av * 0.2316418882f + 1.0f;
    f32x2 t; t.x = __builtin_amdgcn_rcpf(d.x); t.y = __builtin_amdgcn_rcpf(d.y);
    f32x2 q = t * 0.5307027145f + (-0.7265760135f); q = q * t + 0.7107068705f; q = q * t + (-0.142248368f); q = q * t + 0.127414796f; q = q * t;
    const f32x2 s = (v * v) * (-0.72134752044f);
    f32x2 e; e.x = __builtin_amdgcn_exp2f(s.x); e.y = __builtin_amdgcn_exp2f(s.y);
    const f32x2 m = v * (q * e), r = v - m;
    f32x2 o; o.x = v.x < 0.f ? m.x : r.x; o.y = v.y < 0.f ? m.y : r.y; return o;
}

struct EpiF32 {
    static constexpr bool PERM = false, AFTER_DRAIN = false;
    float* C; int ldc; const float* bias;
    __device__ __forceinline__ void operator()(const f32x4 (&acc)[2][2][4][2], const Unit& u, int wr, int wc, int fr, int fq) const {
        const int row0 = u.pm * BM + wr * 64 + fr, col0 = u.pn * BM + wc * 32 + 4 * fq;
        f32x4 bv[2][2];
#pragma unroll
        for (int bj = 0; bj < 2; ++bj)
#pragma unroll
            for (int n = 0; n < 2; ++n) bv[bj][n] = bias ? *(const f32x4*)(bias + col0 + bj * HALF + n * 16) : (f32x4){0.f, 0.f, 0.f, 0.f};
#pragma unroll
        for (int ai = 0; ai < 2; ++ai)
#pragma unroll
            for (int m = 0; m < 4; ++m) { float* rowp = C + (size_t)(row0 + ai * HALF + m * 16) * ldc + col0;
#pragma unroll
                for (int bj = 0; bj < 2; ++bj)
#pragma unroll
                    for (int n = 0; n < 2; ++n) *(f32x4*)(rowp + bj * HALF + n * 16) = acc[ai][bj][m][n] + bv[bj][n]; }
    }
};
template <int ACT  > struct EpiBf16 {
    static constexpr bool PERM = true, AFTER_DRAIN = false;
    bf16_t* O; int ldc; const float* bias; int split_cols; size_t split_stride;
    __device__ __forceinline__ void operator()(const f32x4 (&acc)[2][2][4][2], const Unit& u, int wr, int wc, int fr, int fq) const {
        const int row0 = u.pm * BM + wr * 64 + fr; int colt = u.pn * BM; bf16_t* base = O;
        if (split_cols) { const int t = colt / split_cols; base += (size_t)t * split_stride; colt -= t * split_cols; }
        const int col0 = colt + wc * 32 + 8 * fq, bcol0 = u.pn * BM + wc * 32 + 8 * fq;
        f32x4 bv[2][2];
#pragma unroll
        for (int bj = 0; bj < 2; ++bj)
#pragma unroll
            for (int n = 0; n < 2; ++n) bv[bj][n] = bias ? *(const f32x4*)(bias + bcol0 + bj * HALF + 4 * n) : (f32x4){0.f, 0.f, 0.f, 0.f};
#pragma unroll
        for (int ai = 0; ai < 2; ++ai)
#pragma unroll
            for (int m = 0; m < 4; ++m) { bf16_t* rowp = base + (size_t)(row0 + ai * HALF + m * 16) * ldc + col0;
#pragma unroll
                for (int bj = 0; bj < 2; ++bj) { f32x4 v0 = acc[ai][bj][m][0] + bv[bj][0], v1 = acc[ai][bj][m][1] + bv[bj][1];
                    if (ACT == 1) { f32x2 a = gelu_pk((f32x2){v0[0], v0[1]}), b = gelu_pk((f32x2){v0[2], v0[3]}), c = gelu_pk((f32x2){v1[0], v1[1]}), d = gelu_pk((f32x2){v1[2], v1[3]});
                        v0 = (f32x4){a.x, a.y, b.x, b.y}; v1 = (f32x4){c.x, c.y, d.x, d.y}; }
                    if (ACT == 2) {
#pragma unroll
                        for (int j = 0; j < 4; ++j) { v0[j] = 0.5f * v0[j] * (1.0f + erff(v0[j] * 0.70710678f)); v1[j] = 0.5f * v1[j] * (1.0f + erff(v1[j] * 0.70710678f)); } }
                    u32x4 w; w.x = cvt_pk_bf16(v0[0], v0[1]); w.y = cvt_pk_bf16(v0[2], v0[3]); w.z = cvt_pk_bf16(v1[0], v1[1]); w.w = cvt_pk_bf16(v1[2], v1[3]);
                    *(u32x4*)(rowp + bj * HALF) = w; } }
    }
};

struct PanelStats {
    unsigned* xbuf;
    unsigned* cnt;
    unsigned* tmo;
    int ntn; float eps;
    unsigned code;
    __device__ __forceinline__ bool run(const f32x4 (&v)[2][2][4][2], const Unit& u, int wr, int wc, int fr, int fq, PG8_LAS unsigned char* lds, int wid, int lane) const {
        typedef float f32x2v __attribute__((ext_vector_type(2)));
        PG8_LAS f32x2v* P = (PG8_LAS f32x2v*)lds;
        PG8_LAS f32x2v* S = (PG8_LAS f32x2v*)(lds + 8192);
        PG8_LAS unsigned* flag = (PG8_LAS unsigned*)(lds + 8192 + 2048);
#pragma unroll
        for (int ai = 0; ai < 2; ++ai)
#pragma unroll
            for (int m = 0; m < 4; ++m) {
                float s = 0.f;
#pragma unroll
                for (int bj = 0; bj < 2; ++bj)
#pragma unroll
                    for (int n = 0; n < 2; ++n) { const f32x4 x = v[ai][bj][m][n]; s += (x[0] + x[1]) + (x[2] + x[3]); }
                s += __shfl_xor(s, 16); s += __shfl_xor(s, 32);
                const float mw = s * (1.0f / 64.0f); float q = 0.f;
#pragma unroll
                for (int bj = 0; bj < 2; ++bj)
#pragma unroll
                    for (int n = 0; n < 2; ++n) { const f32x4 d = v[ai][bj][m][n] - mw; q += (d[0] * d[0] + d[1] * d[1]) + (d[2] * d[2] + d[3] * d[3]); }
                q += __shfl_xor(q, 16); q += __shfl_xor(q, 32);
                if (fq == 0) P[(ai * HALF + wr * 64 + m * 16 + fr) * 4 + wc] = (f32x2v){mw, q};
            }
        asm volatile("s_waitcnt lgkmcnt(0)" ::: "memory"); __builtin_amdgcn_s_barrier(); asm volatile("" ::: "memory");
#if defined(BROKEN_NO_WAIT)
        if (blockIdx.x >= 64) { const long long t0 = clock64(); while (clock64() - t0 < 60000) __builtin_amdgcn_s_sleep(8); }
#endif
        const int row = wid * 32 + (lane & 31);
        if (lane < 32) {
            const f32x2v a = P[row * 4 + 0], b = P[row * 4 + 1], c = P[row * 4 + 2], d = P[row * 4 + 3];
            const float mt = (a.x + b.x + c.x + d.x) * 0.25f;
            const float da = a.x - mt, db = b.x - mt, dc = c.x - mt, dd = d.x - mt;
            const float m2 = (a.y + b.y) + (c.y + d.y) + 64.0f * ((da * da + db * db) + (dc * dc + dd * dd));
            unsigned long long* slot = (unsigned long long*)xbuf + ((size_t)(u.pm * BM + row) * 4 + u.pn);
            __hip_atomic_store(slot, ((unsigned long long)__float_as_uint(m2) << 32) | __float_as_uint(mt), __ATOMIC_RELAXED, __HIP_MEMORY_SCOPE_AGENT);
        }
        asm volatile("s_waitcnt vmcnt(0)" ::: "memory");
        if (lane == 0) __hip_atomic_fetch_add(cnt + 64 * u.pm, 1u, __ATOMIC_RELAXED, __HIP_MEMORY_SCOPE_AGENT);
        if (wid == 0) {
            bool dead = false; const unsigned long long t0 = __builtin_amdgcn_s_memrealtime(); const unsigned want = 8u * (unsigned)ntn;
            for (;;) {
#if defined(BROKEN_NO_WAIT)
                break;
#endif
                if ((unsigned)__builtin_amdgcn_readfirstlane(__hip_atomic_load(cnt + 64 * u.pm, __ATOMIC_RELAXED, __HIP_MEMORY_SCOPE_AGENT)) >= want) break;
                if (__builtin_amdgcn_s_memrealtime() - t0 > 2000000ull) {
                    if (lane == 0) { unsigned expect = 0u; __hip_atomic_compare_exchange_strong(tmo + 1, &expect, code | (unsigned)(u.pm & 0xff), __ATOMIC_RELAXED, __ATOMIC_RELAXED, __HIP_MEMORY_SCOPE_AGENT);
                                     __hip_atomic_store(tmo, 1u, __ATOMIC_RELAXED, __HIP_MEMORY_SCOPE_AGENT); }
                    dead = true; break; }
                __builtin_amdgcn_s_sleep(2);
            }
            __builtin_amdgcn_fence(__ATOMIC_ACQUIRE, "agent");
            if (lane == 0) flag[0] = dead ? 1u : 0u;
        }
        asm volatile("s_waitcnt vmcnt(0) lgkmcnt(0)" ::: "memory"); __builtin_amdgcn_s_barrier(); asm volatile("" ::: "memory");
        const bool bad = flag[0] != 0u;
        if (lane < 32) {
            const unsigned long long* slot = (const unsigned long long*)xbuf + (size_t)(u.pm * BM + row) * 4; float mt[4], m2[4]; float ms = 0.f;
#pragma unroll
            for (int t = 0; t < 4; ++t) { if (t < ntn) { const unsigned long long w = __hip_atomic_load(slot + t, __ATOMIC_RELAXED, __HIP_MEMORY_SCOPE_AGENT); mt[t] = __uint_as_float((unsigned)w); m2[t] = __uint_as_float((unsigned)(w >> 32)); } else { mt[t] = 0.f; m2[t] = 0.f; } ms += mt[t]; }
            const float mean = ms / (float)ntn; float q = 0.f;
#pragma unroll
            for (int t = 0; t < 4; ++t) if (t < ntn) { const float dm = mt[t] - mean; q += m2[t] + 256.0f * dm * dm; }
            S[row] = (f32x2v){mean, 1.0f / sqrtf(q / (256.0f * (float)ntn) + eps)};
        }
        asm volatile("s_waitcnt lgkmcnt(0)" ::: "memory"); __builtin_amdgcn_s_barrier(); asm volatile("" ::: "memory");
        return bad;
    }
};
struct EpiLnRes {
    static constexpr bool PERM = false, AFTER_DRAIN = true;
    const float* base; float* out; int ldc; const float* bias; PanelStats st; unsigned poison;
    __device__ __forceinline__ void refuse(size_t i0, size_t stride, int M, int N) const { const float q = __builtin_nanf(""); for (size_t i = i0; i < (size_t)M * N; i += stride) out[(i / N) * ldc + i % N] = q;
        if (i0 == 0) { unsigned expect = 0u; __hip_atomic_compare_exchange_strong(st.tmo + 1, &expect, 0x7f0u, __ATOMIC_RELAXED, __ATOMIC_RELAXED, __HIP_MEMORY_SCOPE_AGENT); __hip_atomic_store(st.tmo, 1u, __ATOMIC_RELAXED, __HIP_MEMORY_SCOPE_AGENT); } }
    __device__ __forceinline__ void fused(f32x4 (&acc)[2][2][4][2], const Unit& u, int wr, int wc, int fr, int fq, PG8_LAS unsigned char* lds, int wid, int lane) const {
        typedef float f32x2v __attribute__((ext_vector_type(2)));
        const PG8_LAS f32x2v* S = (const PG8_LAS f32x2v*)(lds + 8192);
        const int col0 = u.pn * BM + wc * 32 + 4 * fq;
#pragma unroll
        for (int bj = 0; bj < 2; ++bj)
#pragma unroll
            for (int n = 0; n < 2; ++n) { const f32x4 bv = bias ? *(const f32x4*)(bias + col0 + bj * HALF + n * 16) : (f32x4){0.f, 0.f, 0.f, 0.f};
#pragma unroll
                for (int ai = 0; ai < 2; ++ai)
#pragma unroll
                    for (int m = 0; m < 4; ++m) acc[ai][bj][m][n] += bv; }
        const bool bad = st.run(acc, u, wr, wc, fr, fq, lds, wid, lane) || poison != 0u;
        const float qnan = __builtin_nanf("");
#pragma unroll
        for (int ai = 0; ai < 2; ++ai)
#pragma unroll
            for (int m = 0; m < 4; ++m) { const int r = ai * HALF + wr * 64 + m * 16 + fr; const f32x2v sr = S[r]; const size_t off = (size_t)(u.pm * BM + r) * ldc + col0;
#pragma unroll
                for (int bj = 0; bj < 2; ++bj)
#pragma unroll
                    for (int n = 0; n < 2; ++n) { const f32x4 bs = *(const f32x4*)(base + off + bj * HALF + n * 16); f32x4 o = bs + (acc[ai][bj][m][n] - sr.x) * sr.y;
                        if (bad) o = (f32x4){qnan, qnan, qnan, qnan}; *(f32x4*)(out + off + bj * HALF + n * 16) = o; }
                asm volatile("" ::: "memory"); }
    }
};
struct EpiLnResLn {
    static constexpr bool PERM = false, AFTER_DRAIN = true;
    const float* base; float* out; bf16_t* xn; int ldc; const float* bias; PanelStats st1, st2; unsigned poison;
    __device__ __forceinline__ void refuse(size_t i0, size_t stride, int M, int N) const { const float q = __builtin_nanf(""); for (size_t i = i0; i < (size_t)M * N; i += stride) { const size_t o = (i / N) * ldc + i % N; out[o] = q; xn[o] = (bf16_t)0x7fc0u; }
        if (i0 == 0) { unsigned expect = 0u; __hip_atomic_compare_exchange_strong(st1.tmo + 1, &expect, 0x7f0u, __ATOMIC_RELAXED, __ATOMIC_RELAXED, __HIP_MEMORY_SCOPE_AGENT); __hip_atomic_store(st1.tmo, 1u, __ATOMIC_RELAXED, __HIP_MEMORY_SCOPE_AGENT); } }
    __device__ __forceinline__ void fused(f32x4 (&acc)[2][2][4][2], const Unit& u, int wr, int wc, int fr, int fq, PG8_LAS unsigned char* lds, int wid, int lane) const {
        typedef float f32x2v __attribute__((ext_vector_type(2))); typedef unsigned u32x2v __attribute__((ext_vector_type(2)));
        const PG8_LAS f32x2v* S = (const PG8_LAS f32x2v*)(lds + 8192);
        const int col0 = u.pn * BM + wc * 32 + 4 * fq;
#pragma unroll
        for (int bj = 0; bj < 2; ++bj)
#pragma unroll
            for (int n = 0; n < 2; ++n) { const f32x4 bv = bias ? *(const f32x4*)(bias + col0 + bj * HALF + n * 16) : (f32x4){0.f, 0.f, 0.f, 0.f};
#pragma unroll
                for (int ai = 0; ai < 2; ++ai)
#pragma unroll
                    for (int m = 0; m < 4; ++m) acc[ai][bj][m][n] += bv; }
        bool bad = st1.run(acc, u, wr, wc, fr, fq, lds, wid, lane) || poison != 0u;
        const float qnan = __builtin_nanf("");
#pragma unroll
        for (int ai = 0; ai < 2; ++ai)
#pragma unroll
            for (int m = 0; m < 4; ++m) { const int r = ai * HALF + wr * 64 + m * 16 + fr; const f32x2v sr = S[r]; const size_t off = (size_t)(u.pm * BM + r) * ldc + col0;
#pragma unroll
                for (int bj = 0; bj < 2; ++bj)
#pragma unroll
                    for (int n = 0; n < 2; ++n) { const f32x4 bs = *(const f32x4*)(base + off + bj * HALF + n * 16); acc[ai][bj][m][n] = bs + (acc[ai][bj][m][n] - sr.x) * sr.y; }
                asm volatile("" : "+v"(acc[ai][0][m][0]), "+v"(acc[ai][0][m][1]), "+v"(acc[ai][1][m][0]), "+v"(acc[ai][1][m][1]));
                if (m & 1) asm volatile("" ::: "memory"); }
        const bool bad1 = bad;
        bad = st2.run(acc, u, wr, wc, fr, fq, lds, wid, lane) || bad;
#pragma unroll
        for (int ai = 0; ai < 2; ++ai)
#pragma unroll
            for (int m = 0; m < 4; ++m) { const int r = ai * HALF + wr * 64 + m * 16 + fr; const f32x2v sr = S[r]; const size_t off = (size_t)(u.pm * BM + r) * ldc + col0;
#pragma unroll
                for (int bj = 0; bj < 2; ++bj)
#pragma unroll
                    for (int n = 0; n < 2; ++n) { const f32x4 x1 = acc[ai][bj][m][n]; *(f32x4*)(out + off + bj * HALF + n * 16) = bad1 ? (f32x4){qnan, qnan, qnan, qnan} : x1;
                        const f32x4 o = (x1 - sr.x) * sr.y; u32x2v w; w.x = cvt_pk_bf16(o[0], o[1]); w.y = cvt_pk_bf16(o[2], o[3]);
                        if (bad) { w.x = 0x7fc07fc0u; w.y = 0x7fc07fc0u; } *(u32x2v*)(xn + off + bj * HALF + n * 16) = w; }
                asm volatile("" ::: "memory"); }
    }
};

typedef int i32x4 __attribute__((ext_vector_type(4)));
template <class Epi, class Sched, bool STAMP = false, bool I8 = false>
__device__ __forceinline__ void gemm_phase(PG8_LAS unsigned char* lds, const Gemm g, const Sched& S, const Epi& E, unsigned long long* stamps) {
    const int lane = mk_hw_lane(), wid = g.wave, tid = wid * 64 + lane, wr = wid >> 2, wc = wid & 3, fr = lane & 15, fq = lane >> 4;
    const int K = g.K, nt = K / BK;
    int ts_lo = 0, ts_hi = 0, nts = 0; const unsigned long long rt_entry = STAMP ? (unsigned long long)wall_clock64() : 0ull;
#define PG8_STAMP() do { if (STAMP && wid == 0 && nts < 64) { const unsigned long long _c = (unsigned long long)clock64(); \
        ts_lo = (lane == nts) ? (int)(unsigned)_c : ts_lo; ts_hi = (lane == nts) ? (int)(unsigned)(_c >> 32) : ts_hi; ++nts; } } while (0)
    PG8_STAMP();
    unsigned voffA[2], voffB[2];
#pragma unroll
    for (int i = 0; i < 2; ++i) { int R, C; stage_rc(tid * 16 + i * 8192, R, C); const int Rb = Epi::PERM ? ((R & ~31) + perm32(R & 31)) : R;
        voffA[i] = (unsigned)(R * K + C) * 2u; voffB[i] = (unsigned)(Rb * K + C) * 2u; }
    const size_t kstep = (size_t)(BK * 2);
    const size_t hstep = (size_t)HALF * K * 2;
    const size_t tstep = 2 * hstep;
    const unsigned ldsw = (unsigned)wid * 1024u;
    const int aoff = lds_byte(wr * 64 + fr, fq * 8), boff = lds_byte(wc * 32 + fr, fq * 8);
#define PG8_SA(b, h) (((b) * 2 + (h)) * HTB)
#define PG8_SB(b, h) ((4 + (b) * 2 + (h)) * HTB)
#define PG8_STAGE(bufoff, gbase, voff) do { _Pragma("unroll") for (int _i = 0; _i < 2; ++_i) \
        __builtin_amdgcn_global_load_lds((const unsigned*)((const char*)(gbase) + (voff)[_i]), (PG8_LAS unsigned*)(lds + (bufoff) + ldsw + _i * 8192), 16, 0, 0); } while (0)
#define PG8_LDA(dst, b, h) do { _Pragma("unroll") for (int m = 0; m < 4; ++m) _Pragma("unroll") for (int k = 0; k < 2; ++k) dst[m][k] = *(const PG8_LAS bf16x8*)(lds + PG8_SA(b, h) + aoff + m * 2048 + k * 1024); } while (0)
#define PG8_LDB(dst, b, h) do { _Pragma("unroll") for (int n = 0; n < 2; ++n) _Pragma("unroll") for (int k = 0; k < 2; ++k) dst[n][k] = *(const PG8_LAS bf16x8*)(lds + PG8_SB(b, h) + boff + n * 2048 + k * 1024); } while (0)
#define PG8_MMA(ai, bj, At, Bt) do { __builtin_amdgcn_s_setprio(1); _Pragma("unroll") for (int m = 0; m < 4; ++m) _Pragma("unroll") for (int n = 0; n < 2; ++n) _Pragma("unroll") for (int k = 0; k < 2; ++k) \
        { if constexpr (I8) acc[ai][bj][m][n] = __builtin_bit_cast(f32x4, __builtin_amdgcn_mfma_i32_16x16x64_i8(__builtin_bit_cast(i32x4, Bt[n][k]), __builtin_bit_cast(i32x4, At[m][k]), __builtin_bit_cast(i32x4, acc[ai][bj][m][n]), 0, 0, 0)); \
          else acc[ai][bj][m][n] = __builtin_amdgcn_mfma_f32_16x16x32_bf16(Bt[n][k], At[m][k], acc[ai][bj][m][n], 0, 0, 0); } __builtin_amdgcn_s_setprio(0); } while (0)
#define PG8_WAIT_V(n) asm volatile("s_waitcnt vmcnt(" #n ")" ::: "memory")
#define PG8_WAIT_L(n) asm volatile("s_waitcnt lgkmcnt(" #n ")" ::: "memory")
#define PG8_BAR __builtin_amdgcn_s_barrier()
#define PG8_SCHED __builtin_amdgcn_sched_barrier(0)
    Unit cur, nxt; int ui = 0;
    if (!S.next(0, cur)) return;
    f32x4 acc[2][2][4][2];
#pragma unroll
    for (int a = 0; a < 2; ++a)
#pragma unroll
        for (int b = 0; b < 2; ++b)
#pragma unroll
            for (int m = 0; m < 4; ++m)
#pragma unroll
                for (int n = 0; n < 2; ++n) acc[a][b][m][n] = (f32x4){0.f, 0.f, 0.f, 0.f};
    bf16x8 At[4][2], B0[2][2], B1[2][2];
    const char* cA = (const char*)g.A + (size_t)cur.pm * tstep; const char* cB = (const char*)g.Bt + (size_t)cur.pn * tstep;
    S.a_ready(cur);
    PG8_STAGE(PG8_SB(0, 0), cB, voffB); PG8_STAGE(PG8_SA(0, 0), cA, voffA); PG8_STAGE(PG8_SB(0, 1), cB + hstep, voffB); PG8_STAGE(PG8_SA(0, 1), cA + hstep, voffA);
    if (wr == 1) PG8_BAR;
    PG8_WAIT_V(4); PG8_BAR;
    PG8_STAGE(PG8_SB(1, 0), cB + kstep, voffB); PG8_STAGE(PG8_SA(1, 0), cA + kstep, voffA); PG8_STAGE(PG8_SB(1, 1), cB + hstep + kstep, voffB);
    PG8_WAIT_V(6); PG8_BAR;
    PG8_STAMP();
    for (;;) {
        const bool has_next = S.next(ui + 1, nxt);
        const char* nA = has_next ? (const char*)g.A + (size_t)nxt.pm * tstep : cA; const char* nB = has_next ? (const char*)g.Bt + (size_t)nxt.pn * tstep : cB;
        for (int t = 0; t < nt; t += 2) {
            const bool last = (t == nt - 2);
            const char* a1 = cA + (size_t)(t + 1) * kstep;
            const char* a2 = last ? nA : cA + (size_t)(t + 2) * kstep; const char* b2 = last ? nB : cB + (size_t)(t + 2) * kstep;
            const char* a3 = a2 + kstep; const char* b3 = b2 + kstep;
            if (last && has_next) S.a_ready(nxt);
            PG8_LDB(B0, 0, 0); PG8_SCHED; PG8_LDA(At, 0, 0); PG8_STAGE(PG8_SA(1, 1), a1 + hstep, voffA);
            PG8_WAIT_L(8); PG8_BAR; PG8_WAIT_L(0); PG8_MMA(0, 0, At, B0); PG8_BAR; PG8_SCHED;
            PG8_LDB(B1, 0, 1); PG8_STAGE(PG8_SB(0, 0), b2, voffB);
            PG8_BAR; PG8_WAIT_L(0); PG8_MMA(0, 1, At, B1); PG8_BAR;
            PG8_LDA(At, 0, 1); PG8_STAGE(PG8_SA(0, 0), a2, voffA);
            PG8_BAR; PG8_WAIT_L(0); PG8_MMA(1, 0, At, B0); PG8_BAR; PG8_SCHED;
            PG8_STAGE(PG8_SB(0, 1), b2 + hstep, voffB);
            PG8_WAIT_V(6); PG8_BAR; PG8_MMA(1, 1, At, B1); PG8_BAR;
            PG8_LDB(B0, 1, 0); PG8_SCHED; PG8_LDA(At, 1, 0); PG8_STAGE(PG8_SA(0, 1), a2 + hstep, voffA);
            PG8_WAIT_L(8); PG8_BAR; PG8_WAIT_L(0); PG8_MMA(0, 0, At, B0); PG8_BAR; PG8_SCHED;
            PG8_LDB(B1, 1, 1); PG8_STAGE(PG8_SB(1, 0), b3, voffB);
            PG8_BAR; PG8_WAIT_L(0); PG8_MMA(0, 1, At, B1); PG8_BAR;
            PG8_LDA(At, 1, 1); PG8_STAGE(PG8_SA(1, 0), a3, voffA);
            PG8_BAR; PG8_WAIT_L(0); PG8_MMA(1, 0, At, B0); PG8_BAR; PG8_SCHED;
            PG8_STAGE(PG8_SB(1, 1), b3 + hstep, voffB);
            PG8_WAIT_V(6); PG8_BAR; PG8_MMA(1, 1, At, B1); PG8_BAR;
        }
        PG8_STAMP();
        if constexpr (I8) {
            const int r0_ = cur.pm * BM + wr * 64 + fr, c0_ = cur.pn * BM + wc * 32 + (Epi::PERM ? 8 * fq : 4 * fq);
#pragma unroll
            for (int bj = 0; bj < 2; ++bj)
#pragma unroll
                for (int n = 0; n < 2; ++n) { const f32x4 sbv = *(const f32x4*)(g.sb + c0_ + bj * HALF + (Epi::PERM ? 4 * n : 16 * n));
#pragma unroll
                    for (int ai = 0; ai < 2; ++ai)
#pragma unroll
                        for (int m = 0; m < 4; ++m) { const float sav = g.sa[r0_ + ai * HALF + m * 16]; const i32x4 iv = __builtin_bit_cast(i32x4, acc[ai][bj][m][n]);
                            acc[ai][bj][m][n] = (f32x4){(float)iv[0] * sav * sbv[0], (float)iv[1] * sav * sbv[1], (float)iv[2] * sav * sbv[2], (float)iv[3] * sav * sbv[3]}; } }
        }
        if constexpr (!Epi::AFTER_DRAIN) { E(acc, cur, wr, wc, fr, fq); S.done(cur); }
        PG8_STAMP();
        if (!has_next) break;
#pragma unroll
        for (int a = 0; a < 2; ++a)
#pragma unroll
            for (int b = 0; b < 2; ++b)
#pragma unroll
                for (int m = 0; m < 4; ++m)
#pragma unroll
                    for (int n = 0; n < 2; ++n) acc[a][b][m][n] = (f32x4){0.f, 0.f, 0.f, 0.f};
        cur = nxt; cA = nA; cB = nB; ++ui;
    }
    PG8_WAIT_V(0);
    if (wr == 0) PG8_BAR;
    PG8_BAR;
    if constexpr (Epi::AFTER_DRAIN) { E.fused(acc, cur, wr, wc, fr, fq, lds, wid, lane); S.done(cur); }
    PG8_STAMP();
    if (STAMP && wid == 0) { stamps[lane] = lane < nts ? (((unsigned long long)(unsigned)ts_hi << 32) | (unsigned)ts_lo) : 0ull;
        if (lane == 62) stamps[62] = rt_entry; if (lane == 63) stamps[63] = (unsigned long long)wall_clock64(); }
#undef PG8_STAMP
#undef PG8_SA
#undef PG8_SB
#undef PG8_STAGE
#undef PG8_LDA
#undef PG8_LDB
#undef PG8_MMA
#undef PG8_WAIT_V
#undef PG8_WAIT_L
#undef PG8_BAR
#undef PG8_SCHED
}
}

namespace mk {
using pg8::bf16_t; using pg8::bf16x8; using pg8::f32x4; using pg8::u32x4;
typedef float f32x16 __attribute__((ext_vector_type(16)));
typedef unsigned u32x2 __attribute__((ext_vector_type(2)));
typedef __bf16 bf16x2 __attribute__((ext_vector_type(2)));

constexpr int T = 16384, DM = 4096, SEQ = 2048, NBATCH = 8;
constexpr int A_COLS = 18432, B_COLS = 12320, B_COLS_PAD = 12544, FOXW = 12288;
constexpr float DN_ALPHA = 1.4142135623730951f;
constexpr float LN_EPS = 1e-5f;
constexpr float LOG2E = 1.4426950408889634f, LN2 = 0.6931471805599453f;
constexpr float QSCALE2 = 0.08838834764831845f * 1.4426950408889634f;

constexpr size_t MB = (size_t)1 << 20;
constexpr size_t WS_CTL = 0;
constexpr size_t WS_WIN = 1 * MB;
constexpr size_t WS_WOUT = WS_WIN + 144 * MB;
constexpr size_t WS_WQ = WS_WOUT + 32 * MB;
constexpr size_t WS_U = WS_WQ + 16 * MB;
constexpr size_t WS_V = WS_U + 128 * MB;
constexpr size_t WS_HF = WS_V + 128 * MB;
constexpr size_t WS_HB = WS_HF + 256 * MB;
constexpr size_t WS_QKV = WS_HB + 128 * MB;
constexpr size_t WS_OG = WS_QKV + 576 * MB;
constexpr size_t WS_LSE = WS_OG + 192 * MB;
constexpr size_t WS_FG = WS_LSE + 3 * MB;
constexpr size_t WS_C2 = WS_FG + 2 * MB;
constexpr size_t WS_SC = WS_C2 + 2 * MB;
constexpr size_t WS_END = WS_SC + 1 * MB;
constexpr size_t WS_A2 = WS_QKV;
constexpr size_t WS_QP = WS_QKV + 128 * MB;
constexpr size_t WS_PART = WS_QKV + 192 * MB;
constexpr size_t WS_POUT = WS_QKV + 448 * MB;
constexpr size_t WS_PIDX = WS_QKV + 704 * MB;
constexpr size_t WS_PGATE = WS_QKV + 712 * MB;
constexpr size_t WS_PW = WS_QKV + 720 * MB;
constexpr size_t WS_X8 = WS_POUT;
constexpr size_t WS_XS = WS_SC + 256 * 1024;
constexpr size_t WS_WS = WS_SC + 512 * 1024;
constexpr size_t WS_WQ8 = WS_END;
constexpr size_t WS_WIN8 = WS_END + 8 * MB;
constexpr size_t WS_WOUT8 = WS_END + 88 * MB;
constexpr size_t WS_SC2 = WS_END + 108 * MB;
constexpr size_t WS_END2 = WS_END + 110 * MB;
constexpr size_t WS_X8A = WS_HB;
constexpr size_t WS_X8B = WS_HB + 64 * MB;
constexpr size_t WS_A28 = WS_QKV;
constexpr size_t WS_OG8 = WS_QKV + 448 * MB;
static_assert(WS_PW + 8 * MB <= WS_OG + 192 * MB, "PEER scratch must fit in the q|k|v + OG regions");
constexpr int BAR_REGION_WORDS = 4096;
constexpr int MAX_LAUNCHES = 32;

constexpr int NTHREADS = 512;
constexpr int LDS_BYTES = 147456;
constexpr int LDS_BARW = LDS_BYTES - 16;

struct Ctx { LAS unsigned char* lds; int tid, lane, wave, G, bid; };

typedef float f32x2c __attribute__((ext_vector_type(2)));
__device__ __forceinline__ unsigned pk2(float lo, float hi) { const f32x2c v = {lo, hi}; const bf16x2 b = __builtin_convertvector(v, bf16x2); return __builtin_bit_cast(unsigned, b); }
__device__ __forceinline__ float bf_lo(unsigned w) { return __uint_as_float(w << 16); }
__device__ __forceinline__ float bf_hi(unsigned w) { return __uint_as_float(w & 0xffff0000u); }
template <int CTRL> __device__ __forceinline__ float dppf(float x) { return __builtin_bit_cast(float, __builtin_amdgcn_mov_dpp(__builtin_bit_cast(int, x), CTRL, 0xf, 0xf, true)); }
__device__ __forceinline__ float wave_sum(float x) {
    x += dppf<0xB1>(x); x += dppf<0x4E>(x); x += dppf<0x141>(x); x += dppf<0x128>(x);
    auto s = __builtin_amdgcn_permlane16_swap(__float_as_uint(x), __float_as_uint(x), false, false);
    x = __uint_as_float(s[0]) + __uint_as_float(s[1]);
    auto t = __builtin_amdgcn_permlane32_swap(__float_as_uint(x), __float_as_uint(x), false, false);
    return __uint_as_float(t[0]) + __uint_as_float(t[1]);
}
__device__ __forceinline__ float pair_max(float x) { auto t = __builtin_amdgcn_permlane32_swap(__float_as_uint(x), __float_as_uint(x), false, false); return fmaxf(__uint_as_float(t[0]), __uint_as_float(t[1])); }
__device__ __forceinline__ float pair_sum(float x) { auto t = __builtin_amdgcn_permlane32_swap(__float_as_uint(x), __float_as_uint(x), false, false); return __uint_as_float(t[0]) + __uint_as_float(t[1]); }
__device__ __forceinline__ int pair_maxi(int x) { auto t = __builtin_amdgcn_permlane32_swap((unsigned)x, (unsigned)x, false, false); const int a = (int)t[0], b = (int)t[1]; return a > b ? a : b; }
__device__ __forceinline__ bf16x8 pack8(float a0, float a1, float a2, float a3, float b0, float b1, float b2, float b3) {
    u32x4 w = {pk2(a0, a1), pk2(a2, a3), pk2(b0, b1), pk2(b2, b3)}; return __builtin_bit_cast(bf16x8, w);
}
__device__ __forceinline__ float dot2(unsigned a, unsigned b, float acc) { return __builtin_amdgcn_fdot2_f32_bf16(__builtin_bit_cast(bf16x2, a), __builtin_bit_cast(bf16x2, b), acc, false); }
#define MK_LDS_WAIT() asm volatile("s_waitcnt lgkmcnt(0)" ::: "memory")

__device__ __forceinline__ void transpose_weights(const Ctx& c, const float* __restrict__ W, int K, int N, bf16_t* __restrict__ WT) {
    LAS float* scr = (LAS float*)(c.lds + c.wave * 8704);
    const int lane = c.lane, nblk = N / 32, nitems = (K / 64) * nblk;
    for (int item = c.bid * 8 + c.wave; item < nitems; item += c.G * 8) {
        const int kb = item / nblk, nb = item - kb * nblk, k0 = 64 * kb, n0 = 32 * nb;
#pragma unroll 8
        for (int i = 0; i < 32; ++i) { const int kk = 2 * i + (lane >> 5); scr[kk * 33 + (lane & 31)] = W[(size_t)(k0 + kk) * N + n0 + (lane & 31)]; }
        MK_LDS_WAIT();
        const int cch = lane & 7;
#pragma unroll
        for (int j = 0; j < 4; ++j) { const int n = (lane >> 3) + 8 * j; const LAS float* s = scr + (8 * cch) * 33 + n;
            u32x4 o; o.x = pk2(s[0 * 33], s[1 * 33]); o.y = pk2(s[2 * 33], s[3 * 33]); o.z = pk2(s[4 * 33], s[5 * 33]); o.w = pk2(s[6 * 33], s[7 * 33]);
            *(u32x4*)(WT + (size_t)(n0 + n) * K + k0 + 8 * cch) = o; }
        MK_LDS_WAIT();
    }
}
__device__ __forceinline__ unsigned pack_i8x4(f32x4 a);
template <int KK>
__device__ __forceinline__ void transpose_quant(const Ctx& c, const float* __restrict__ W, int N, unsigned char* __restrict__ W8, float* __restrict__ sc, int rot) {
    constexpr int NT = KK / 512, NREG = NT < 6 ? NT : 6;
    LAS float* scr = (LAS float*)(c.lds + c.wave * 8704);
    LAS float* cmx = (LAS float*)(c.lds + 8 * 8704);
    static_assert(8 * 8704 + 1024 + 2 * 4 * 512 * 16 <= LDS_BARW, "transpose_quant LDS");
    const int nblk = N / 32;
#pragma unroll 1
    for (int nb = (c.bid - rot % c.G + c.G) % c.G; nb < nblk; nb += c.G) {
        int lane = mk_hw_lane();
        LAS u32x4* priv = (LAS u32x4*)(c.lds + 8 * 8704 + 1024) + (c.wave * 64 + lane);
        const int n0 = 32 * nb, cch = lane & 7;
        u32x4 keep[NREG][4]; float mx[4] = {0.f, 0.f, 0.f, 0.f};
        f32x4 ld[8];
#define MK_TQ_LOAD(t_) do { int k0_ = 64 * (c.wave + 8 * (t_)); asm volatile("" : "+s"(k0_)); const float* wp_ = W + (size_t)(k0_ + (lane >> 3)) * N + n0 + 4 * (lane & 7); \
            _Pragma("unroll") for (int i_ = 0; i_ < 8; ++i_) ld[i_] = *(const f32x4*)(wp_ + (size_t)(8 * i_) * N); } while (0)
        MK_TQ_LOAD(0);
#pragma unroll
        for (int t = 0; t < NT; ++t) { asm volatile("" : "+v"(lane));
#pragma unroll
            for (int i = 0; i < 8; ++i) { LAS float* d = scr + (8 * i + (lane >> 3)) * 33 + 4 * (lane & 7); d[0] = ld[i][0]; d[1] = ld[i][1]; d[2] = ld[i][2]; d[3] = ld[i][3]; }
            asm volatile("" ::: "memory");
            if (t + 1 < NT) MK_TQ_LOAD(t + 1);
            asm volatile("" ::: "memory");
            MK_LDS_WAIT();
#pragma unroll
            for (int j = 0; j < 4; ++j) { asm volatile("" ::: "memory");
                const int n = (lane >> 3) + 8 * j; const LAS float* s = scr + (8 * cch) * 33 + n;
                u32x4 o; o.x = pk2(s[0 * 33], s[1 * 33]); o.y = pk2(s[2 * 33], s[3 * 33]); o.z = pk2(s[4 * 33], s[5 * 33]); o.w = pk2(s[6 * 33], s[7 * 33]);
                if (t < NREG) keep[t < NREG ? t : 0][j] = o; else priv[((t - NREG) * 4 + j) * 512] = o;
#pragma unroll
                for (int e = 0; e < 4; ++e) mx[j] = fmaxf(mx[j], fmaxf(fabsf(bf_lo(o[e])), fabsf(bf_hi(o[e])))); }
            MK_LDS_WAIT();
        }
#undef MK_TQ_LOAD
#pragma unroll
        for (int j = 0; j < 4; ++j) { float m = mx[j]; m = fmaxf(m, dppf<0xB1>(m)); m = fmaxf(m, dppf<0x4E>(m)); m = fmaxf(m, dppf<0x141>(m));
            if (cch == 0) cmx[c.wave * 32 + (lane >> 3) + 8 * j] = m; }
        __syncthreads();
        float scale[4];
#pragma unroll
        for (int j = 0; j < 4; ++j) { const int n = (lane >> 3) + 8 * j; float m = cmx[n];
#pragma unroll
            for (int w = 1; w < 8; ++w) m = fmaxf(m, cmx[w * 32 + n]);
            const bool ok = (m > 1e-30f) && (m < 1e30f);
            scale[j] = ok ? 127.0f / m : 0.f;
            if (c.wave == 0 && cch == 0) sc[n0 + n] = ok ? m * (1.0f / 127.0f) : 0.f; }
#pragma unroll
        for (int t = 0; t < NT; ++t)
#pragma unroll
            for (int j = 0; j < 4; ++j) { u32x4 o; if (t < NREG) o = keep[t < NREG ? t : 0][j]; else o = priv[((t - NREG) * 4 + j) * 512]; asm volatile("" : "+v"(o));
                u32x2 w;
                w[0] = pack_i8x4((f32x4){bf_lo(o[0]), bf_hi(o[0]), bf_lo(o[1]), bf_hi(o[1])} * scale[j]);
                w[1] = pack_i8x4((f32x4){bf_lo(o[2]), bf_hi(o[2]), bf_lo(o[3]), bf_hi(o[3])} * scale[j]);
                *(u32x2*)(W8 + (size_t)(n0 + (lane >> 3) + 8 * j) * KK + 64 * (c.wave + 8 * t) + 8 * cch) = w; }
        __syncthreads();
    }
}
__device__ __forceinline__ int strips_for(int nblk, int rot, int G, int b) { const int r = (b - rot % G + G) % G; return nblk / G + (r < nblk % G ? 1 : 0); }
struct ConvDeal { int lo, hi, covered; };
__device__ __forceinline__ ConvDeal conv_deal(int G, int bid, int nb0, int w0, int nb1, int rot1, int w1, int nb2, int rot2, int w2, int total) {
    int cmax = 0, csum = 0, cpre = 0, mine = 0;
    int r1 = (G - rot1 % G) % G, r2 = (G - rot2 % G) % G;
    const int q0 = nb0 / G, m0 = nb0 % G, q1 = nb1 / G, m1 = nb1 % G, q2 = nb2 / G, m2 = nb2 % G;
    for (int b = 0; b < G; ++b) { const int cb = (q0 + (b < m0 ? 1 : 0)) * w0 + (q1 + (r1 < m1 ? 1 : 0)) * w1 + (q2 + (r2 < m2 ? 1 : 0)) * w2;
        cmax = cb > cmax ? cb : cmax; csum += cb; if (b < bid) cpre += cb; if (b == bid) mine = cb;
        r1 = (r1 + 1 == G) ? 0 : r1 + 1; r2 = (r2 + 1 == G) ? 0 : r2 + 1; }
    const int spare = total - (G * cmax - csum);
    ConvDeal d;
    if (spare < 0) { d.lo = 0; d.hi = 0; d.covered = 0; return d; }
    const int base = (spare / G) & ~7;
    d.lo = base * bid + (bid * cmax - cpre); d.hi = d.lo + base + (cmax - mine); d.covered = G * base + (G * cmax - csum);
    return d;
}
__device__ __forceinline__ void convert_flat(const Ctx& c, const float* __restrict__ src, bf16_t* __restrict__ dst, size_t n) {
    const size_t n8 = n / 8, stride = (size_t)c.G * NTHREADS;
    for (size_t i = (size_t)c.bid * NTHREADS + c.tid; i < n8; i += stride) {
        const f32x4 a = *(const f32x4*)(src + i * 8), b = *(const f32x4*)(src + i * 8 + 4);
        u32x4 o = {pk2(a[0], a[1]), pk2(a[2], a[3]), pk2(b[0], b[1]), pk2(b[2], b[3])};
        *(u32x4*)(dst + i * 8) = o;
    }
}
__device__ __forceinline__ void zero_flat16(const Ctx& c, void* dst, size_t bytes) {
    const size_t n = bytes / 16, stride = (size_t)c.G * NTHREADS; const u32x4 z = {0u, 0u, 0u, 0u};
    for (size_t i = (size_t)c.bid * NTHREADS + c.tid; i < n; i += stride) ((u32x4*)dst)[i] = z;
}

__device__ __forceinline__ float wave_max(float x) {
    x = fmaxf(x, dppf<0xB1>(x)); x = fmaxf(x, dppf<0x4E>(x)); x = fmaxf(x, dppf<0x141>(x)); x = fmaxf(x, dppf<0x128>(x));
    auto s = __builtin_amdgcn_permlane16_swap(__float_as_uint(x), __float_as_uint(x), false, false);
    x = fmaxf(__uint_as_float(s[0]), __uint_as_float(s[1]));
    auto t = __builtin_amdgcn_permlane32_swap(__float_as_uint(x), __float_as_uint(x), false, false);
    return fmaxf(__uint_as_float(t[0]), __uint_as_float(t[1]));
}
__device__ __forceinline__ void convert_rows_fp8(const Ctx& c, const float* __restrict__ src, unsigned char* __restrict__ dst, float* __restrict__ inv, int rows) {
    for (int row = c.bid * 8 + c.wave; row < rows; row += c.G * 8) {
        const float* rp = src + (size_t)row * DM + c.lane * 16;
        f32x4 v[16]; float mx = 0.f;
#pragma unroll
        for (int i = 0; i < 4; ++i)
#pragma unroll
            for (int q = 0; q < 4; ++q) { v[4 * i + q] = *(const f32x4*)(rp + i * 1024 + 4 * q);
                mx = fmaxf(mx, fmaxf(fmaxf(fabsf(v[4 * i + q][0]), fabsf(v[4 * i + q][1])), fmaxf(fabsf(v[4 * i + q][2]), fabsf(v[4 * i + q][3])))); }
        mx = wave_max(mx);
        const unsigned ex = (__float_as_uint(mx) >> 23) & 0xffu;
        const bool ok = (ex > 8u) && (ex < 250u);
        const float scale = ok ? __uint_as_float((261u - ex) << 23) : 1.0f, iscale = ok ? __uint_as_float((ex - 7u) << 23) : 1.0f;
        if (c.lane == 0) inv[row] = iscale;
        unsigned char* op = dst + ((size_t)(c.lane >> 3) * 16384 + row) * 128 + (c.lane & 7) * 16;
#pragma unroll
        for (int i = 0; i < 4; ++i) { u32x4 w;
#pragma unroll
            for (int q = 0; q < 4; ++q) { const f32x4 a = v[4 * i + q] * scale; int t = 0; t = __builtin_amdgcn_cvt_pk_fp8_f32(a[0], a[1], t, false); t = __builtin_amdgcn_cvt_pk_fp8_f32(a[2], a[3], t, true); w[q] = (unsigned)t; }
            *(u32x4*)(op + (size_t)i * 8 * 16384 * 128) = w; }
    }
}

__device__ __forceinline__ unsigned pack_i8x4(f32x4 a) {
    const int q0 = (int)__builtin_rintf(a[0]), q1 = (int)__builtin_rintf(a[1]), q2 = (int)__builtin_rintf(a[2]), q3 = (int)__builtin_rintf(a[3]);
    return ((unsigned)q0 & 0xffu) | (((unsigned)q1 & 0xffu) << 8) | (((unsigned)q2 & 0xffu) << 16) | ((unsigned)q3 << 24);
}
__device__ __forceinline__ void convert_rows_i8(const Ctx& c, const float* __restrict__ src, unsigned char* __restrict__ dst, float* __restrict__ inv, int row_begin, int row_end, int row_step) {
    for (int row = row_begin; row < row_end; row += row_step) {
        const float* rp = src + (size_t)row * DM + c.lane * 16;
        f32x4 v[16]; float mx = 0.f;
#pragma unroll
        for (int i = 0; i < 4; ++i)
#pragma unroll
            for (int q = 0; q < 4; ++q) { v[4 * i + q] = *(const f32x4*)(rp + i * 1024 + 4 * q);
                mx = fmaxf(mx, fmaxf(fmaxf(fabsf(v[4 * i + q][0]), fabsf(v[4 * i + q][1])), fmaxf(fabsf(v[4 * i + q][2]), fabsf(v[4 * i + q][3])))); }
        mx = wave_max(mx);
        const bool ok = (mx > 1e-30f) && (mx < 1e30f);
        const float scale = ok ? 127.0f / mx : 1.0f, iscale = ok ? mx * (1.0f / 127.0f) : 1.0f;
        if (c.lane == 0) inv[row] = iscale;
        unsigned char* op = dst + ((size_t)(c.lane >> 3) * 16384 + row) * 128 + (c.lane & 7) * 16;
#pragma unroll
        for (int i = 0; i < 4; ++i) { u32x4 w;
#pragma unroll
            for (int q = 0; q < 4; ++q) w[q] = pack_i8x4(v[4 * i + q] * scale);
            *(u32x4*)(op + (size_t)i * 8 * 16384 * 128) = w; }
    }
}

template <int KK>
__device__ __forceinline__ void quant_rows_bf16_i8(const Ctx& c, const bf16_t* __restrict__ src, unsigned char* __restrict__ dst, float* __restrict__ sc, int rows) {
    constexpr int NCH = KK / 512;
    for (int row = c.bid * 8 + c.wave; row < rows; row += c.G * 8) {
        int ln = c.lane; asm volatile("" : "+v"(ln));
        const bf16_t* rp = src + (size_t)row * KK + ln * 8;
        u32x4 v[NCH]; float mx = 0.f;
#pragma unroll
        for (int i = 0; i < NCH; ++i) { v[i] = *(const u32x4*)(rp + i * 512);
#pragma unroll
            for (int j = 0; j < 4; ++j) mx = fmaxf(mx, fmaxf(fabsf(bf_lo(v[i][j])), fabsf(bf_hi(v[i][j])))); }
        mx = wave_max(mx);
        const bool ok = (mx > 1e-30f) && (mx < 1e30f);
        const float scale = ok ? 127.0f / mx : 0.f;
        if (ln == 0) sc[row] = ok ? mx * (1.0f / 127.0f) : 0.f;
        unsigned char* op = dst + (size_t)row * KK + ln * 8;
#pragma unroll
        for (int i = 0; i < NCH; ++i) { u32x2 w;
            w[0] = pack_i8x4((f32x4){bf_lo(v[i][0]), bf_hi(v[i][0]), bf_lo(v[i][1]), bf_hi(v[i][1])} * scale);
            w[1] = pack_i8x4((f32x4){bf_lo(v[i][2]), bf_hi(v[i][2]), bf_lo(v[i][3]), bf_hi(v[i][3])} * scale);
            *(u32x2*)(op + i * 512) = w; }
    }
}

__device__ __forceinline__ void quant_rows_f32_i8(const Ctx& c, const float* __restrict__ src, unsigned char* __restrict__ dst, float* __restrict__ sc, int rows) {
    for (int row = c.bid * 8 + c.wave; row < rows; row += c.G * 8) {
        int ln = c.lane; asm volatile("" : "+v"(ln));
        const size_t off = (size_t)row * DM + 4 * ln;
        f32x4 v[16]; float mx = 0.f;
#pragma unroll
        for (int j = 0; j < 16; ++j) { v[j] = *(const f32x4*)(src + off + 256 * j); mx = fmaxf(mx, fmaxf(fmaxf(fabsf(v[j][0]), fabsf(v[j][1])), fmaxf(fabsf(v[j][2]), fabsf(v[j][3])))); }
        mx = wave_max(mx);
        const bool ok = (mx > 1e-30f) && (mx < 1e30f);
        const float scale = ok ? 127.0f / mx : 0.f;
        if (ln == 0) sc[row] = ok ? mx * (1.0f / 127.0f) : 0.f;
#pragma unroll
        for (int j = 0; j < 16; ++j) *(unsigned*)(dst + off + 256 * j) = pack_i8x4(v[j] * scale);
    }
}

__device__ __forceinline__ void ln_phase(const Ctx& c, const bf16_t* Hf, float* dst, bf16_t* Hb, const float* __restrict__ g, const float* __restrict__ b, unsigned char* X8 = nullptr, float* XS = nullptr) {
    for (int row = c.bid * 8 + c.wave; row < T; row += c.G * 8) {
        int ln = c.lane; asm volatile("" : "+v"(ln));
        const size_t off = (size_t)row * DM + 4 * ln;
        f32x4 v[16]; float s = 0.f;
#pragma unroll
        for (int j = 0; j < 16; ++j) { const u32x2 hw = *(const u32x2*)(Hf + off + 256 * j); v[j] = (f32x4){bf_lo(hw[0]), bf_hi(hw[0]), bf_lo(hw[1]), bf_hi(hw[1])}; s += (v[j][0] + v[j][1]) + (v[j][2] + v[j][3]); }
        const float mean = wave_sum(s) * (1.f / DM); float q = 0.f;
#pragma unroll
        for (int j = 0; j < 16; ++j) { v[j] = v[j] - mean; q += (v[j][0] * v[j][0] + v[j][1] * v[j][1]) + (v[j][2] * v[j][2] + v[j][3] * v[j][3]); }
        const float rstd = 1.0f / sqrtf(wave_sum(q) * (1.f / DM) + LN_EPS);
#pragma unroll
        for (int j = 0; j < 16; ++j) { if ((j & 3) == 0) asm volatile("" ::: "memory");
            const f32x4 gg = *(const f32x4*)(g + 4 * ln + 256 * j), bb = *(const f32x4*)(b + 4 * ln + 256 * j);
            const f32x4 o = v[j] * rstd * gg + bb; if (dst) *(f32x4*)(dst + off + 256 * j) = o; v[j] = o;
            if (Hb) { u32x2 w = {pk2(o[0], o[1]), pk2(o[2], o[3])}; *(u32x2*)(Hb + off + 256 * j) = w; } }
        if (X8) {
            float mx = 0.f;
#pragma unroll
            for (int j = 0; j < 16; ++j) mx = fmaxf(mx, fmaxf(fmaxf(fabsf(v[j][0]), fabsf(v[j][1])), fmaxf(fabsf(v[j][2]), fabsf(v[j][3]))));
            mx = wave_max(mx);
            const bool ok = (mx > 1e-30f) && (mx < 1e30f);
            const float scale = ok ? 127.0f / mx : 1.0f;
            if (ln == 0) XS[row] = ok ? mx * (1.0f / 127.0f) : 1.0f;
#pragma unroll
            for (int j = 0; j < 16; ++j) *(unsigned*)(X8 + off + 256 * j) = pack_i8x4(v[j] * scale);
        }
    }
}

__device__ __forceinline__ void merge_phase(const Ctx& c, const bf16_t* __restrict__ OG, const float* __restrict__ LSE, unsigned char* __restrict__ A28, float* __restrict__ SA2) {
    for (int tok = c.bid * 8 + c.wave; tok < T; tok += c.G * 8) {
        int ln = c.lane; asm volatile("" : "+v"(ln));
        float o[32]; float mx = 0.f;
#pragma unroll
        for (int j = 0; j < 4; ++j) { const int col = 8 * ln + 512 * j, head = col >> 7;
            const float l0 = LSE[(0 * (size_t)T + tok) * 16 + head], l1 = LSE[(1 * (size_t)T + tok) * 16 + head], l2 = LSE[(2 * (size_t)T + tok) * 16 + head];
            const float lm = fmaxf(l0, fmaxf(l1, l2));
            float e0 = __expf(l0 - lm), e1 = __expf(l1 - lm), e2 = __expf(l2 - lm); const float inv = 1.0f / (e0 + e1 + e2); e0 *= inv; e1 *= inv; e2 *= inv;
            const u32x4 a = *(const u32x4*)(OG + (0 * (size_t)T + tok) * 2048 + col), b = *(const u32x4*)(OG + (1 * (size_t)T + tok) * 2048 + col), d = *(const u32x4*)(OG + (2 * (size_t)T + tok) * 2048 + col);
#pragma unroll
            for (int w = 0; w < 4; ++w) { const float lo = e0 * bf_lo(a[w]) + e1 * bf_lo(b[w]) + e2 * bf_lo(d[w]), hi = e0 * bf_hi(a[w]) + e1 * bf_hi(b[w]) + e2 * bf_hi(d[w]);
                o[8 * j + 2 * w] = lo; o[8 * j + 2 * w + 1] = hi; mx = fmaxf(mx, fmaxf(fabsf(lo), fabsf(hi))); } }
        mx = wave_max(mx);
        const bool ok = (mx > 1e-30f) && (mx < 1e30f);
        const float scale = ok ? 127.0f / mx : 0.f;
        if (ln == 0) SA2[tok] = ok ? mx * (1.0f / 127.0f) : 0.f;
#pragma unroll
        for (int j = 0; j < 4; ++j) { u32x2 w;
            w[0] = pack_i8x4((f32x4){o[8 * j], o[8 * j + 1], o[8 * j + 2], o[8 * j + 3]} * scale); w[1] = pack_i8x4((f32x4){o[8 * j + 4], o[8 * j + 5], o[8 * j + 6], o[8 * j + 7]} * scale);
            *(u32x2*)(A28 + (size_t)tok * 2048 + 8 * ln + 512 * j) = w; }
    }
}

__device__ __forceinline__ void cumsum_phase(const Ctx& c, const float* __restrict__ FG, const float* __restrict__ fbias, float* __restrict__ C2, float* __restrict__ C2N) {
    LAS float* wtot = (LAS float*)c.lds;
    for (int seq = c.bid; seq < NBATCH * 32; seq += c.G) {
        const int b = seq >> 5, hd = seq & 31; const float bias = fbias[hd];
        float p[4]; float run = 0.f;
#pragma unroll
        for (int i = 0; i < 4; ++i) { const float z = FG[((size_t)b * SEQ + 4 * c.tid + i) * 32 + hd] + bias; const float lf = fminf(z, 0.f) - log1pf(__expf(-fabsf(z))); run += lf; p[i] = run; }
        float v = run;
#pragma unroll
        for (int o = 1; o < 64; o <<= 1) { const float nb = __shfl_up(v, o); if (c.lane >= o) v += nb; }
        if (c.lane == 63) wtot[c.wave] = v;
        __syncthreads();
        float woff = 0.f;
        for (int w = 0; w < c.wave; ++w) woff += wtot[w];
        const float excl = woff + v - run;
        f32x4 o = {(excl + p[0]) * LOG2E, (excl + p[1]) * LOG2E, (excl + p[2]) * LOG2E, (excl + p[3]) * LOG2E};
        *(f32x4*)(C2 + (size_t)seq * SEQ + 4 * c.tid) = o; *(f32x4*)(C2N + (size_t)seq * SEQ + 4 * c.tid) = -o;
        __syncthreads();
    }
}

constexpr float ATT_THR = 8.0f;
constexpr int KT_PITCH = 272, KT_BYTES = 64 * KT_PITCH;
constexpr int VT_PITCH = 144, VT_BYTES = 128 * VT_PITCH;
constexpr int ABUF_BYTES = KT_BYTES + VT_BYTES;
constexpr int AHALF_BYTES = 2 * ABUF_BYTES + 512;
static_assert(2 * AHALF_BYTES <= LDS_BARW, "attention LDS");

struct AttnHalf { const bf16_t* q; const bf16_t* k; const bf16_t* v; bf16_t* o; float* lse; const float* c2; const float* c2n; float sd2; };
struct AttnTile { size_t rstride, ostride, lstride; int q0, kt_lo, kt_hi; unsigned Wn; int desc; };

__device__ __forceinline__ void half_barrier(LAS unsigned* cnt, int& gen, int lane) {
    asm volatile("s_waitcnt lgkmcnt(0)" ::: "memory");
    if (lane == 0) __hip_atomic_fetch_add((unsigned*)cnt, 1u, __ATOMIC_RELAXED, __HIP_MEMORY_SCOPE_WORKGROUP);
    ++gen; const unsigned target = 4u * (unsigned)gen;
    for (unsigned spins = 0; spins < (1u << 22); ++spins) {
        const unsigned v = __hip_atomic_load((unsigned*)cnt, __ATOMIC_RELAXED, __HIP_MEMORY_SCOPE_WORKGROUP);
        if ((unsigned)__builtin_amdgcn_readfirstlane((int)v) >= target) break;
        __builtin_amdgcn_s_sleep(1);
    }
    asm volatile("s_waitcnt lgkmcnt(0)" ::: "memory");
}
constexpr int ATT_CNT_OFF = 2 * AHALF_BYTES;
static_assert(ATT_CNT_OFF + 128 <= LDS_BARW, "attention counters");
template <int MODE, int VAR = 0>
__device__ __forceinline__ void attn_tile(const Ctx& c, const AttnHalf& H, const AttnTile& A, int& gen) {
    int lane = c.lane; asm volatile("" : "+v"(lane));
    const int hw = c.wave & 3, ht = (c.wave & 3) * 64 + lane, h = lane >> 5, cc = lane & 31;
    LAS unsigned char* base = c.lds + (c.wave >> 2) * AHALF_BYTES;
    LAS unsigned* hcnt = (LAS unsigned*)(c.lds + ATT_CNT_OFF + (c.wave >> 2) * 64);
    const int qlo = A.q0 + 32 * hw, qm = qlo + cc;
    bf16x8 qf[8];
    { const bf16_t* qp = H.q + (size_t)qm * A.rstride + 8 * h;
#pragma unroll
      for (int ks = 0; ks < 8; ++ks) { const u32x4 w = *(const u32x4*)(qp + 16 * ks); u32x4 o;
#pragma unroll
          for (int j = 0; j < 4; ++j) o[j] = pk2(bf_lo(w[j]) * QSCALE2, bf_hi(w[j]) * QSCALE2);
          qf[ks] = __builtin_bit_cast(bf16x8, o); } }
    const float rowterm = MODE ? H.c2[qm] : -H.sd2 * (float)qm;
    f32x16 oacc[4];
#pragma unroll
    for (int d = 0; d < 4; ++d)
#pragma unroll
        for (int r = 0; r < 16; ++r) oacc[d][r] = 0.f;
    float m_run = 0.f, l_run = 0.f;

    u32x4 kst[4], vst[4]; float ctv = 0.f;
    const int s_key = ht >> 4, s_c16 = ht & 15;
    const int v_kq = ht & 15, v_do = ht >> 4;
    const int v_kqs = (v_kq & ~3) | ((v_kq & 1) << 1) | ((v_kq >> 1) & 1);
#define MK_ATT_LOAD(kt) do { const int k0_ = 64 * (kt); \
        _Pragma("unroll") for (int i_ = 0; i_ < 4; ++i_) kst[i_] = *(const u32x4*)(H.k + (size_t)(k0_ + s_key + 16 * i_) * A.rstride + s_c16 * 8); \
        _Pragma("unroll") for (int i_ = 0; i_ < 4; ++i_) vst[i_] = *(const u32x4*)(H.v + (size_t)(k0_ + 4 * v_kq + i_) * A.rstride + v_do * 8); \
        if (ht < 64) ctv = MODE ? H.c2n[k0_ + ht] : H.sd2 * (float)(k0_ + ht); } while (0)
#define MK_ATT_WRITE(b) do { LAS unsigned char* kb_ = base + (b) * ABUF_BYTES; LAS unsigned char* vb_ = kb_ + KT_BYTES; \
        _Pragma("unroll") for (int i_ = 0; i_ < 4; ++i_) *(LAS u32x4*)(kb_ + (s_key + 16 * i_) * KT_PITCH + s_c16 * 16) = kst[i_]; \
        _Pragma("unroll") for (int w_ = 0; w_ < 4; ++w_) { \
            u32x2 e_ = {(vst[0][w_] & 0xffffu) | (vst[1][w_] << 16), (vst[2][w_] & 0xffffu) | (vst[3][w_] << 16)}; \
            u32x2 o_ = {(vst[0][w_] >> 16) | (vst[1][w_] & 0xffff0000u), (vst[2][w_] >> 16) | (vst[3][w_] & 0xffff0000u)}; \
            *(LAS u32x2*)(vb_ + (v_do * 8 + 2 * w_) * VT_PITCH + v_kqs * 8) = e_; \
            *(LAS u32x2*)(vb_ + (v_do * 8 + 2 * w_ + 1) * VT_PITCH + v_kqs * 8) = o_; } \
        if (ht < 64) ((LAS float*)(base + 2 * ABUF_BYTES + (b) * 256))[ht] = ctv; } while (0)

#define MK_KT(t_) (A.desc ? (A.kt_hi - 1 - (t_)) : (A.kt_lo + (t_)))
    const int nt = A.kt_hi - A.kt_lo, qhi = qlo + 31;
    f32x16 s0, s1, c1;
    bf16x8 pb[4], pbn0, pbn1; float ps0 = 0.f;
#define MK_SCORE(t_) do { \
        const LAS unsigned char* kb_ = base + ((t_) & 1) * ABUF_BYTES; \
        const LAS float* ctp_ = (const LAS float*)(base + 2 * ABUF_BYTES + ((t_) & 1) * 256) + 4 * h; \
        { const float rb_ = rowterm - m_run;     \
          _Pragma("unroll") for (int q4_ = 0; q4_ < 4; ++q4_) { const f32x4 c0_ = *(const LAS f32x4*)(ctp_ + 8 * q4_), c1_ = *(const LAS f32x4*)(ctp_ + 32 + 8 * q4_); \
              _Pragma("unroll") for (int i_ = 0; i_ < 4; ++i_) { s0[4 * q4_ + i_] = rb_ + c0_[i_]; s1[4 * q4_ + i_] = rb_ + c1_[i_]; } } } \
        const LAS unsigned char* ka_ = kb_ + cc * KT_PITCH + 16 * h; \
        _Pragma("unroll") for (int ks_ = 0; ks_ < 8; ++ks_) { \
            const bf16x8 a0_ = *(const LAS bf16x8*)(ka_ + 32 * ks_), a1_ = *(const LAS bf16x8*)(ka_ + 32 * KT_PITCH + 32 * ks_); \
            s0 = __builtin_amdgcn_mfma_f32_32x32x16_bf16(a0_, qf[ks_], s0, 0, 0, 0); \
            s1 = __builtin_amdgcn_mfma_f32_32x32x16_bf16(a1_, qf[ks_], s1, 0, 0, 0); } } while (0)
#define MK_PARTIAL(t_) do { const int k0_ = 64 * MK_KT(t_); \
        const bool full_ = (k0_ + 63 <= qlo) && (MODE || (k0_ + (int)A.Wn >= qhi)); \
        if (!full_) { const int dq_ = qm - k0_ - 4 * h; const float NEG_ = -__builtin_inff(); \
            _Pragma("unroll") for (int r_ = 0; r_ < 16; ++r_) { const int ko_ = (r_ & 3) + 8 * (r_ >> 2); \
                if ((unsigned)(dq_ - ko_) > A.Wn) s0[r_] = NEG_; \
                if ((unsigned)(dq_ - ko_ - 32) > A.Wn) s1[r_] = NEG_; } } \
        float mx_ = fmaxf(s0[0], s1[0]); \
        _Pragma("unroll") for (int r_ = 1; r_ < 16; ++r_) mx_ = fmaxf(mx_, fmaxf(s0[r_], s1[r_])); \
        mx_ = pair_max(mx_); \
        if (!__all(mx_ <= ATT_THR)) {     \
            const float shift_ = (mx_ > ATT_THR) ? mx_ : 0.f, alpha_ = __builtin_amdgcn_exp2f(-shift_); \
            m_run += shift_; l_run *= alpha_; \
            _Pragma("unroll") for (int r_ = 0; r_ < 16; ++r_) { s0[r_] -= shift_; s1[r_] -= shift_; } \
            _Pragma("unroll") for (int d_ = 0; d_ < 4; ++d_) _Pragma("unroll") for (int r_ = 0; r_ < 16; ++r_) oacc[d_][r_] *= alpha_; } \
        ps0 = 0.f; \
        _Pragma("unroll") for (int r_ = 0; r_ < 16; ++r_) { s0[r_] = __builtin_amdgcn_exp2f(s0[r_]); ps0 += s0[r_]; } \
        pbn0 = pack8(s0[0], s0[1], s0[2], s0[3], s0[4], s0[5], s0[6], s0[7]); pbn1 = pack8(s0[8], s0[9], s0[10], s0[11], s0[12], s0[13], s0[14], s0[15]); \
        c1 = s1; } while (0)
#define MK_FINISH() do { float ps_ = ps0; \
        _Pragma("unroll") for (int r_ = 0; r_ < 16; ++r_) { c1[r_] = __builtin_amdgcn_exp2f(c1[r_]); ps_ += c1[r_]; } \
        l_run += ps_; pb[0] = pbn0; pb[1] = pbn1; \
        pb[2] = pack8(c1[0], c1[1], c1[2], c1[3], c1[4], c1[5], c1[6], c1[7]); pb[3] = pack8(c1[8], c1[9], c1[10], c1[11], c1[12], c1[13], c1[14], c1[15]); } while (0)
#define MK_PV(t_) do { const LAS unsigned char* va_ = base + ((t_) & 1) * ABUF_BYTES + KT_BYTES + cc * VT_PITCH + 16 * h; \
        _Pragma("unroll") for (int d_ = 0; d_ < 4; ++d_) _Pragma("unroll") for (int kk_ = 0; kk_ < 4; ++kk_) { \
            const bf16x8 a_ = *(const LAS bf16x8*)(va_ + d_ * 32 * VT_PITCH + kk_ * 32); \
            oacc[d_] = __builtin_amdgcn_mfma_f32_32x32x16_bf16(a_, pb[kk_], oacc[d_], 0, 0, 0); } } while (0)
    MK_ATT_LOAD(MK_KT(0));
    half_barrier(hcnt, gen, lane);
    MK_ATT_WRITE(0);
    half_barrier(hcnt, gen, lane);
    if (nt > 1) MK_ATT_LOAD(MK_KT(1));
    MK_SCORE(0);
    MK_PARTIAL(0);
    if (nt > 1) MK_ATT_WRITE(1);
    half_barrier(hcnt, gen, lane);
#pragma unroll 1
    for (int t = 1; t < nt; ++t) {
        const bool more = (t + 1 < nt);
        if (more) MK_ATT_LOAD(MK_KT(t + 1));
        __builtin_amdgcn_sched_barrier(0);
        MK_SCORE(t); MK_FINISH();
        __builtin_amdgcn_sched_barrier(0);
        MK_PV(t - 1); MK_PARTIAL(t);
        __builtin_amdgcn_sched_barrier(0);
        half_barrier(hcnt, gen, lane);
        if (more) MK_ATT_WRITE((t + 1) & 1);
        half_barrier(hcnt, gen, lane);
    }
    MK_FINISH();
    MK_PV(nt - 1);
#undef MK_SCORE
#undef MK_PARTIAL
#undef MK_FINISH
#undef MK_PV
#undef MK_ATT_LOAD
#undef MK_KT
#undef MK_ATT_WRITE
    const float lt = pair_sum(l_run), inv = 1.0f / lt;
    bf16_t* op = H.o + (size_t)qm * A.ostride + 8 * h;
#pragma unroll
    for (int d = 0; d < 4; ++d)
#pragma unroll
        for (int rq = 0; rq < 4; rq += 2) {
            const unsigned a0 = pk2(oacc[d][4 * rq] * inv, oacc[d][4 * rq + 1] * inv), a1 = pk2(oacc[d][4 * rq + 2] * inv, oacc[d][4 * rq + 3] * inv);
            const unsigned b0 = pk2(oacc[d][4 * rq + 4] * inv, oacc[d][4 * rq + 5] * inv), b1 = pk2(oacc[d][4 * rq + 6] * inv, oacc[d][4 * rq + 7] * inv);
            auto r0 = __builtin_amdgcn_permlane32_swap(a0, b0, false, false); auto r1 = __builtin_amdgcn_permlane32_swap(a1, b1, false, false);
            u32x4 w = {r0[0], r1[0], r0[1], r1[1]};
            *(u32x4*)(op + 32 * d + 8 * rq) = w;
        }
    if (MODE == 0 && h == 0) H.lse[(size_t)qm * A.lstride] = (m_run + log2f(lt)) * LN2;
}

__device__ __forceinline__ void dil_attn_phase(const Ctx& c, const bf16_t* QKV, bf16_t* OG, float* LSE) {
    const int hf = c.wave >> 2; int gen = 0;
    if (c.tid < 32) ((LAS unsigned*)(c.lds + ATT_CNT_OFF))[c.tid] = 0u;
    __syncthreads();
    if (hf) { for (int i = 0; i < 12; ++i) __builtin_amdgcn_s_sleep(127); }
#pragma unroll 1
    for (int it = c.bid; it < NBATCH * 3 * 8 * 16; it += c.G) {
        const int rq = (it + (it >> 8)) & 15, hp = (it >> 4) & 7, rest = it >> 7, g = rest % 3, b = rest / 3;
        const int dil = (g == 0) ? 1 : (g == 1 ? 4 : 16), ntile = 16 / dil, r = rq / ntile, qt = rq - r * ntile;
        const int head = 2 * hp + hf;
        const size_t row0 = (size_t)b * SEQ + r;
        AttnHalf H; AttnTile A;
        const bf16_t* base = QKV + row0 * A_COLS + g * 6144 + head * 128;
        H.q = base; H.k = base + 2048; H.v = base + 4096;
        H.o = OG + ((size_t)g * T + row0) * 2048 + head * 128;
        H.lse = LSE + ((size_t)g * T + row0) * 16 + head;
        H.c2 = nullptr; H.c2n = nullptr;
        H.sd2 = exp2f(-0.5f * (float)(head + 1)) * (float)dil * LOG2E;
        A.rstride = (size_t)dil * A_COLS; A.ostride = (size_t)dil * 2048; A.lstride = (size_t)dil * 16;
        A.q0 = 128 * qt; A.kt_lo = qt ? (2 * qt - 2) : 0; A.kt_hi = 2 * qt + 2; A.Wn = 128u; A.desc = 0;
        attn_tile<0>(c, H, A, gen);
    }
    __syncthreads();
}
template <int VAR = 0>
__device__ __forceinline__ void fox_attn_phase(const Ctx& c, const bf16_t* QKV, const float* C2, const float* C2N, bf16_t* O, bool xmode, int xx, int xr) {
    const int hf = c.wave >> 2; int gen = 0;
    if (c.tid < 32) ((LAS unsigned*)(c.lds + ATT_CNT_OFF))[c.tid] = 0u;
    __syncthreads();
    if (hf) { for (int i = 0; i < 12; ++i) __builtin_amdgcn_s_sleep(127); }
#pragma unroll 1
    for (int n = 0;; ++n) {
        const int i = n >> 1; int it;
        if (xmode) { if (i >= 4) break; it = ((xx * 4 + (xr >> 3)) + 32 * i) * 8 + (xr & 7); }
        else { it = c.bid + i * c.G; if (it >= NBATCH * 16 * 8) break; }
        const int x0 = it & 7, hp = (it >> 3) & 15, b = it >> 7;
        const int x = (n & 1) ? 15 - x0 : x0;
        const int head = 2 * hp + hf;
        const size_t row0 = (size_t)b * SEQ;
        AttnHalf H; AttnTile A;
        const bf16_t* base = QKV + row0 * FOXW + head * 128;
        H.q = base; H.k = base + 4096; H.v = base + 8192;
        H.o = O + row0 * 4096 + head * 128; H.lse = nullptr; H.c2 = C2 + ((size_t)b * 32 + head) * SEQ; H.c2n = C2N + ((size_t)b * 32 + head) * SEQ; H.sd2 = 0.f;
        A.rstride = FOXW; A.ostride = 4096; A.lstride = 0; A.Wn = 0x7fffffffu; A.kt_lo = 0;
        A.q0 = 128 * x; A.kt_hi = 2 * x + 2; A.desc = (n & 1);
        attn_tile<1, VAR>(c, H, A, gen);
    }
    __syncthreads();
}

template <bool F32BASE>
struct EpiRes {
    static constexpr bool PERM = true, AFTER_DRAIN = false;
    const void* base; bf16_t* C; int ldc; float alpha;
    __device__ __forceinline__ void operator()(const f32x4 (&acc)[2][2][4][2], const pg8::Unit& u, int wr, int wc, int fr, int fq) const {
        const int row0 = u.pm * 256 + wr * 64 + fr, col0 = u.pn * 256 + wc * 32 + 8 * fq;
#pragma unroll
        for (int ai = 0; ai < 2; ++ai)
#pragma unroll
            for (int m = 0; m < 4; ++m) { const size_t off = (size_t)(row0 + ai * 128 + m * 16) * ldc + col0;
#pragma unroll
                for (int bj = 0; bj < 2; ++bj) { f32x4 b0, b1;
                    if (F32BASE) { b0 = *(const f32x4*)((const float*)base + off + bj * 128); b1 = *(const f32x4*)((const float*)base + off + bj * 128 + 4); }
                    else { const u32x4 w = *(const u32x4*)((const bf16_t*)base + off + bj * 128); b0 = (f32x4){bf_lo(w[0]), bf_hi(w[0]), bf_lo(w[1]), bf_hi(w[1])}; b1 = (f32x4){bf_lo(w[2]), bf_hi(w[2]), bf_lo(w[3]), bf_hi(w[3])}; }
                    const f32x4 o0 = b0 * alpha + acc[ai][bj][m][0], o1 = b1 * alpha + acc[ai][bj][m][1];
                    u32x4 w = {pk2(o0[0], o0[1]), pk2(o0[2], o0[3]), pk2(o1[0], o1[1]), pk2(o1[2], o1[3])};
                    *(u32x4*)(C + off + bj * 128) = w; } }
    }
};
struct EpiFox {
    static constexpr bool PERM = true, AFTER_DRAIN = false;
    bf16_t* O; float* FG;
    __device__ __forceinline__ void operator()(const f32x4 (&acc)[2][2][4][2], const pg8::Unit& u, int wr, int wc, int fr, int fq) const {
        const int row0 = u.pm * 256 + wr * 64 + fr;
        if (u.pn < 48) {
            const int col0 = u.pn * 256 + wc * 32 + 8 * fq;
#pragma unroll
            for (int ai = 0; ai < 2; ++ai)
#pragma unroll
                for (int m = 0; m < 4; ++m) { bf16_t* rowp = O + (size_t)(row0 + ai * 128 + m * 16) * FOXW + col0;
#pragma unroll
                    for (int bj = 0; bj < 2; ++bj) { const f32x4 v0 = acc[ai][bj][m][0], v1 = acc[ai][bj][m][1];
                        u32x4 w = {pk2(v0[0], v0[1]), pk2(v0[2], v0[3]), pk2(v1[0], v1[1]), pk2(v1[2], v1[3])};
                        *(u32x4*)(rowp + bj * 128) = w; } }
        } else if (wc == 0) {
#pragma unroll
            for (int ai = 0; ai < 2; ++ai)
#pragma unroll
                for (int m = 0; m < 4; ++m) { float* rowp = FG + (size_t)(row0 + ai * 128 + m * 16) * 32 + 8 * fq;
                    *(f32x4*)(rowp) = acc[ai][0][m][0]; *(f32x4*)(rowp + 4) = acc[ai][0][m][1]; }
        }
    }
};

constexpr int SK_PITCH = 272, SK_BYTES = 2 * 128 * SK_PITCH;
constexpr int SEL_IDX_OFF = SK_BYTES, SEL_GATE_OFF = SEL_IDX_OFF + 32 * 128 * 4, WBUF_OFF = SEL_GATE_OFF + 32 * 128 * 4, PEER_LDS_END = WBUF_OFF + 8 * 128 * 4;
static_assert(PEER_LDS_END <= LDS_BARW, "peer LDS");
struct CandTab { int i[50], j[50]; };
__host__ __device__ constexpr CandTab make_cand() { CandTab t{}; int s = 0; for (int i = 0; i < 16; ++i) for (int j = 0; j < 16; ++j) if ((i + 1) * (j + 1) <= 16) { t.i[s] = i; t.j[s] = j; ++s; } return t; }
__device__ __forceinline__ int f2ord(float f) { const int b = __float_as_int(f); return b ^ ((b >> 31) & 0x7fffffff); }
__device__ __forceinline__ float ord2f(int o) { return __int_as_float(o ^ ((o >> 31) & 0x7fffffff)); }
__device__ __forceinline__ float gelu_exact(float v) { return 0.5f * v * (1.0f + erff(v * 0.70710678118654752f)); }

#define MK_CE(a, b) do { const int hi_ = (a) > (b) ? (a) : (b), lo_ = (a) > (b) ? (b) : (a); (a) = hi_; (b) = lo_; } while (0)
template <int BASE> __device__ __forceinline__ void sort16_desc(int (&v)[64]) {
#pragma unroll
    for (int k = 2; k <= 16; k <<= 1)
#pragma unroll
        for (int j = k >> 1; j > 0; j >>= 1)
#pragma unroll
            for (int i = 0; i < 16; ++i) { const int l = i ^ j; if (l > i) { if ((i & k) == 0) MK_CE(v[BASE + i], v[BASE + l]); else MK_CE(v[BASE + l], v[BASE + i]); } }
}
template <int A, int B> __device__ __forceinline__ void merge_top16(int (&v)[64]) {
#pragma unroll
    for (int i = 0; i < 16; ++i) v[A + i] = v[A + i] > v[B + 15 - i] ? v[A + i] : v[B + 15 - i];
#pragma unroll
    for (int j = 8; j > 0; j >>= 1)
#pragma unroll
        for (int i = 0; i < 16; ++i) { const int l = i ^ j; if (l > i) MK_CE(v[A + i], v[A + l]); }
}
__device__ __forceinline__ void top16_of_64(int (&v)[64]) {
    sort16_desc<0>(v); sort16_desc<16>(v); sort16_desc<32>(v); sort16_desc<48>(v);
    merge_top16<0, 16>(v); merge_top16<32, 48>(v); merge_top16<0, 32>(v);
}
constexpr int LTAB_OFF = WBUF_OFF + 8 * 128 * 4, PEER_LDS_END2 = LTAB_OFF + 8 * 32 * 32;
static_assert(PEER_LDS_END2 <= LDS_BARW, "peer LDS 2");

__device__ __forceinline__ void peer_select(const Ctx& c, const bf16_t* __restrict__ QP, int tok0, unsigned short* __restrict__ IDXg, float* __restrict__ GATEg) {
    int lane = c.lane; asm volatile("" : "+v"(lane));
    const int h = lane >> 5, cc = lane & 31, head = c.wave;
    const bf16_t* qrow = QP + (size_t)(tok0 + cc) * 2048 + head * 256 + 8 * h;
    int L[2][16];
#pragma unroll
    for (int p = 0; p < 2; ++p) {
        bf16x8 qf[8];
#pragma unroll
        for (int ks = 0; ks < 8; ++ks) qf[ks] = *(const bf16x8*)(qrow + p * 128 + 16 * ks);
        f32x16 acc[4];
#pragma unroll
        for (int kb = 0; kb < 4; ++kb)
#pragma unroll
            for (int r = 0; r < 16; ++r) acc[kb][r] = 0.f;
        const LAS unsigned char* ska = c.lds + p * (128 * SK_PITCH) + cc * SK_PITCH + 16 * h;
#pragma unroll
        for (int kb = 0; kb < 4; ++kb)
#pragma unroll
            for (int ks = 0; ks < 8; ++ks) { const bf16x8 a = *(const LAS bf16x8*)(ska + kb * 32 * SK_PITCH + 32 * ks); acc[kb] = __builtin_amdgcn_mfma_f32_32x32x16_bf16(a, qf[ks], acc[kb], 0, 0, 0); }
        int pk[64];
#pragma unroll
        for (int kb = 0; kb < 4; ++kb)
#pragma unroll
            for (int r = 0; r < 16; ++r) { const int n = 32 * kb + (r & 3) + 8 * (r >> 2); pk[16 * kb + r] = (f2ord(acc[kb][r]) & ~127) | (127 - n - 4 * h); }
        top16_of_64(pk);
        int lo16[16], up16[16];
#pragma unroll
        for (int i = 0; i < 16; ++i) { auto t = __builtin_amdgcn_permlane32_swap((unsigned)pk[i], (unsigned)pk[i], false, false); lo16[i] = (int)t[0]; up16[i] = (int)t[1]; }
#pragma unroll
        for (int i = 0; i < 16; ++i) L[p][i] = lo16[i] > up16[15 - i] ? lo16[i] : up16[15 - i];
#pragma unroll
        for (int j = 8; j > 0; j >>= 1)
#pragma unroll
            for (int i = 0; i < 16; ++i) { const int l = i ^ j; if (l > i) MK_CE(L[p][i], L[p][l]); }
    }
    LAS unsigned char* tab = c.lds + LTAB_OFF + (c.wave * 32 + cc) * 32;
    if (h == 0) {
        u32x4 w0, w1;
#pragma unroll
        for (int q4 = 0; q4 < 4; ++q4) {
            w0[q4] = (unsigned)(127 - (L[0][4 * q4] & 127)) | ((unsigned)(127 - (L[0][4 * q4 + 1] & 127)) << 8) | ((unsigned)(127 - (L[0][4 * q4 + 2] & 127)) << 16) | ((unsigned)(127 - (L[0][4 * q4 + 3] & 127)) << 24);
            w1[q4] = (unsigned)(127 - (L[1][4 * q4] & 127)) | ((unsigned)(127 - (L[1][4 * q4 + 1] & 127)) << 8) | ((unsigned)(127 - (L[1][4 * q4 + 2] & 127)) << 16) | ((unsigned)(127 - (L[1][4 * q4 + 3] & 127)) << 24); }
        *(LAS u32x4*)(tab) = w0; *(LAS u32x4*)(tab + 16) = w1;
    }
    constexpr CandTab CT = make_cand();
    int pk2v[64];
#pragma unroll
    for (int s = 0; s < 64; ++s) {
        if (s < 50) { const int i = CT.i[s], j = CT.j[s];
            const float sum = ord2f(L[0][i] & ~127) + ord2f(L[1][j] & ~127);
            pk2v[s] = (f2ord(sum) & ~255) | (255 - (16 * i + j)); }
        else pk2v[s] = (int)0x80000000;
    }
    top16_of_64(pk2v);
    MK_LDS_WAIT();
    float tops[16]; int eidx[16];
#pragma unroll
    for (int it = 0; it < 16; ++it) { const int code = 255 - (pk2v[it] & 255); tops[it] = ord2f(pk2v[it] & ~255);
        eidx[it] = (int)tab[code >> 4] * 128 + (int)tab[16 + (code & 15)]; }
    { const float t0 = tops[0]; float den = 0.f;
#pragma unroll
      for (int it = 0; it < 16; ++it) { tops[it] = __expf(tops[it] - t0); den += tops[it]; }
      const float rden = 1.0f / den;
#pragma unroll
      for (int it = 0; it < 16; ++it) tops[it] *= rden; }
    unsigned short* si = IDXg + (size_t)(tok0 + cc) * 128 + head * 16;
    float* sg = GATEg + (size_t)(tok0 + cc) * 128 + head * 16;
    if (h == 0) {
        u32x4 w0, w1;
#pragma unroll
        for (int q4 = 0; q4 < 4; ++q4) { w0[q4] = (unsigned)eidx[2 * q4] | ((unsigned)eidx[2 * q4 + 1] << 16); w1[q4] = (unsigned)eidx[8 + 2 * q4] | ((unsigned)eidx[8 + 2 * q4 + 1] << 16); }
        *(u32x4*)(si) = w0; *(u32x4*)(si + 8) = w1;
    } else {
#pragma unroll
        for (int q4 = 0; q4 < 4; ++q4) { f32x4 w = {tops[4 * q4], tops[4 * q4 + 1], tops[4 * q4 + 2], tops[4 * q4 + 3]}; *(f32x4*)(sg + 4 * q4) = w; }
    }
}

typedef float f32x2 __attribute__((ext_vector_type(2)));
constexpr int NSLICE = 32, TOKBLK = 512;
#define MK_P_LOAD_ROWS(R, tl, Tb) do { const u32x4 j0_ = *(const LAS u32x4*)(ilds + (tl) * 256), j1_ = *(const LAS u32x4*)(ilds + (tl) * 256 + 16); \
        _Pragma("unroll") for (int w_ = 0; w_ < 4; ++w_) { R[2 * w_] = *(const u32x4*)((Tb) + (size_t)(j0_[w_] & 0xffffu) * 128); R[2 * w_ + 1] = *(const u32x4*)((Tb) + (size_t)(j0_[w_] >> 16) * 128); \
                                                           R[8 + 2 * w_] = *(const u32x4*)((Tb) + (size_t)(j1_[w_] & 0xffffu) * 128); R[8 + 2 * w_ + 1] = *(const u32x4*)((Tb) + (size_t)(j1_[w_] >> 16) * 128); } } while (0)
#define MK_P_FILL_IDX() do { const u32x4* src_ = (const u32x4*)(IDX + (size_t)tok0 * 128) + lane; LAS u32x4* dl_ = (LAS u32x4*)(c.lds + c.wave * 16384) + lane; \
        u32x4 tmp_[16]; _Pragma("unroll") for (int i_ = 0; i_ < 16; ++i_) tmp_[i_] = src_[64 * i_]; \
        _Pragma("unroll") for (int i_ = 0; i_ < 16; ++i_) dl_[64 * i_] = tmp_[i_]; MK_LDS_WAIT(); } while (0)

__device__ __forceinline__ void peer_pass1_unit(const Ctx& c, int slice, int tok0, const unsigned char* __restrict__ Us, const unsigned short* __restrict__ IDX, const unsigned char* __restrict__ X8, unsigned* __restrict__ PART, bool fill) {
    int lane = c.lane; asm volatile("" : "+v"(lane));
    const int p = lane >> 3, q = lane & 7;
    const unsigned char* Tb = Us + (size_t)slice * 16384 * 128 + q * 16;
    const LAS unsigned char* ilds = c.lds + c.wave * 16384 + p * 32;
    const unsigned char* xp = X8 + (size_t)tok0 * DM + slice * 128 + 16 * q;
    unsigned* pp = PART + ((size_t)slice * T + tok0) * 64 + 8 * p + q;
    if (fill) MK_P_FILL_IDX();
    u32x4 XA[2], XB[2], RA[16], RB[16];
#define MK_P1_LOAD_X(X, t) do { X[0] = *(const u32x4*)(xp + (size_t)(t) * DM); X[1] = *(const u32x4*)(xp + (size_t)((t) + 1) * DM); } while (0)
#define MK_P1_COMPUTE(R, Xv, t) do { int r_[16]; \
        _Pragma("unroll") for (int i_ = 0; i_ < 16; ++i_) { int a_ = 0; \
            _Pragma("unroll") for (int w_ = 0; w_ < 4; ++w_) a_ = __builtin_amdgcn_sdot4((int)R[i_][w_], (int)Xv[w_], a_, false); \
            a_ += __builtin_amdgcn_mov_dpp(a_, 0xB1, 0xf, 0xf, true); a_ += __builtin_amdgcn_mov_dpp(a_, 0x4E, 0xf, 0xf, true); a_ += __builtin_amdgcn_mov_dpp(a_, 0x141, 0xf, 0xf, true); r_[i_] = a_; } \
        int v0_ = r_[0], v1_ = r_[1]; \
        _Pragma("unroll") for (int i_ = 1; i_ < 8; ++i_) { v0_ = (q == i_) ? r_[2 * i_] : v0_; v1_ = (q == i_) ? r_[2 * i_ + 1] : v1_; } \
        pp[(size_t)(t) * 64] = pk2((float)v0_, (float)v1_); } while (0)
    constexpr int NT = TOKBLK / 8;
    MK_P1_LOAD_X(XA, 0);
    MK_P_LOAD_ROWS(RA, 0, Tb);
#pragma unroll 1
    for (int t = 0; t < NT; t += 4) {
        MK_P1_LOAD_X(XB, t + 2);
        MK_P_LOAD_ROWS(RB, t + 1, Tb); MK_P1_COMPUTE(RA, XA[0], t);
        MK_P_LOAD_ROWS(RA, t + 2, Tb); MK_P1_COMPUTE(RB, XA[1], t + 1);
        if (t + 4 < NT) MK_P1_LOAD_X(XA, t + 4);
        MK_P_LOAD_ROWS(RB, t + 3, Tb); MK_P1_COMPUTE(RA, XB[0], t + 2);
        if (t + 4 < NT) MK_P_LOAD_ROWS(RA, t + 4, Tb);
        MK_P1_COMPUTE(RB, XB[1], t + 3);
    }
#undef MK_P1_LOAD_X
#undef MK_P1_COMPUTE
}
__device__ __forceinline__ void peer_pass2_unit(const Ctx& c, int slice, int tok0, const unsigned char* __restrict__ Vs, const unsigned short* __restrict__ IDX, const unsigned char* __restrict__ W8, const float* __restrict__ WS, unsigned* __restrict__ OUT, bool fill) {
    int lane = c.lane; asm volatile("" : "+v"(lane));
    const int p = lane >> 3, q = lane & 7;
    const unsigned char* Tb = Vs + (size_t)slice * 16384 * 128 + q * 16;
    const LAS unsigned char* ilds = c.lds + c.wave * 16384 + p * 32;
    const unsigned char* wp = W8 + (size_t)tok0 * 128 + 16 * p;
    const float* wsp = WS + tok0;
    unsigned* op = OUT + (size_t)tok0 * (DM / 2) + slice * 64 + 8 * q + p;
    const bool b3 = (lane & 8) != 0;
    if (fill) MK_P_FILL_IDX();
    u32x4 WA[2], WB[2], RA[16], RB[16]; float SA[2], SB[2];
#define MK_P2_LOAD_W(Wt, St, t) do { Wt[0] = *(const u32x4*)(wp + (size_t)(t) * 128); Wt[1] = *(const u32x4*)(wp + (size_t)((t) + 1) * 128); St[0] = wsp[(t)]; St[1] = wsp[(t) + 1]; } while (0)
#define MK_P2_COMPUTE(R, Wv, sc, t) do { int acc_[16]; \
        _Pragma("unroll") for (int m_ = 0; m_ < 16; ++m_) acc_[m_] = 0; \
        _Pragma("unroll") for (int g_ = 0; g_ < 4; ++g_) { const int wq_ = (int)Wv[g_];     \
            _Pragma("unroll") for (int w_ = 0; w_ < 4; ++w_) { const unsigned a_ = R[4 * g_][w_], b_ = R[4 * g_ + 1][w_], c_ = R[4 * g_ + 2][w_], d_ = R[4 * g_ + 3][w_]; \
                const unsigned p0_ = __builtin_amdgcn_perm(b_, a_, 0x05010400u), p1_ = __builtin_amdgcn_perm(b_, a_, 0x07030602u), p2_ = __builtin_amdgcn_perm(d_, c_, 0x05010400u), p3_ = __builtin_amdgcn_perm(d_, c_, 0x07030602u); \
                acc_[4 * w_ + 0] = __builtin_amdgcn_sdot4((int)__builtin_amdgcn_perm(p2_, p0_, 0x05040100u), wq_, acc_[4 * w_ + 0], false); \
                acc_[4 * w_ + 1] = __builtin_amdgcn_sdot4((int)__builtin_amdgcn_perm(p2_, p0_, 0x07060302u), wq_, acc_[4 * w_ + 1], false); \
                acc_[4 * w_ + 2] = __builtin_amdgcn_sdot4((int)__builtin_amdgcn_perm(p3_, p1_, 0x05040100u), wq_, acc_[4 * w_ + 2], false); \
                acc_[4 * w_ + 3] = __builtin_amdgcn_sdot4((int)__builtin_amdgcn_perm(p3_, p1_, 0x07060302u), wq_, acc_[4 * w_ + 3], false); } } \
          \
        int u_[8]; _Pragma("unroll") for (int i_ = 0; i_ < 8; ++i_) { auto s_ = __builtin_amdgcn_permlane32_swap((unsigned)acc_[i_], (unsigned)acc_[i_ + 8], false, false); u_[i_] = (int)s_[0] + (int)s_[1]; } \
        int t_[4]; _Pragma("unroll") for (int i_ = 0; i_ < 4; ++i_) { auto s_ = __builtin_amdgcn_permlane16_swap((unsigned)u_[i_], (unsigned)u_[i_ + 4], false, false); t_[i_] = (int)s_[0] + (int)s_[1]; } \
        const int k0_ = b3 ? t_[2] : t_[0], s0_ = b3 ? t_[0] : t_[2], k1_ = b3 ? t_[3] : t_[1], s1_ = b3 ? t_[1] : t_[3]; \
        const int rx_ = k0_ + __builtin_amdgcn_mov_dpp(s0_, 0x128, 0xf, 0xf, true), ry_ = k1_ + __builtin_amdgcn_mov_dpp(s1_, 0x128, 0xf, 0xf, true); \
        op[(size_t)(t) * (DM / 2)] = pk2((float)rx_ * (sc), (float)ry_ * (sc)); } while (0)
    constexpr int NT = TOKBLK / 8;
    MK_P2_LOAD_W(WA, SA, 0);
    MK_P_LOAD_ROWS(RA, 0, Tb);
#pragma unroll 1
    for (int t = 0; t < NT; t += 4) {
        MK_P2_LOAD_W(WB, SB, t + 2);
        MK_P_LOAD_ROWS(RB, t + 1, Tb); MK_P2_COMPUTE(RA, WA[0], SA[0], t);
        MK_P_LOAD_ROWS(RA, t + 2, Tb); MK_P2_COMPUTE(RB, WA[1], SA[1], t + 1);
        if (t + 4 < NT) MK_P2_LOAD_W(WA, SA, t + 4);
        MK_P_LOAD_ROWS(RB, t + 3, Tb); MK_P2_COMPUTE(RA, WB[0], SB[0], t + 2);
        if (t + 4 < NT) MK_P_LOAD_ROWS(RA, t + 4, Tb);
        MK_P2_COMPUTE(RB, WB[1], SB[1], t + 3);
    }
#undef MK_P2_LOAD_W
#undef MK_P2_COMPUTE
}
#undef MK_P_LOAD_ROWS
#undef MK_P_FILL_IDX

struct PeerDeal { bool xcd_mode; int x, r; };
__device__ __forceinline__ int deal_xcd(const PeerDeal& d) { return d.x; }
__device__ __forceinline__ int deal_rank(const PeerDeal& d) { return d.r; }
__device__ __forceinline__ PeerDeal peer_deal(const Ctx& c, unsigned* xc, unsigned myx, unsigned myrank, bool census_done) {
    bool ok = census_done && (c.G == 256);
#pragma unroll
    for (int j = 0; j < 16; ++j) { const unsigned n = __hip_atomic_load(xc + j, __ATOMIC_RELAXED, __HIP_MEMORY_SCOPE_AGENT); ok = ok && (n == ((j < 8) ? 32u : 0u)); }
    PeerDeal d; d.xcd_mode = ok && myx < 8u && myrank < 32u; d.x = (int)myx; d.r = (int)myrank; return d;
}
template <int PASS>
__device__ __forceinline__ void peer_pass_phase(const Ctx& c, const PeerDeal& d, const unsigned char* Ts, const unsigned short* IDX, const unsigned char* X8, const unsigned char* W8, const float* WS, void* DST) {
#pragma unroll 1
    for (int i = 0;; ++i) {
        int slice, blk;
        if (d.xcd_mode) { if (i >= 4) break; slice = d.x + 8 * i; blk = d.r; }
        else { const int u = c.bid + i * c.G; if (u >= NSLICE * (T / TOKBLK)) break; slice = u / (T / TOKBLK); blk = u % (T / TOKBLK); }
        const int tok0 = blk * TOKBLK + c.wave * (TOKBLK / 8);
        const bool fill = !(d.xcd_mode && i > 0);
        if (PASS == 1) peer_pass1_unit(c, slice, tok0, Ts, IDX, X8, (unsigned*)DST, fill); else peer_pass2_unit(c, slice, tok0, Ts, IDX, W8, WS, (unsigned*)DST, fill);
    }
}
__device__ __forceinline__ void peer_act_phase(const Ctx& c, const unsigned* __restrict__ PART, const unsigned short* __restrict__ IDX, const float* __restrict__ GATE, const float* __restrict__ SU, const float* __restrict__ SV, const float* __restrict__ XS, unsigned short* __restrict__ W8, float* __restrict__ WS) {
    const size_t n2 = (size_t)T * 64, stride = (size_t)c.G * NTHREADS;
    for (size_t id = (size_t)c.bid * NTHREADS + c.tid; id < n2; id += stride) {
        float s0 = 0.f, s1 = 0.f;
#pragma unroll 8
        for (int j = 0; j < NSLICE; ++j) { const unsigned w = PART[(size_t)j * n2 + id]; s0 += bf_lo(w); s1 += bf_hi(w); }
        const unsigned ee = *(const unsigned*)(IDX + 2 * id); const unsigned e0 = ee & 0xffffu, e1 = ee >> 16;
        const float g0 = GATE[2 * id], g1 = GATE[2 * id + 1];
        const size_t tok = id >> 6; const float xs = XS[tok];
        const float w0 = g0 * gelu_exact(s0 * SU[e0] * xs) * SV[e0], w1 = g1 * gelu_exact(s1 * SU[e1] * xs) * SV[e1];
        const float mx = wave_max(fmaxf(fabsf(w0), fabsf(w1)));
        const bool ok = (mx > 1e-30f) && (mx < 1e30f);
        const float scale = ok ? 127.0f / mx : 0.f;
        if (c.lane == 0) WS[tok] = ok ? mx * (1.0f / 127.0f) : 0.f;
        const int q0 = (int)__builtin_rintf(w0 * scale), q1 = (int)__builtin_rintf(w1 * scale);
        W8[id] = (unsigned short)(((unsigned)q0 & 0xffu) | (((unsigned)q1 & 0xffu) << 8));
    }
}
__device__ __forceinline__ void ln_add_phase(const Ctx& c, const bf16_t* Y, const float* __restrict__ g1, const float* __restrict__ b1, const bf16_t* __restrict__ ADD, float* dst, bf16_t* Hb, const float* __restrict__ g, const float* __restrict__ b, unsigned char* X8 = nullptr, float* XS = nullptr) {
    for (int row = c.bid * 8 + c.wave; row < T; row += c.G * 8) {
        int ln = c.lane; asm volatile("" : "+v"(ln));
        const size_t off = (size_t)row * DM + 4 * ln;
        f32x4 v[16]; float s = 0.f;
#pragma unroll
        for (int j = 0; j < 16; ++j) { const u32x2 hw = *(const u32x2*)(Y + off + 256 * j); v[j] = (f32x4){bf_lo(hw[0]), bf_hi(hw[0]), bf_lo(hw[1]), bf_hi(hw[1])}; s += (v[j][0] + v[j][1]) + (v[j][2] + v[j][3]); }
        float mean = wave_sum(s) * (1.f / DM), qq = 0.f;
#pragma unroll
        for (int j = 0; j < 16; ++j) { v[j] = v[j] - mean; qq += (v[j][0] * v[j][0] + v[j][1] * v[j][1]) + (v[j][2] * v[j][2] + v[j][3] * v[j][3]); }
        float rstd = 1.0f / sqrtf(wave_sum(qq) * (1.f / DM) + LN_EPS);
        s = 0.f;
#pragma unroll
        for (int j = 0; j < 16; ++j) { if ((j & 1) == 0) asm volatile("" ::: "memory");
            const f32x4 gg = *(const f32x4*)(g1 + 4 * ln + 256 * j), bb = *(const f32x4*)(b1 + 4 * ln + 256 * j);
            const u32x2 aw = *(const u32x2*)(ADD + off + 256 * j); const f32x4 av = {bf_lo(aw[0]), bf_hi(aw[0]), bf_lo(aw[1]), bf_hi(aw[1])};
            v[j] = (v[j] * rstd * gg + bb) * DN_ALPHA + av; s += (v[j][0] + v[j][1]) + (v[j][2] + v[j][3]); }
        mean = wave_sum(s) * (1.f / DM); qq = 0.f;
#pragma unroll
        for (int j = 0; j < 16; ++j) { v[j] = v[j] - mean; qq += (v[j][0] * v[j][0] + v[j][1] * v[j][1]) + (v[j][2] * v[j][2] + v[j][3] * v[j][3]); }
        rstd = 1.0f / sqrtf(wave_sum(qq) * (1.f / DM) + LN_EPS);
#pragma unroll
        for (int j = 0; j < 16; ++j) { if ((j & 1) == 0) asm volatile("" ::: "memory");
            const f32x4 gg = *(const f32x4*)(g + 4 * ln + 256 * j), bb = *(const f32x4*)(b + 4 * ln + 256 * j);
            const f32x4 o = v[j] * rstd * gg + bb; if (dst) *(f32x4*)(dst + off + 256 * j) = o; v[j] = o;
            if (Hb) { u32x2 w = {pk2(o[0], o[1]), pk2(o[2], o[3])}; *(u32x2*)(Hb + off + 256 * j) = w; } }
        if (X8) {
            float mx = 0.f;
#pragma unroll
            for (int j = 0; j < 16; ++j) mx = fmaxf(mx, fmaxf(fmaxf(fabsf(v[j][0]), fabsf(v[j][1])), fmaxf(fabsf(v[j][2]), fabsf(v[j][3]))));
            mx = wave_max(mx);
            const bool ok = (mx > 1e-30f) && (mx < 1e30f);
            const float scale = ok ? 127.0f / mx : 0.f;
            if (ln == 0) XS[row] = ok ? mx * (1.0f / 127.0f) : 0.f;
#pragma unroll
            for (int j = 0; j < 16; ++j) *(unsigned*)(X8 + off + 256 * j) = pack_i8x4(v[j] * scale);
        }
    }
}

__device__ __forceinline__ void peer_select_phase(const Ctx& c, const bf16_t* QP, const float* __restrict__ subk, unsigned short* IDXg, float* GATEg) {
    for (int i = c.tid; i < 2 * 128 * 16; i += NTHREADS) { const int row = i >> 4, ch = i & 15;
        const f32x4 a = *(const f32x4*)(subk + row * 128 + ch * 8), bq = *(const f32x4*)(subk + row * 128 + ch * 8 + 4);
        u32x4 w = {pk2(a[0], a[1]), pk2(a[2], a[3]), pk2(bq[0], bq[1]), pk2(bq[2], bq[3])};
        *(LAS u32x4*)(c.lds + row * SK_PITCH + ch * 16) = w; }
    __syncthreads();
#pragma unroll 1
    for (int unit = c.bid; unit < T / 32; unit += c.G) peer_select(c, QP, unit * 32, IDXg, GATEg);
    __syncthreads();
}

constexpr int NPHASES = 27;
struct Args { const float* in[14]; float* out; unsigned char* ws; int ph_lo, ph_hi, li, pad; };

__global__ void __launch_bounds__(NTHREADS, 2) mk_fwd(Args args) {
    extern __shared__ __attribute__((aligned(16))) unsigned char lds_raw[];
    Ctx c; c.lds = (LAS unsigned char*)lds_raw; c.wave = __builtin_amdgcn_readfirstlane((int)(threadIdx.x >> 6)); c.G = gridDim.x; c.bid = blockIdx.x; c.lane = mk_hw_lane(); c.tid = c.wave * 64 + c.lane;
#define RELANE() do { c.lane = mk_hw_lane(); c.tid = c.wave * 64 + c.lane; } while (0)
    if (c.tid < 4) ((LAS unsigned*)(c.lds + LDS_BARW))[c.tid] = 0u;
    __syncthreads();
    unsigned char* ws = args.ws;
    XcdBarrier bar = xcd_barrier_post((unsigned*)(ws + WS_CTL) + (size_t)args.li * BAR_REGION_WORDS, (volatile LAS unsigned*)(c.lds + LDS_BARW), c.wave);
    const int lo = args.ph_lo, hi = args.ph_hi; const int rep_ = 1; (void)rep_;
#ifndef MK_ONLY
#define MK_ONLY -1
#endif
#define IN(k) ((MK_ONLY < 0 || MK_ONLY == (k)) && lo <= (k) && (k) < hi)
#define SEAM(k) do { if (IN((k) + 1) && !((MK_DUP == (k) || MK_DUP2 == (k)) && rep_ == 0)) xcd_barrier(bar); } while (0)
#ifndef MK_DUP
#define MK_DUP -1
#endif
#ifndef MK_DUPS
#define MK_DUPS -1
#endif
#ifndef MK_FOXVAR
#define MK_FOXVAR 0
#endif
#ifndef MK_DUP2
#define MK_DUP2 -1
#endif
#define REP(k) for (int rep_ = 0; rep_ < ((MK_DUP == (k) || MK_DUP2 == (k)) ? 2 : 1); ++rep_)
#define INP(k) ([&]() { int k_ = (k); asm volatile("" : "+s"(k_)); return args.in[k_]; }())
#define x INP(0)
#define a_w_in INP(1)
#define a_w_out INP(2)
#define b_w_in INP(3)
#define b_f_bias INP(4)
#define b_w_out INP(5)
#define peer_w_q INP(6)
#define peer_sk INP(7)
#define peer_u INP(8)
#define peer_v INP(9)
#define ln_mix_g INP(10)
#define ln_mix_b INP(11)
#define ln_ffn_g INP(12)
#define ln_ffn_b INP(13)
    bf16_t* W_IN = (bf16_t*)(ws + WS_WIN); bf16_t* W_OUT = (bf16_t*)(ws + WS_WOUT); bf16_t* W_Q = (bf16_t*)(ws + WS_WQ); unsigned char* UB = ws + WS_U; unsigned char* VB = ws + WS_V; float* SU = (float*)(ws + WS_SC); float* SV = SU + 16384;
    bf16_t* HF = (bf16_t*)(ws + WS_HF);     bf16_t* HB = (bf16_t*)(ws + WS_HB); bf16_t* QKV = (bf16_t*)(ws + WS_QKV); bf16_t* OG = (bf16_t*)(ws + WS_OG);
    float* LSE = (float*)(ws + WS_LSE); float* FG = (float*)(ws + WS_FG); float* C2 = (float*)(ws + WS_C2); bf16_t* A2 = (bf16_t*)(ws + WS_A2); bf16_t* QP = (bf16_t*)(ws + WS_QP);
    const size_t EU = (size_t)16384 * DM;

    unsigned* XC = (unsigned*)(ws + WS_CTL) + (MAX_LAUNCHES * BAR_REGION_WORDS) + (size_t)args.li * 64;
    const unsigned myx = xb_xcc_id(); unsigned myrank = 0;
    { unsigned r0 = 0; if (c.tid == 0) r0 = __hip_atomic_fetch_add(XC + myx, 1u, __ATOMIC_RELAXED, __HIP_MEMORY_SCOPE_AGENT); myrank = (unsigned)__builtin_amdgcn_readfirstlane((int)r0); }
    if (c.tid == 0) ((LAS unsigned*)(c.lds + LDS_BARW))[2] = myrank;
    __syncthreads();
    myrank = (unsigned)__builtin_amdgcn_readfirstlane((int)((LAS unsigned*)(c.lds + LDS_BARW))[2]);
    unsigned short* PIDX = (unsigned short*)(ws + WS_PIDX); float* PGATE = (float*)(ws + WS_PGATE); unsigned short* PW = (unsigned short*)(ws + WS_PW); float* WSC = (float*)(ws + WS_WS); unsigned char* WQ8 = ws + WS_WQ8; unsigned* PART = (unsigned*)(ws + WS_PART); bf16_t* POUT = (bf16_t*)(ws + WS_POUT); unsigned char* X8 = ws + WS_X8; float* XS = (float*)(ws + WS_XS);

    unsigned char* WIN8 = ws + WS_WIN8; unsigned char* WOUT8 = ws + WS_WOUT8; unsigned char* X8A = ws + WS_X8A; unsigned char* X8B = ws + WS_X8B; unsigned char* A28 = ws + WS_A28; unsigned char* OG8 = ws + WS_OG8;
    float* SBIN = (float*)(ws + WS_SC2); float* SBOUT = SBIN + 32768; float* SBQ = SBOUT + 8192; float* XSA = SBQ + 8192; float* XSB = XSA + 16384; float* SA2 = XSB + 16384; float* SOG = SA2 + 16384;

    if (IN(0)) { RELANE();
        const int r1 = (A_COLS / 32) % c.G, r2 = (A_COLS / 32 + DM / 32) % c.G;
        transpose_quant<4096>(c, a_w_in, A_COLS, WIN8, SBIN, 0); transpose_quant<2048>(c, a_w_out, DM, WOUT8, SBOUT, r1); transpose_quant<4096>(c, peer_w_q, 2048, WQ8, SBQ, r2);
        RELANE();
        const ConvDeal cd = conv_deal(c.G, c.bid, A_COLS / 32, 32, DM / 32, r1, 16, 2048 / 32, r2, 32, 16384);
        convert_rows_i8(c, peer_u, UB, SU, cd.lo + c.wave, cd.hi, 8); convert_rows_i8(c, peer_u, UB, SU, cd.covered + c.bid * 8 + c.wave, 16384, c.G * 8);
        convert_rows_i8(c, peer_v, VB, SV, c.bid * 8 + c.wave, 16384, c.G * 8); quant_rows_f32_i8(c, x, X8A, XSA, T);
        SEAM(0);
    }
    if (IN(2)) { RELANE();
        pg8::Gemm g{(const bf16_t*)X8A, (const bf16_t*)WIN8, T, A_COLS, DM / 2, c.wave, XSA, SBIN}; pg8::StaticOrder S; S.init(T, A_COLS, c.G, c.bid);
        pg8::EpiBf16<0> E{QKV, A_COLS, nullptr, 0, 0};
        pg8::gemm_phase<pg8::EpiBf16<0>, pg8::StaticOrder, false, true>(c.lds, g, S, E, nullptr);
        SEAM(2);
    }
    if (IN(3)) { RELANE(); dil_attn_phase(c, QKV, OG, LSE); SEAM(3); }
    if (IN(4)) { RELANE(); merge_phase(c, OG, LSE, A28, SA2); SEAM(4); }
    if (IN(5)) { RELANE();
        pg8::Gemm g{(const bf16_t*)A28, (const bf16_t*)WOUT8, T, DM, 2048 / 2, c.wave, SA2, SBOUT}; pg8::StaticOrder S; S.init(T, DM, c.G, c.bid);
        EpiRes<true> E{x, HF, DM, DN_ALPHA};
        pg8::gemm_phase<EpiRes<true>, pg8::StaticOrder, false, true>(c.lds, g, S, E, nullptr);
        SEAM(5);
    }
    if (IN(6)) { RELANE(); ln_phase(c, HF, nullptr, nullptr, ln_mix_g, ln_mix_b, X8, XS); SEAM(6);     }
    if (IN(7)) { RELANE();
        pg8::Gemm g{(const bf16_t*)X8, (const bf16_t*)WQ8, T, 2048, DM / 2, c.wave, XS, SBQ}; pg8::StaticOrder S; S.init(T, 2048, c.G, c.bid);
        pg8::EpiBf16<0> E{QP, 2048, nullptr, 0, 0};
        pg8::gemm_phase<pg8::EpiBf16<0>, pg8::StaticOrder, false, true>(c.lds, g, S, E, nullptr);
        SEAM(7);
    }
    if (IN(8)) { RELANE(); peer_select_phase(c, QP, peer_sk, PIDX, PGATE); SEAM(8); }
    if (IN(9)) { RELANE(); const PeerDeal d = peer_deal(c, XC, myx, myrank, IN(8)); peer_pass_phase<1>(c, d, UB, PIDX, X8, nullptr, nullptr, PART);
#if MK_DUPS == 9
        peer_pass_phase<1>(c, d, UB, PIDX, X8, nullptr, nullptr, PART);
#endif
        SEAM(9); }
    if (IN(10)) { RELANE(); peer_act_phase(c, PART, PIDX, PGATE, SU, SV, XS, PW, WSC); SEAM(10); }
    if (IN(11)) { RELANE(); const PeerDeal d = peer_deal(c, XC, myx, myrank, IN(10)); peer_pass_phase<2>(c, d, VB, PIDX, nullptr, (const unsigned char*)PW, WSC, POUT);
#if MK_DUPS == 11
        peer_pass_phase<2>(c, d, VB, PIDX, nullptr, (const unsigned char*)PW, WSC, POUT);
#endif
        SEAM(11); }
    if (IN(12)) { RELANE(); ln_add_phase(c, HF, ln_mix_g, ln_mix_b, POUT, nullptr, HF, ln_ffn_g, ln_ffn_b, X8B, XSB);   }
    if (IN(13)) { RELANE();
        const int r1 = (B_COLS / 32) % c.G, r2 = (B_COLS / 32 + DM / 32) % c.G;
        transpose_quant<4096>(c, b_w_in, B_COLS, WIN8, SBIN, 0); transpose_quant<4096>(c, b_w_out, DM, WOUT8, SBOUT, r1); transpose_quant<4096>(c, peer_w_q + (size_t)DM * 2048, 2048, WQ8, SBQ, r2);
        RELANE();
        zero_flat16(c, WIN8 + (size_t)B_COLS * DM, (size_t)(B_COLS_PAD - B_COLS) * DM);
        for (int i = c.bid * NTHREADS + c.tid; i < B_COLS_PAD - B_COLS; i += c.G * NTHREADS) SBIN[B_COLS + i] = 0.f;
        const ConvDeal cd = conv_deal(c.G, c.bid, B_COLS / 32, 32, DM / 32, r1, 32, 2048 / 32, r2, 32, 16384);
        convert_rows_i8(c, peer_u + EU, UB, SU, cd.lo + c.wave, cd.hi, 8); convert_rows_i8(c, peer_u + EU, UB, SU, cd.covered + c.bid * 8 + c.wave, 16384, c.G * 8);
        convert_rows_i8(c, peer_v + EU, VB, SV, c.bid * 8 + c.wave, 16384, c.G * 8);
        SEAM(13);
    }
    if (IN(15)) { RELANE();
        pg8::Gemm g{(const bf16_t*)X8B, (const bf16_t*)WIN8, T, B_COLS_PAD, DM / 2, c.wave, XSB, SBIN}; pg8::StaticOrder S; S.init(T, B_COLS_PAD, c.G, c.bid);
        EpiFox E{QKV, FG};
        pg8::gemm_phase<EpiFox, pg8::StaticOrder, false, true>(c.lds, g, S, E, nullptr);
        SEAM(15);
    }
    if (IN(16)) { RELANE(); cumsum_phase(c, FG, b_f_bias, C2, LSE  ); SEAM(16); }
    if (IN(17)) { RELANE(); const PeerDeal d = peer_deal(c, XC, myx, myrank, IN(16));
#if MK_DUPS == 17
        fox_attn_phase<MK_FOXVAR>(c, QKV, C2, LSE, OG, d.xcd_mode, deal_xcd(d), deal_rank(d));
#endif
        fox_attn_phase<0>(c, QKV, C2, LSE, OG, d.xcd_mode, deal_xcd(d), deal_rank(d));
        SEAM(17); }
    if (IN(18)) { RELANE(); quant_rows_bf16_i8<4096>(c, OG, OG8, SOG, T); SEAM(18); }
    if (IN(19)) { RELANE();
        pg8::Gemm g{(const bf16_t*)OG8, (const bf16_t*)WOUT8, T, DM, DM / 2, c.wave, SOG, SBOUT}; pg8::StaticOrder S; S.init(T, DM, c.G, c.bid);
        EpiRes<false> E{HF, HF, DM, DN_ALPHA};
        pg8::gemm_phase<EpiRes<false>, pg8::StaticOrder, false, true>(c.lds, g, S, E, nullptr);
        SEAM(19);
    }
    if (IN(20)) { RELANE(); ln_phase(c, HF, nullptr, nullptr, ln_mix_g + DM, ln_mix_b + DM, X8, XS); SEAM(20); }
    if (IN(21)) { RELANE();
        pg8::Gemm g{(const bf16_t*)X8, (const bf16_t*)WQ8, T, 2048, DM / 2, c.wave, XS, SBQ}; pg8::StaticOrder S; S.init(T, 2048, c.G, c.bid);
        pg8::EpiBf16<0> E{QP, 2048, nullptr, 0, 0};
        pg8::gemm_phase<pg8::EpiBf16<0>, pg8::StaticOrder, false, true>(c.lds, g, S, E, nullptr);
        SEAM(21);
    }
    if (IN(22)) { RELANE(); peer_select_phase(c, QP, peer_sk + 2 * 128 * 128, PIDX, PGATE); SEAM(22); }
    if (IN(23)) { RELANE(); const PeerDeal d = peer_deal(c, XC, myx, myrank, IN(22)); peer_pass_phase<1>(c, d, UB, PIDX, X8, nullptr, nullptr, PART); SEAM(23); }
    if (IN(24)) { RELANE(); peer_act_phase(c, PART, PIDX, PGATE, SU, SV, XS, PW, WSC); SEAM(24); }
    if (IN(25)) { RELANE(); const PeerDeal d = peer_deal(c, XC, myx, myrank, IN(24)); peer_pass_phase<2>(c, d, VB, PIDX, nullptr, (const unsigned char*)PW, WSC, POUT); SEAM(25); }
    if (IN(26)) { RELANE(); ln_add_phase(c, HF, ln_mix_g + DM, ln_mix_b + DM, POUT, args.out, nullptr, ln_ffn_g + DM, ln_ffn_b + DM); }
#undef IN
#undef SEAM
#undef x
#undef a_w_in
#undef a_w_out
#undef b_w_in
#undef b_f_bias
#undef b_w_out
#undef peer_w_q
#undef peer_sk
#undef peer_u
#undef peer_v
#undef ln_mix_g
#undef ln_mix_b
#undef ln_ffn_g
#undef ln_ffn_b
#undef INP
}
}

extern "C" void kernel_launch(void* const* d_in, const int* in_sizes, int n_in, void* d_out, int out_size, void* d_ws, size_t ws_size, hipStream_t stream) {
    using namespace mk;
    static int grid = 0;
    if (grid == 0) {
        if (n_in != 14 || out_size != T * DM || ws_size < WS_END2) { fprintf(stderr, "kernel_launch: unexpected shapes (n_in %d out %d ws %zu need %zu); nothing launched\n", n_in, out_size, ws_size, (size_t)WS_END2); grid = -1; return; }
        int dev = 0, cus = 0, per_cu = 0;
        if (hipGetDevice(&dev) != hipSuccess || hipDeviceGetAttribute(&cus, hipDeviceAttributeMultiprocessorCount, dev) != hipSuccess) { grid = -1; return; }
        if (hipFuncSetAttribute((const void*)mk_fwd, hipFuncAttributeMaxDynamicSharedMemorySize, LDS_BYTES) != hipSuccess) { fprintf(stderr, "kernel_launch: hipFuncSetAttribute failed\n"); grid = -1; return; }
        if (hipOccupancyMaxActiveBlocksPerMultiprocessor(&per_cu, (const void*)mk_fwd, NTHREADS, LDS_BYTES) != hipSuccess || per_cu < 1) { fprintf(stderr, "kernel_launch: occupancy query says %d\n", per_cu); per_cu = 1; }
        (void)hipGetLastError();
        grid = cus;
    }
    if (grid < 0) return;
    if (hipMemsetAsync((char*)d_ws + WS_CTL, 0, (size_t)MAX_LAUNCHES * BAR_REGION_WORDS * 4 + MAX_LAUNCHES * 256, stream) != hipSuccess) return;
    Args a{};
    for (int i = 0; i < 14; ++i) a.in[i] = (const float*)d_in[i];
    a.out = (float*)d_out; a.ws = (unsigned char*)d_ws; a.pad = 0;
#if MK_N_LAUNCHES == 1
    a.ph_lo = 0; a.ph_hi = NPHASES; a.li = 0;
    hipLaunchKernelGGL(mk_fwd, dim3(grid), dim3(NTHREADS), LDS_BYTES, stream, a);
#else
    for (int p = 0; p < NPHASES; ++p) { a.ph_lo = p; a.ph_hi = p + 1; a.li = p; hipLaunchKernelGGL(mk_fwd, dim3(grid), dim3(NTHREADS), LDS_BYTES, stream, a); }
#endif
}
```

```cpp
#include <hip/hip_runtime.h>
#include <cstdio>
#include <cstdint>
#ifndef MK_N_LAUNCHES
#define MK_N_LAUNCHES 1
#endif
__device__ __forceinline__ int mk_hw_lane() { int l; asm volatile("v_mbcnt_lo_u32_b32 %0, -1, 0\n\tv_mbcnt_hi_u32_b32 %0, -1, %0" : "=v"(l)); return l; }

#define XB_TMO      128
#define XB_XCNT(j)  (256  + 64 * (j))
#define XB_XSUB(j)  (1280 + 64 * (j))
#define XB_XGEN(j)  (2304 + 64 * (j))
#define XB_TOP      3328
#define XB_TOPGEN   3392
#define XCD_BAR_WORDS 3456
#define XB_SPIN_CAP (1u << 18)
#define LAS __attribute__((address_space(3)))

__device__ __forceinline__ unsigned xb_ld(unsigned* p)              { return __hip_atomic_load(p, __ATOMIC_RELAXED, __HIP_MEMORY_SCOPE_AGENT); }
__device__ __forceinline__ unsigned xb_add(unsigned* p, unsigned v) { return __hip_atomic_fetch_add(p, v, __ATOMIC_RELAXED, __HIP_MEMORY_SCOPE_AGENT); }
__device__ __forceinline__ unsigned xb_xcc_id() { return (unsigned)__builtin_amdgcn_s_getreg((3 << 11) | 20) & 0xFu; }
#define XB_SPIN(cond, bar) do { unsigned _sp = 0; while (cond) { __builtin_amdgcn_s_sleep(1); \
    if ((++_sp & 255u) == 0u) { if (xb_ld(&(bar)[XB_TMO])) break; if (_sp > XB_SPIN_CAP) { atomicAdd(&(bar)[XB_TMO], 1u); break; } } } } while (0)

struct XcdBarrier {
    unsigned* bar; unsigned x; int wave;
    volatile LAS unsigned* st;
};

__device__ __forceinline__ XcdBarrier xcd_barrier_post(unsigned* bar, volatile LAS unsigned* st, int wave) {
    XcdBarrier b; b.bar = bar; b.x = xb_xcc_id(); b.st = st; b.wave = wave;
    if (wave == 0 && mk_hw_lane() == 0) (void)xb_add(&bar[XB_XCNT(b.x)], 1u);
    return b;
}
__device__ __forceinline__ void xcd_barrier_complete(unsigned* bar, unsigned x, unsigned& nloc, unsigned& nx) {
    const unsigned G = gridDim.x * gridDim.y * gridDim.z;
    unsigned sum, cnt, mine, sp = 0u;
    for (;;) {
        sum = 0u; cnt = 0u; mine = 0u;
#pragma unroll
        for (unsigned j = 0; j < 16; ++j) { const unsigned c = xb_ld(&bar[XB_XCNT(j)]); sum += c; cnt += (c > 0u) ? 1u : 0u; mine = (j == x) ? c : mine; }
        if (sum == G) break;
        __builtin_amdgcn_s_sleep(1);
        if ((++sp & 255u) == 0u) { if (xb_ld(&bar[XB_TMO])) break; if (sp > XB_SPIN_CAP) { atomicAdd(&bar[XB_TMO], 1u); break; } }
    }
    nloc = mine > 0u ? mine : 1u; nx = cnt > 0u ? cnt : 1u;
}

__device__ __forceinline__ void xcd_barrier(const XcdBarrier& b) {
    asm volatile("s_waitcnt vmcnt(0)" ::: "memory");
    __syncthreads();
    if (b.wave == 0 && mk_hw_lane() == 0) {
        unsigned* bar = b.bar;
        __builtin_amdgcn_s_waitcnt(0);
        unsigned nloc = b.st[0], nx = b.st[1];
        if (nloc == 0u) { xcd_barrier_complete(bar, b.x, nloc, nx); b.st[0] = nloc; b.st[1] = nx; }
        const unsigned old = xb_add(&bar[XB_XSUB(b.x)], 1u);
        const unsigned gen = old / nloc;
        if (old + 1u == (gen + 1u) * nloc) {
            __builtin_amdgcn_fence(__ATOMIC_RELEASE, "agent");
            asm volatile("s_waitcnt vmcnt(0)" ::: "memory");
            const unsigned og = xb_add(&bar[XB_TOP], 1u);
            const unsigned tg = og / nx;
            if (og + 1u == (tg + 1u) * nx) xb_add(&bar[XB_TOPGEN], 1u);
            else XB_SPIN(xb_ld(&bar[XB_TOPGEN]) == tg, bar);
            __builtin_amdgcn_fence(__ATOMIC_ACQUIRE, "agent");
            xb_add(&bar[XB_XGEN(b.x)], 1u);
            asm volatile("s_waitcnt vmcnt(0)" ::: "memory");
        } else {
            XB_SPIN(xb_ld(&bar[XB_XGEN(b.x)]) == gen, bar);
            __builtin_amdgcn_fence(__ATOMIC_ACQUIRE, "agent");
            asm volatile("s_waitcnt vmcnt(0)" ::: "memory");
        }
    }
    __syncthreads();
}

namespace pg8 {
#define PG8_LAS __attribute__((address_space(3)))
typedef unsigned short bf16_t;
typedef short bf16x8 __attribute__((ext_vector_type(8)));
typedef float f32x4 __attribute__((ext_vector_type(4)));
typedef unsigned u32x4 __attribute__((ext_vector_type(4)));
constexpr int BM = 256, BK = 64, HALF = 128, HTB = HALF * BK * 2  , STAGE_BYTES = 8 * HTB, NXCD = 8, WGM = 8;

__host__ __device__ __forceinline__ int lds_byte(int r, int c) { const int st = (r >> 4) * 2 + (c >> 5), rr = r & 15, cc = c & 31, ob = rr * 64 + cc * 2; return st * 1024 + (ob ^ (((ob >> 9) & 1) << 5)); }
__host__ __device__ __forceinline__ void stage_rc(int b, int& R, int& C) { const int st = b / 1024, sb = b % 1024, swz = sb ^ (((sb >> 9) & 1) << 5); R = (st >> 1) * 16 + swz / 64; C = (st & 1) * 32 + (swz % 64) / 2; }
__host__ __device__ __forceinline__ int perm32(int rho) { const int n = rho >> 4, i = rho & 15; return 8 * (i >> 2) + 4 * n + (i & 3); }

struct Unit { int pm, pn; };
struct Gemm { const bf16_t* A; const bf16_t* Bt; int M, N, K, wave; const float* sa; const float* sb; };

struct StaticOrder {
    int nM, nN, nwg, G, c;
    __host__ __device__ void init(int M, int N, int G_, int c_) { nM = M / BM; nN = N / BM; nwg = nM * nN; G = G_; c = c_; }
    __host__ __device__ bool next(int i, Unit& u) const {
        const long L = (long)i * G + c; if (L >= nwg) return false;
        int wgid = (int)L; { const int q = nwg / NXCD, r = nwg % NXCD, xcd = wgid % NXCD, off = wgid / NXCD; wgid = (xcd < r ? xcd * (q + 1) : r * (q + 1) + (xcd - r) * q) + off; }
        const int nig = WGM * nN, gid = wgid / nig, fm = gid * WGM, gsz = (nM - fm) < WGM ? (nM - fm) : WGM;
        u.pm = fm + ((wgid % nig) % gsz); u.pn = (wgid % nig) / gsz; return true;
    }
    __device__ __forceinline__ void a_ready(const Unit&) const {}
    __device__ __forceinline__ void done(const Unit&) const {}
};
struct CountedOrder : StaticOrder {
    const unsigned* ready; unsigned need; unsigned* tmo;
    __device__ __forceinline__ void a_ready(const Unit& u) const {
        if (threadIdx.x < 64) {
            const unsigned long long t0 = __builtin_amdgcn_s_memrealtime(); unsigned polls = 0;
            while ((unsigned)__builtin_amdgcn_readfirstlane(__hip_atomic_load(ready + 64 * u.pm, __ATOMIC_RELAXED, __HIP_MEMORY_SCOPE_AGENT)) < need) {
                if ((++polls & 255u) == 0u && __builtin_amdgcn_readfirstlane(__hip_atomic_load(tmo, __ATOMIC_RELAXED, __HIP_MEMORY_SCOPE_AGENT)) != 0u) break;
                if (__builtin_amdgcn_s_memrealtime() - t0 > 2000000ull) {
                    if (threadIdx.x == 0) { unsigned expect = 0u; __hip_atomic_compare_exchange_strong(tmo + 1, &expect, 0x600u | (unsigned)(u.pm & 0xff), __ATOMIC_RELAXED, __ATOMIC_RELAXED, __HIP_MEMORY_SCOPE_AGENT); __hip_atomic_store(tmo, 1u, __ATOMIC_RELAXED, __HIP_MEMORY_SCOPE_AGENT); }
                    break; }
                __builtin_amdgcn_s_sleep(2); }
            __builtin_amdgcn_fence(__ATOMIC_ACQUIRE, "agent");
            asm volatile("s_waitcnt vmcnt(0)" ::: "memory");
        }
#if !defined(BROKEN_HOOK_NO_BARRIER)
        asm volatile("" ::: "memory"); __builtin_amdgcn_s_barrier(); asm volatile("" ::: "memory");
#endif
    }
};

__device__ __forceinline__ unsigned cvt_pk_bf16(float lo, float hi) { unsigned r; asm volatile("v_cvt_pk_bf16_f32 %0, %1, %2" : "=v"(r) : "v"(lo), "v"(hi)); return r; }
typedef float f32x2 __attribute__((ext_vector_type(2)));
__device__ __forceinline__ f32x2 gelu_pk(f32x2 v) {
    const f32x2 av = __builtin_elementwise_abs(v), d = av * 0.2316418882f + 1.0f;
    f32x2 t; t.x = __builtin_amdgcn_rcpf(d.x); t.y = __builtin_amdgcn_rcpf(d.y);
    f32x2 q = t * 0.5307027145f + (-0.7265760135f); q = q * t + 0.7107068705f; q = q * t + (-0.142248368f); q = q * t + 0.127414796f; q = q * t;
    const f32x2 s = (v * v) * (-0.72134752044f);
    f32x2 e; e.x = __builtin_amdgcn_exp2f(s.x); e.y = __builtin_amdgcn_exp2f(s.y);
    const f32x2 m = v * (q * e), r = v - m;
    f32x2 o; o.x = v.x < 0.f ? m.x : r.x; o.y = v.y < 0.f ? m.y : r.y; return o;
}

struct EpiF32 {
    static constexpr bool PERM = false, AFTER_DRAIN = false;
    float* C; int ldc; const float* bias;
    __device__ __forceinline__ void operator()(const f32x4 (&acc)[2][2][4][2], const Unit& u, int wr, int wc, int fr, int fq) const {
        const int row0 = u.pm * BM + wr * 64 + fr, col0 = u.pn * BM + wc * 32 + 4 * fq;
        f32x4 bv[2][2];
#pragma unroll
        for (int bj = 0; bj < 2; ++bj)
#pragma unroll
            for (int n = 0; n < 2; ++n) bv[bj][n] = bias ? *(const f32x4*)(bias + col0 + bj * HALF + n * 16) : (f32x4){0.f, 0.f, 0.f, 0.f};
#pragma unroll
        for (int ai = 0; ai < 2; ++ai)
#pragma unroll
            for (int m = 0; m < 4; ++m) { float* rowp = C + (size_t)(row0 + ai * HALF + m * 16) * ldc + col0;
#pragma unroll
                for (int bj = 0; bj < 2; ++bj)
#pragma unroll
                    for (int n = 0; n < 2; ++n) *(f32x4*)(rowp + bj * HALF + n * 16) = acc[ai][bj][m][n] + bv[bj][n]; }
    }
};
template <int ACT  > struct EpiBf16 {
    static constexpr bool PERM = true, AFTER_DRAIN = false;
    bf16_t* O; int ldc; const float* bias; int split_cols; size_t split_stride;
    __device__ __forceinline__ void operator()(const f32x4 (&acc)[2][2][4][2], const Unit& u, int wr, int wc, int fr, int fq) const {
        const int row0 = u.pm * BM + wr * 64 + fr; int colt = u.pn * BM; bf16_t* base = O;
        if (split_cols) { const int t = colt / split_cols; base += (size_t)t * split_stride; colt -= t * split_cols; }
        const int col0 = colt + wc * 32 + 8 * fq, bcol0 = u.pn * BM + wc * 32 + 8 * fq;
        f32x4 bv[2][2];
#pragma unroll
        for (int bj = 0; bj < 2; ++bj)
#pragma unroll
            for (int n = 0; n < 2; ++n) bv[bj][n] = bias ? *(const f32x4*)(bias + bcol0 + bj * HALF + 4 * n) : (f32x4){0.f, 0.f, 0.f, 0.f};
#pragma unroll
        for (int ai = 0; ai < 2; ++ai)
#pragma unroll
            for (int m = 0; m < 4; ++m) { bf16_t* rowp = base + (size_t)(row0 + ai * HALF + m * 16) * ldc + col0;
#pragma unroll
                for (int bj = 0; bj < 2; ++bj) { f32x4 v0 = acc[ai][bj][m][0] + bv[bj][0], v1 = acc[ai][bj][m][1] + bv[bj][1];
                    if (ACT == 1) { f32x2 a = gelu_pk((f32x2){v0[0], v0[1]}), b = gelu_pk((f32x2){v0[2], v0[3]}), c = gelu_pk((f32x2){v1[0], v1[1]}), d = gelu_pk((f32x2){v1[2], v1[3]});
                        v0 = (f32x4){a.x, a.y, b.x, b.y}; v1 = (f32x4){c.x, c.y, d.x, d.y}; }
                    if (ACT == 2) {
#pragma unroll
                        for (int j = 0; j < 4; ++j) { v0[j] = 0.5f * v0[j] * (1.0f + erff(v0[j] * 0.70710678f)); v1[j] = 0.5f * v1[j] * (1.0f + erff(v1[j] * 0.70710678f)); } }
                    u32x4 w; w.x = cvt_pk_bf16(v0[0], v0[1]); w.y = cvt_pk_bf16(v0[2], v0[3]); w.z = cvt_pk_bf16(v1[0], v1[1]); w.w = cvt_pk_bf16(v1[2], v1[3]);
                    *(u32x4*)(rowp + bj * HALF) = w; } }
    }
};

struct PanelStats {
    unsigned* xbuf;
    unsigned* cnt;
    unsigned* tmo;
    int ntn; float eps;
    unsigned code;
    __device__ __forceinline__ bool run(const f32x4 (&v)[2][2][4][2], const Unit& u, int wr, int wc, int fr, int fq, PG8_LAS unsigned char* lds, int wid, int lane) const {
        typedef float f32x2v __attribute__((ext_vector_type(2)));
        PG8_LAS f32x2v* P = (PG8_LAS f32x2v*)lds;
        PG8_LAS f32x2v* S = (PG8_LAS f32x2v*)(lds + 8192);
        PG8_LAS unsigned* flag = (PG8_LAS unsigned*)(lds + 8192 + 2048);
#pragma unroll
        for (int ai = 0; ai < 2; ++ai)
#pragma unroll
            for (int m = 0; m < 4; ++m) {
                float s = 0.f;
#pragma unroll
                for (int bj = 0; bj < 2; ++bj)
#pragma unroll
                    for (int n = 0; n < 2; ++n) { const f32x4 x = v[ai][bj][m][n]; s += (x[0] + x[1]) + (x[2] + x[3]); }
                s += __shfl_xor(s, 16); s += __shfl_xor(s, 32);
                const float mw = s * (1.0f / 64.0f); float q = 0.f;
#pragma unroll
                for (int bj = 0; bj < 2; ++bj)
#pragma unroll
                    for (int n = 0; n < 2; ++n) { const f32x4 d = v[ai][bj][m][n] - mw; q += (d[0] * d[0] + d[1] * d[1]) + (d[2] * d[2] + d[3] * d[3]); }
                q += __shfl_xor(q, 16); q += __shfl_xor(q, 32);
                if (fq == 0) P[(ai * HALF + wr * 64 + m * 16 + fr) * 4 + wc] = (f32x2v){mw, q};
            }
        asm volatile("s_waitcnt lgkmcnt(0)" ::: "memory"); __builtin_amdgcn_s_barrier(); asm volatile("" ::: "memory");
#if defined(BROKEN_NO_WAIT)
        if (blockIdx.x >= 64) { const long long t0 = clock64(); while (clock64() - t0 < 60000) __builtin_amdgcn_s_sleep(8); }
#endif
        const int row = wid * 32 + (lane & 31);
        if (lane < 32) {
            const f32x2v a = P[row * 4 + 0], b = P[row * 4 + 1], c = P[row * 4 + 2], d = P[row * 4 + 3];
            const float mt = (a.x + b.x + c.x + d.x) * 0.25f;
            const float da = a.x - mt, db = b.x - mt, dc = c.x - mt, dd = d.x - mt;
            const float m2 = (a.y + b.y) + (c.y + d.y) + 64.0f * ((da * da + db * db) + (dc * dc + dd * dd));
            unsigned long long* slot = (unsigned long long*)xbuf + ((size_t)(u.pm * BM + row) * 4 + u.pn);
            __hip_atomic_store(slot, ((unsigned long long)__float_as_uint(m2) << 32) | __float_as_uint(mt), __ATOMIC_RELAXED, __HIP_MEMORY_SCOPE_AGENT);
        }
        asm volatile("s_waitcnt vmcnt(0)" ::: "memory");
        if (lane == 0) __hip_atomic_fetch_add(cnt + 64 * u.pm, 1u, __ATOMIC_RELAXED, __HIP_MEMORY_SCOPE_AGENT);
        if (wid == 0) {
            bool dead = false; const unsigned long long t0 = __builtin_amdgcn_s_memrealtime(); const unsigned want = 8u * (unsigned)ntn;
            for (;;) {
#if defined(BROKEN_NO_WAIT)
                break;
#endif
                if ((unsigned)__builtin_amdgcn_readfirstlane(__hip_atomic_load(cnt + 64 * u.pm, __ATOMIC_RELAXED, __HIP_MEMORY_SCOPE_AGENT)) >= want) break;
                if (__builtin_amdgcn_s_memrealtime() - t0 > 2000000ull) {
                    if (lane == 0) { unsigned expect = 0u; __hip_atomic_compare_exchange_strong(tmo + 1, &expect, code | (unsigned)(u.pm & 0xff), __ATOMIC_RELAXED, __ATOMIC_RELAXED, __HIP_MEMORY_SCOPE_AGENT);
                                     __hip_atomic_store(tmo, 1u, __ATOMIC_RELAXED, __HIP_MEMORY_SCOPE_AGENT); }
                    dead = true; break; }
                __builtin_amdgcn_s_sleep(2);
            }
            __builtin_amdgcn_fence(__ATOMIC_ACQUIRE, "agent");
            if (lane == 0) flag[0] = dead ? 1u : 0u;
        }
        asm volatile("s_waitcnt vmcnt(0) lgkmcnt(0)" ::: "memory"); __builtin_amdgcn_s_barrier(); asm volatile("" ::: "memory");
        const bool bad = flag[0] != 0u;
        if (lane < 32) {
            const unsigned long long* slot = (const unsigned long long*)xbuf + (size_t)(u.pm * BM + row) * 4; float mt[4], m2[4]; float ms = 0.f;
#pragma unroll
            for (int t = 0; t < 4; ++t) { if (t < ntn) { const unsigned long long w = __hip_atomic_load(slot + t, __ATOMIC_RELAXED, __HIP_MEMORY_SCOPE_AGENT); mt[t] = __uint_as_float((unsigned)w); m2[t] = __uint_as_float((unsigned)(w >> 32)); } else { mt[t] = 0.f; m2[t] = 0.f; } ms += mt[t]; }
            const float mean = ms / (float)ntn; float q = 0.f;
#pragma unroll
            for (int t = 0; t < 4; ++t) if (t < ntn) { const float dm = mt[t] - mean; q += m2[t] + 256.0f * dm * dm; }
            S[row] = (f32x2v){mean, 1.0f / sqrtf(q / (256.0f * (float)ntn) + eps)};
        }
        asm volatile("s_waitcnt lgkmcnt(0)" ::: "memory"); __builtin_amdgcn_s_barrier(); asm volatile("" ::: "memory");
        return bad;
    }
};
struct EpiLnRes {
    static constexpr bool PERM = false, AFTER_DRAIN = true;
    const float* base; float* out; int ldc; const float* bias; PanelStats st; unsigned poison;
    __device__ __forceinline__ void refuse(size_t i0, size_t stride, int M, int N) const { const float q = __builtin_nanf(""); for (size_t i = i0; i < (size_t)M * N; i += stride) out[(i / N) * ldc + i % N] = q;
        if (i0 == 0) { unsigned expect = 0u; __hip_atomic_compare_exchange_strong(st.tmo + 1, &expect, 0x7f0u, __ATOMIC_RELAXED, __ATOMIC_RELAXED, __HIP_MEMORY_SCOPE_AGENT); __hip_atomic_store(st.tmo, 1u, __ATOMIC_RELAXED, __HIP_MEMORY_SCOPE_AGENT); } }
    __device__ __forceinline__ void fused(f32x4 (&acc)[2][2][4][2], const Unit& u, int wr, int wc, int fr, int fq, PG8_LAS unsigned char* lds, int wid, int lane) const {
        typedef float f32x2v __attribute__((ext_vector_type(2)));
        const PG8_LAS f32x2v* S = (const PG8_LAS f32x2v*)(lds + 8192);
        const int col0 = u.pn * BM + wc * 32 + 4 * fq;
#pragma unroll
        for (int bj = 0; bj < 2; ++bj)
#pragma unroll
            for (int n = 0; n < 2; ++n) { const f32x4 bv = bias ? *(const f32x4*)(bias + col0 + bj * HALF + n * 16) : (f32x4){0.f, 0.f, 0.f, 0.f};
#pragma unroll
                for (int ai = 0; ai < 2; ++ai)
#pragma unroll
                    for (int m = 0; m < 4; ++m) acc[ai][bj][m][n] += bv; }
        const bool bad = st.run(acc, u, wr, wc, fr, fq, lds, wid, lane) || poison != 0u;
        const float qnan = __builtin_nanf("");
#pragma unroll
        for (int ai = 0; ai < 2; ++ai)
#pragma unroll
            for (int m = 0; m < 4; ++m) { const int r = ai * HALF + wr * 64 + m * 16 + fr; const f32x2v sr = S[r]; const size_t off = (size_t)(u.pm * BM + r) * ldc + col0;
#pragma unroll
                for (int bj = 0; bj < 2; ++bj)
#pragma unroll
                    for (int n = 0; n < 2; ++n) { const f32x4 bs = *(const f32x4*)(base + off + bj * HALF + n * 16); f32x4 o = bs + (acc[ai][bj][m][n] - sr.x) * sr.y;
                        if (bad) o = (f32x4){qnan, qnan, qnan, qnan}; *(f32x4*)(out + off + bj * HALF + n * 16) = o; }
                asm volatile("" ::: "memory"); }
    }
};
struct EpiLnResLn {
    static constexpr bool PERM = false, AFTER_DRAIN = true;
    const float* base; float* out; bf16_t* xn; int ldc; const float* bias; PanelStats st1, st2; unsigned poison;
    __device__ __forceinline__ void refuse(size_t i0, size_t stride, int M, int N) const { const float q = __builtin_nanf(""); for (size_t i = i0; i < (size_t)M * N; i += stride) { const size_t o = (i / N) * ldc + i % N; out[o] = q; xn[o] = (bf16_t)0x7fc0u; }
        if (i0 == 0) { unsigned expect = 0u; __hip_atomic_compare_exchange_strong(st1.tmo + 1, &expect, 0x7f0u, __ATOMIC_RELAXED, __ATOMIC_RELAXED, __HIP_MEMORY_SCOPE_AGENT); __hip_atomic_store(st1.tmo, 1u, __ATOMIC_RELAXED, __HIP_MEMORY_SCOPE_AGENT); } }
    __device__ __forceinline__ void fused(f32x4 (&acc)[2][2][4][2], const Unit& u, int wr, int wc, int fr, int fq, PG8_LAS unsigned char* lds, int wid, int lane) const {
        typedef float f32x2v __attribute__((ext_vector_type(2))); typedef unsigned u32x2v __attribute__((ext_vector_type(2)));
        const PG8_LAS f32x2v* S = (const PG8_LAS f32x2v*)(lds + 8192);
        const int col0 = u.pn * BM + wc * 32 + 4 * fq;
#pragma unroll
        for (int bj = 0; bj < 2; ++bj)
#pragma unroll
            for (int n = 0; n < 2; ++n) { const f32x4 bv = bias ? *(const f32x4*)(bias + col0 + bj * HALF + n * 16) : (f32x4){0.f, 0.f, 0.f, 0.f};
#pragma unroll
                for (int ai = 0; ai < 2; ++ai)
#pragma unroll
                    for (int m = 0; m < 4; ++m) acc[ai][bj][m][n] += bv; }
        bool bad = st1.run(acc, u, wr, wc, fr, fq, lds, wid, lane) || poison != 0u;
        const float qnan = __builtin_nanf("");
#pragma unroll
        for (int ai = 0; ai < 2; ++ai)
#pragma unroll
            for (int m = 0; m < 4; ++m) { const int r = ai * HALF + wr * 64 + m * 16 + fr; const f32x2v sr = S[r]; const size_t off = (size_t)(u.pm * BM + r) * ldc + col0;
#pragma unroll
                for (int bj = 0; bj < 2; ++bj)
#pragma unroll
                    for (int n = 0; n < 2; ++n) { const f32x4 bs = *(const f32x4*)(base + off + bj * HALF + n * 16); acc[ai][bj][m][n] = bs + (acc[ai][bj][m][n] - sr.x) * sr.y; }
                asm volatile("" : "+v"(acc[ai][0][m][0]), "+v"(acc[ai][0][m][1]), "+v"(acc[ai][1][m][0]), "+v"(acc[ai][1][m][1]));
                if (m & 1) asm volatile("" ::: "memory"); }
        const bool bad1 = bad;
        bad = st2.run(acc, u, wr, wc, fr, fq, lds, wid, lane) || bad;
#pragma unroll
        for (int ai = 0; ai < 2; ++ai)
#pragma unroll
            for (int m = 0; m < 4; ++m) { const int r = ai * HALF + wr * 64 + m * 16 + fr; const f32x2v sr = S[r]; const size_t off = (size_t)(u.pm * BM + r) * ldc + col0;
#pragma unroll
                for (int bj = 0; bj < 2; ++bj)
#pragma unroll
                    for (int n = 0; n < 2; ++n) { const f32x4 x1 = acc[ai][bj][m][n]; *(f32x4*)(out + off + bj * HALF + n * 16) = bad1 ? (f32x4){qnan, qnan, qnan, qnan} : x1;
                        const f32x4 o = (x1 - sr.x) * sr.y; u32x2v w; w.x = cvt_pk_bf16(o[0], o[1]); w.y = cvt_pk_bf16(o[2], o[3]);
                        if (bad) { w.x = 0x7fc07fc0u; w.y = 0x7fc07fc0u; } *(u32x2v*)(xn + off + bj * HALF + n * 16) = w; }
                asm volatile("" ::: "memory"); }
    }
};

typedef int i32x4 __attribute__((ext_vector_type(4)));
template <class Epi, class Sched, bool STAMP = false, bool I8 = false>
__device__ __forceinline__ void gemm_phase(PG8_LAS unsigned char* lds, const Gemm g, const Sched& S, const Epi& E, unsigned long long* stamps) {
    const int lane = mk_hw_lane(), wid = g.wave, tid = wid * 64 + lane, wr = wid >> 2, wc = wid & 3, fr = lane & 15, fq = lane >> 4;
    const int K = g.K, nt = K / BK;
    int ts_lo = 0, ts_hi = 0, nts = 0; const unsigned long long rt_entry = STAMP ? (unsigned long long)wall_clock64() : 0ull;
#define PG8_STAMP() do { if (STAMP && wid == 0 && nts < 64) { const unsigned long long _c = (unsigned long long)clock64(); \
        ts_lo = (lane == nts) ? (int)(unsigned)_c : ts_lo; ts_hi = (lane == nts) ? (int)(unsigned)(_c >> 32) : ts_hi; ++nts; } } while (0)
    PG8_STAMP();
    unsigned voffA[2], voffB[2];
#pragma unroll
    for (int i = 0; i < 2; ++i) { int R, C; stage_rc(tid * 16 + i * 8192, R, C); const int Rb = Epi::PERM ? ((R & ~31) + perm32(R & 31)) : R;
        voffA[i] = (unsigned)(R * K + C) * 2u; voffB[i] = (unsigned)(Rb * K + C) * 2u; }
    const size_t kstep = (size_t)(BK * 2);
    const size_t hstep = (size_t)HALF * K * 2;
    const size_t tstep = 2 * hstep;
    const unsigned ldsw = (unsigned)wid * 1024u;
    const int aoff = lds_byte(wr * 64 + fr, fq * 8), boff = lds_byte(wc * 32 + fr, fq * 8);
#define PG8_SA(b, h) (((b) * 2 + (h)) * HTB)
#define PG8_SB(b, h) ((4 + (b) * 2 + (h)) * HTB)
#define PG8_STAGE(bufoff, gbase, voff) do { _Pragma("unroll") for (int _i = 0; _i < 2; ++_i) \
        __builtin_amdgcn_global_load_lds((const unsigned*)((const char*)(gbase) + (voff)[_i]), (PG8_LAS unsigned*)(lds + (bufoff) + ldsw + _i * 8192), 16, 0, 0); } while (0)
#define PG8_LDA(dst, b, h) do { _Pragma("unroll") for (int m = 0; m < 4; ++m) _Pragma("unroll") for (int k = 0; k < 2; ++k) dst[m][k] = *(const PG8_LAS bf16x8*)(lds + PG8_SA(b, h) + aoff + m * 2048 + k * 1024); } while (0)
#define PG8_LDB(dst, b, h) do { _Pragma("unroll") for (int n = 0; n < 2; ++n) _Pragma("unroll") for (int k = 0; k < 2; ++k) dst[n][k] = *(const PG8_LAS bf16x8*)(lds + PG8_SB(b, h) + boff + n * 2048 + k * 1024); } while (0)
#define PG8_MMA(ai, bj, At, Bt) do { __builtin_amdgcn_s_setprio(1); _Pragma("unroll") for (int m = 0; m < 4; ++m) _Pragma("unroll") for (int n = 0; n < 2; ++n) _Pragma("unroll") for (int k = 0; k < 2; ++k) \
        { if constexpr (I8) acc[ai][bj][m][n] = __builtin_bit_cast(f32x4, __builtin_amdgcn_mfma_i32_16x16x64_i8(__builtin_bit_cast(i32x4, Bt[n][k]), __builtin_bit_cast(i32x4, At[m][k]), __builtin_bit_cast(i32x4, acc[ai][bj][m][n]), 0, 0, 0)); \
          else acc[ai][bj][m][n] = __builtin_amdgcn_mfma_f32_16x16x32_bf16(Bt[n][k], At[m][k], acc[ai][bj][m][n], 0, 0, 0); } __builtin_amdgcn_s_setprio(0); } while (0)
#define PG8_WAIT_V(n) asm volatile("s_waitcnt vmcnt(" #n ")" ::: "memory")
#define PG8_WAIT_L(n) asm volatile("s_waitcnt lgkmcnt(" #n ")" ::: "memory")
#define PG8_BAR __builtin_amdgcn_s_barrier()
#define PG8_SCHED __builtin_amdgcn_sched_barrier(0)
    Unit cur, nxt; int ui = 0;
    if (!S.next(0, cur)) return;
    f32x4 acc[2][2][4][2];
#pragma unroll
    for (int a = 0; a < 2; ++a)
#pragma unroll
        for (int b = 0; b < 2; ++b)
#pragma unroll
            for (int m = 0; m < 4; ++m)
#pragma unroll
                for (int n = 0; n < 2; ++n) acc[a][b][m][n] = (f32x4){0.f, 0.f, 0.f, 0.f};
    bf16x8 At[4][2], B0[2][2], B1[2][2];
    const char* cA = (const char*)g.A + (size_t)cur.pm * tstep; const char* cB = (const char*)g.Bt + (size_t)cur.pn * tstep;
    S.a_ready(cur);
    PG8_STAGE(PG8_SB(0, 0), cB, voffB); PG8_STAGE(PG8_SA(0, 0), cA, voffA); PG8_STAGE(PG8_SB(0, 1), cB + hstep, voffB); PG8_STAGE(PG8_SA(0, 1), cA + hstep, voffA);
    if (wr == 1) PG8_BAR;
    PG8_WAIT_V(4); PG8_BAR;
    PG8_STAGE(PG8_SB(1, 0), cB + kstep, voffB); PG8_STAGE(PG8_SA(1, 0), cA + kstep, voffA); PG8_STAGE(PG8_SB(1, 1), cB + hstep + kstep, voffB);
    PG8_WAIT_V(6); PG8_BAR;
    PG8_STAMP();
    for (;;) {
        const bool has_next = S.next(ui + 1, nxt);
        const char* nA = has_next ? (const char*)g.A + (size_t)nxt.pm * tstep : cA; const char* nB = has_next ? (const char*)g.Bt + (size_t)nxt.pn * tstep : cB;
        for (int t = 0; t < nt; t += 2) {
            const bool last = (t == nt - 2);
            const char* a1 = cA + (size_t)(t + 1) * kstep;
            const char* a2 = last ? nA : cA + (size_t)(t + 2) * kstep; const char* b2 = last ? nB : cB + (size_t)(t + 2) * kstep;
            const char* a3 = a2 + kstep; const char* b3 = b2 + kstep;
            if (last && has_next) S.a_ready(nxt);
            PG8_LDB(B0, 0, 0); PG8_SCHED; PG8_LDA(At, 0, 0); PG8_STAGE(PG8_SA(1, 1), a1 + hstep, voffA);
            PG8_WAIT_L(8); PG8_BAR; PG8_WAIT_L(0); PG8_MMA(0, 0, At, B0); PG8_BAR; PG8_SCHED;
            PG8_LDB(B1, 0, 1); PG8_STAGE(PG8_SB(0, 0), b2, voffB);
            PG8_BAR; PG8_WAIT_L(0); PG8_MMA(0, 1, At, B1); PG8_BAR;
            PG8_LDA(At, 0, 1); PG8_STAGE(PG8_SA(0, 0), a2, voffA);
            PG8_BAR; PG8_WAIT_L(0); PG8_MMA(1, 0, At, B0); PG8_BAR; PG8_SCHED;
            PG8_STAGE(PG8_SB(0, 1), b2 + hstep, voffB);
            PG8_WAIT_V(6); PG8_BAR; PG8_MMA(1, 1, At, B1); PG8_BAR;
            PG8_LDB(B0, 1, 0); PG8_SCHED; PG8_LDA(At, 1, 0); PG8_STAGE(PG8_SA(0, 1), a2 + hstep, voffA);
            PG8_WAIT_L(8); PG8_BAR; PG8_WAIT_L(0); PG8_MMA(0, 0, At, B0); PG8_BAR; PG8_SCHED;
            PG8_LDB(B1, 1, 1); PG8_STAGE(PG8_SB(1, 0), b3, voffB);
            PG8_BAR; PG8_WAIT_L(0); PG8_MMA(0, 1, At, B1); PG8_BAR;
            PG8_LDA(At, 1, 1); PG8_STAGE(PG8_SA(1, 0), a3, voffA);
            PG8_BAR; PG8_WAIT_L(0); PG8_MMA(1, 0, At, B0); PG8_BAR; PG8_SCHED;
            PG8_STAGE(PG8_SB(1, 1), b3 + hstep, voffB);
            PG8_WAIT_V(6); PG8_BAR; PG8_MMA(1, 1, At, B1); PG8_BAR;
        }
        PG8_STAMP();
        if constexpr (I8) {
            const int r0_ = cur.pm * BM + wr * 64 + fr, c0_ = cur.pn * BM + wc * 32 + (Epi::PERM ? 8 * fq : 4 * fq);
#pragma unroll
            for (int bj = 0; bj < 2; ++bj)
#pragma unroll
                for (int n = 0; n < 2; ++n) { const f32x4 sbv = *(const f32x4*)(g.sb + c0_ + bj * HALF + (Epi::PERM ? 4 * n : 16 * n));
#pragma unroll
                    for (int ai = 0; ai < 2; ++ai)
#pragma unroll
                        for (int m = 0; m < 4; ++m) { const float sav = g.sa[r0_ + ai * HALF + m * 16]; const i32x4 iv = __builtin_bit_cast(i32x4, acc[ai][bj][m][n]);
                            acc[ai][bj][m][n] = (f32x4){(float)iv[0] * sav * sbv[0], (float)iv[1] * sav * sbv[1], (float)iv[2] * sav * sbv[2], (float)iv[3] * sav * sbv[3]}; } }
        }
        if constexpr (!Epi::AFTER_DRAIN) { E(acc, cur, wr, wc, fr, fq); S.done(cur); }
        PG8_STAMP();
        if (!has_next) break;
#pragma unroll
        for (int a = 0; a < 2; ++a)
#pragma unroll
            for (int b = 0; b < 2; ++b)
#pragma unroll
                for (int m = 0; m < 4; ++m)
#pragma unroll
                    for (int n = 0; n < 2; ++n) acc[a][b][m][n] = (f32x4){0.f, 0.f, 0.f, 0.f};
        cur = nxt; cA = nA; cB = nB; ++ui;
    }
    PG8_WAIT_V(0);
    if (wr == 0) PG8_BAR;
    PG8_BAR;
    if constexpr (Epi::AFTER_DRAIN) { E.fused(acc, cur, wr, wc, fr, fq, lds, wid, lane); S.done(cur); }
    PG8_STAMP();
    if (STAMP && wid == 0) { stamps[lane] = lane < nts ? (((unsigned long long)(unsigned)ts_hi << 32) | (unsigned)ts_lo) : 0ull;
        if (lane == 62) stamps[62] = rt_entry; if (lane == 63) stamps[63] = (unsigned long long)wall_clock64(); }
#undef PG8_STAMP
#undef PG8_SA
#undef PG8_SB
#undef PG8_STAGE
#undef PG8_LDA
#undef PG8_LDB
#undef PG8_MMA
#undef PG8_WAIT_V
#undef PG8_WAIT_L
#undef PG8_BAR
#undef PG8_SCHED
}
}

namespace mk {
using pg8::bf16_t; using pg8::bf16x8; using pg8::f32x4; using pg8::u32x4;
typedef float f32x16 __attribute__((ext_vector_type(16)));
typedef unsigned u32x2 __attribute__((ext_vector_type(2)));
typedef __bf16 bf16x2 __attribute__((ext_vector_type(2)));

constexpr int T = 16384, DM = 4096, SEQ = 2048, NBATCH = 8;
constexpr int A_COLS = 18432, B_COLS = 12320, B_COLS_PAD = 12544, FOXW = 12288;
constexpr float DN_ALPHA = 1.4142135623730951f;
constexpr float LN_EPS = 1e-5f;
constexpr float LOG2E = 1.4426950408889634f, LN2 = 0.6931471805599453f;
constexpr float QSCALE2 = 0.08838834764831845f * 1.4426950408889634f;

constexpr size_t MB = (size_t)1 << 20;
constexpr size_t WS_CTL = 0;
constexpr size_t WS_WIN = 1 * MB;
constexpr size_t WS_WOUT = WS_WIN + 144 * MB;
constexpr size_t WS_WQ = WS_WOUT + 32 * MB;
constexpr size_t WS_U = WS_WQ + 16 * MB;
constexpr size_t WS_V = WS_U + 128 * MB;
constexpr size_t WS_HF = WS_V + 128 * MB;
constexpr size_t WS_HB = WS_HF + 256 * MB;
constexpr size_t WS_QKV = WS_HB + 128 * MB;
constexpr size_t WS_OG = WS_QKV + 576 * MB;
constexpr size_t WS_LSE = WS_OG + 192 * MB;
constexpr size_t WS_FG = WS_LSE + 3 * MB;
constexpr size_t WS_C2 = WS_FG + 2 * MB;
constexpr size_t WS_SC = WS_C2 + 2 * MB;
constexpr size_t WS_END = WS_SC + 1 * MB;
constexpr size_t WS_A2 = WS_QKV;
constexpr size_t WS_QP = WS_QKV + 128 * MB;
constexpr size_t WS_PART = WS_QKV + 192 * MB;
constexpr size_t WS_POUT = WS_QKV + 448 * MB;
constexpr size_t WS_PIDX = WS_QKV + 704 * MB;
constexpr size_t WS_PGATE = WS_QKV + 712 * MB;
constexpr size_t WS_PW = WS_QKV + 720 * MB;
constexpr size_t WS_X8 = WS_POUT;
constexpr size_t WS_XS = WS_SC + 256 * 1024;
constexpr size_t WS_WS = WS_SC + 512 * 1024;
constexpr size_t WS_WQ8 = WS_END;
constexpr size_t WS_WIN8 = WS_END + 8 * MB;
constexpr size_t WS_WOUT8 = WS_END + 88 * MB;
constexpr size_t WS_SC2 = WS_END + 108 * MB;
constexpr size_t WS_END2 = WS_END + 110 * MB;
constexpr size_t WS_X8A = WS_HB;
constexpr size_t WS_X8B = WS_HB + 64 * MB;
constexpr size_t WS_A28 = WS_QKV;
constexpr size_t WS_OG8 = WS_QKV + 448 * MB;
static_assert(WS_PW + 8 * MB <= WS_OG + 192 * MB, "PEER scratch must fit in the q|k|v + OG regions");
constexpr int BAR_REGION_WORDS = 4096;
constexpr int MAX_LAUNCHES = 32;

constexpr int NTHREADS = 512;
constexpr int LDS_BYTES = 147456;
constexpr int LDS_BARW = LDS_BYTES - 16;

struct Ctx { LAS unsigned char* lds; int tid, lane, wave, G, bid; };

typedef float f32x2c __attribute__((ext_vector_type(2)));
__device__ __forceinline__ unsigned pk2(float lo, float hi) { const f32x2c v = {lo, hi}; const bf16x2 b = __builtin_convertvector(v, bf16x2); return __builtin_bit_cast(unsigned, b); }
__device__ __forceinline__ float bf_lo(unsigned w) { return __uint_as_float(w << 16); }
__device__ __forceinline__ float bf_hi(unsigned w) { return __uint_as_float(w & 0xffff0000u); }
template <int CTRL> __device__ __forceinline__ float dppf(float x) { return __builtin_bit_cast(float, __builtin_amdgcn_mov_dpp(__builtin_bit_cast(int, x), CTRL, 0xf, 0xf, true)); }
__device__ __forceinline__ float wave_sum(float x) {
    x += dppf<0xB1>(x); x += dppf<0x4E>(x); x += dppf<0x141>(x); x += dppf<0x128>(x);
    auto s = __builtin_amdgcn_permlane16_swap(__float_as_uint(x), __float_as_uint(x), false, false);
    x = __uint_as_float(s[0]) + __uint_as_float(s[1]);
    auto t = __builtin_amdgcn_permlane32_swap(__float_as_uint(x), __float_as_uint(x), false, false);
    return __uint_as_float(t[0]) + __uint_as_float(t[1]);
}
__device__ __forceinline__ float pair_max(float x) { auto t = __builtin_amdgcn_permlane32_swap(__float_as_uint(x), __float_as_uint(x), false, false); return fmaxf(__uint_as_float(t[0]), __uint_as_float(t[1])); }
__device__ __forceinline__ float pair_sum(float x) { auto t = __builtin_amdgcn_permlane32_swap(__float_as_uint(x), __float_as_uint(x), false, false); return __uint_as_float(t[0]) + __uint_as_float(t[1]); }
__device__ __forceinline__ int pair_maxi(int x) { auto t = __builtin_amdgcn_permlane32_swap((unsigned)x, (unsigned)x, false, false); const int a = (int)t[0], b = (int)t[1]; return a > b ? a : b; }
__device__ __forceinline__ bf16x8 pack8(float a0, float a1, float a2, float a3, float b0, float b1, float b2, float b3) {
    u32x4 w = {pk2(a0, a1), pk2(a2, a3), pk2(b0, b1), pk2(b2, b3)}; return __builtin_bit_cast(bf16x8, w);
}
__device__ __forceinline__ float dot2(unsigned a, unsigned b, float acc) { return __builtin_amdgcn_fdot2_f32_bf16(__builtin_bit_cast(bf16x2, a), __builtin_bit_cast(bf16x2, b), acc, false); }
#define MK_LDS_WAIT() asm volatile("s_waitcnt lgkmcnt(0)" ::: "memory")

__device__ __forceinline__ void transpose_weights(const Ctx& c, const float* __restrict__ W, int K, int N, bf16_t* __restrict__ WT) {
    LAS float* scr = (LAS float*)(c.lds + c.wave * 8704);
    const int lane = c.lane, nblk = N / 32, nitems = (K / 64) * nblk;
    for (int item = c.bid * 8 + c.wave; item < nitems; item += c.G * 8) {
        const int kb = item / nblk, nb = item - kb * nblk, k0 = 64 * kb, n0 = 32 * nb;
#pragma unroll 8
        for (int i = 0; i < 32; ++i) { const int kk = 2 * i + (lane >> 5); scr[kk * 33 + (lane & 31)] = W[(size_t)(k0 + kk) * N + n0 + (lane & 31)]; }
        MK_LDS_WAIT();
        const int cch = lane & 7;
#pragma unroll
        for (int j = 0; j < 4; ++j) { const int n = (lane >> 3) + 8 * j; const LAS float* s = scr + (8 * cch) * 33 + n;
            u32x4 o; o.x = pk2(s[0 * 33], s[1 * 33]); o.y = pk2(s[2 * 33], s[3 * 33]); o.z = pk2(s[4 * 33], s[5 * 33]); o.w = pk2(s[6 * 33], s[7 * 33]);
            *(u32x4*)(WT + (size_t)(n0 + n) * K + k0 + 8 * cch) = o; }
        MK_LDS_WAIT();
    }
}
__device__ __forceinline__ unsigned pack_i8x4(f32x4 a);
template <int KK>
__device__ __forceinline__ void transpose_quant(const Ctx& c, const float* __restrict__ W, int N, unsigned char* __restrict__ W8, float* __restrict__ sc, int rot) {
    constexpr int NT = KK / 512, NREG = NT < 6 ? NT : 6;
    LAS float* scr = (LAS float*)(c.lds + c.wave * 8704);
    LAS float* cmx = (LAS float*)(c.lds + 8 * 8704);
    static_assert(8 * 8704 + 1024 + 2 * 4 * 512 * 16 <= LDS_BARW, "transpose_quant LDS");
    const int nblk = N / 32;
#pragma unroll 1
    for (int nb = (c.bid - rot % c.G + c.G) % c.G; nb < nblk; nb += c.G) {
        int lane = mk_hw_lane();
        LAS u32x4* priv = (LAS u32x4*)(c.lds + 8 * 8704 + 1024) + (c.wave * 64 + lane);
        const int n0 = 32 * nb, cch = lane & 7;
        u32x4 keep[NREG][4]; float mx[4] = {0.f, 0.f, 0.f, 0.f};
        f32x4 ld[8];
#define MK_TQ_LOAD(t_) do { int k0_ = 64 * (c.wave + 8 * (t_)); asm volatile("" : "+s"(k0_)); const float* wp_ = W + (size_t)(k0_ + (lane >> 3)) * N + n0 + 4 * (lane & 7); \
            _Pragma("unroll") for (int i_ = 0; i_ < 8; ++i_) ld[i_] = *(const f32x4*)(wp_ + (size_t)(8 * i_) * N); } while (0)
        MK_TQ_LOAD(0);
#pragma unroll
        for (int t = 0; t < NT; ++t) { asm volatile("" : "+v"(lane));
#pragma unroll
            for (int i = 0; i < 8; ++i) { LAS float* d = scr + (8 * i + (lane >> 3)) * 33 + 4 * (lane & 7); d[0] = ld[i][0]; d[1] = ld[i][1]; d[2] = ld[i][2]; d[3] = ld[i][3]; }
            asm volatile("" ::: "memory");
            if (t + 1 < NT) MK_TQ_LOAD(t + 1);
            asm volatile("" ::: "memory");
            MK_LDS_WAIT();
#pragma unroll
            for (int j = 0; j < 4; ++j) { asm volatile("" ::: "memory");
                const int n = (lane >> 3) + 8 * j; const LAS float* s = scr + (8 * cch) * 33 + n;
                u32x4 o; o.x = pk2(s[0 * 33], s[1 * 33]); o.y = pk2(s[2 * 33], s[3 * 33]); o.z = pk2(s[4 * 33], s[5 * 33]); o.w = pk2(s[6 * 33], s[7 * 33]);
                if (t < NREG) keep[t < NREG ? t : 0][j] = o; else priv[((t - NREG) * 4 + j) * 512] = o;
#pragma unroll
                for (int e = 0; e < 4; ++e) mx[j] = fmaxf(mx[j], fmaxf(fabsf(bf_lo(o[e])), fabsf(bf_hi(o[e])))); }
            MK_LDS_WAIT();
        }
#undef MK_TQ_LOAD
#pragma unroll
        for (int j = 0; j < 4; ++j) { float m = mx[j]; m = fmaxf(m, dppf<0xB1>(m)); m = fmaxf(m, dppf<0x4E>(m)); m = fmaxf(m, dppf<0x141>(m));
            if (cch == 0) cmx[c.wave * 32 + (lane >> 3) + 8 * j] = m; }
        __syncthreads();
        float scale[4];
#pragma unroll
        for (int j = 0; j < 4; ++j) { const int n = (lane >> 3) + 8 * j; float m = cmx[n];
#pragma unroll
            for (int w = 1; w < 8; ++w) m = fmaxf(m, cmx[w * 32 + n]);
            const bool ok = (m > 1e-30f) && (m < 1e30f);
            scale[j] = ok ? 127.0f / m : 0.f;
            if (c.wave == 0 && cch == 0) sc[n0 + n] = ok ? m * (1.0f / 127.0f) : 0.f; }
#pragma unroll
        for (int t = 0; t < NT; ++t)
#pragma unroll
            for (int j = 0; j < 4; ++j) { u32x4 o; if (t < NREG) o = keep[t < NREG ? t : 0][j]; else o = priv[((t - NREG) * 4 + j) * 512]; asm volatile("" : "+v"(o));
                u32x2 w;
                w[0] = pack_i8x4((f32x4){bf_lo(o[0]), bf_hi(o[0]), bf_lo(o[1]), bf_hi(o[1])} * scale[j]);
                w[1] = pack_i8x4((f32x4){bf_lo(o[2]), bf_hi(o[2]), bf_lo(o[3]), bf_hi(o[3])} * scale[j]);
                *(u32x2*)(W8 + (size_t)(n0 + (lane >> 3) + 8 * j) * KK + 64 * (c.wave + 8 * t) + 8 * cch) = w; }
        __syncthreads();
    }
}
__device__ __forceinline__ int strips_for(int nblk, int rot, int G, int b) { const int r = (b - rot % G + G) % G; return nblk / G + (r < nblk % G ? 1 : 0); }
struct ConvDeal { int lo, hi, covered; };
__device__ __forceinline__ ConvDeal conv_deal(int G, int bid, int nb0, int w0, int nb1, int rot1, int w1, int nb2, int rot2, int w2, int total) {
    int cmax = 0, csum = 0, cpre = 0, mine = 0;
    int r1 = (G - rot1 % G) % G, r2 = (G - rot2 % G) % G;
    const int q0 = nb0 / G, m0 = nb0 % G, q1 = nb1 / G, m1 = nb1 % G, q2 = nb2 / G, m2 = nb2 % G;
    for (int b = 0; b < G; ++b) { const int cb = (q0 + (b < m0 ? 1 : 0)) * w0 + (q1 + (r1 < m1 ? 1 : 0)) * w1 + (q2 + (r2 < m2 ? 1 : 0)) * w2;
        cmax = cb > cmax ? cb : cmax; csum += cb; if (b < bid) cpre += cb; if (b == bid) mine = cb;
        r1 = (r1 + 1 == G) ? 0 : r1 + 1; r2 = (r2 + 1 == G) ? 0 : r2 + 1; }
    const int spare = total - (G * cmax - csum);
    ConvDeal d;
    if (spare < 0) { d.lo = 0; d.hi = 0; d.covered = 0; return d; }
    const int base = (spare / G) & ~7;
    d.lo = base * bid + (bid * cmax - cpre); d.hi = d.lo + base + (cmax - mine); d.covered = G * base + (G * cmax - csum);
    return d;
}
__device__ __forceinline__ void convert_flat(const Ctx& c, const float* __restrict__ src, bf16_t* __restrict__ dst, size_t n) {
    const size_t n8 = n / 8, stride = (size_t)c.G * NTHREADS;
    for (size_t i = (size_t)c.bid * NTHREADS + c.tid; i < n8; i += stride) {
        const f32x4 a = *(const f32x4*)(src + i * 8), b = *(const f32x4*)(src + i * 8 + 4);
        u32x4 o = {pk2(a[0], a[1]), pk2(a[2], a[3]), pk2(b[0], b[1]), pk2(b[2], b[3])};
        *(u32x4*)(dst + i * 8) = o;
    }
}
__device__ __forceinline__ void zero_flat16(const Ctx& c, void* dst, size_t bytes) {
    const size_t n = bytes / 16, stride = (size_t)c.G * NTHREADS; const u32x4 z = {0u, 0u, 0u, 0u};
    for (size_t i = (size_t)c.bid * NTHREADS + c.tid; i < n; i += stride) ((u32x4*)dst)[i] = z;
}

__device__ __forceinline__ float wave_max(float x) {
    x = fmaxf(x, dppf<0xB1>(x)); x = fmaxf(x, dppf<0x4E>(x)); x = fmaxf(x, dppf<0x141>(x)); x = fmaxf(x, dppf<0x128>(x));
    auto s = __builtin_amdgcn_permlane16_swap(__float_as_uint(x), __float_as_uint(x), false, false);
    x = fmaxf(__uint_as_float(s[0]), __uint_as_float(s[1]));
    auto t = __builtin_amdgcn_permlane32_swap(__float_as_uint(x), __float_as_uint(x), false, false);
    return fmaxf(__uint_as_float(t[0]), __uint_as_float(t[1]));
}
__device__ __forceinline__ void convert_rows_fp8(const Ctx& c, const float* __restrict__ src, unsigned char* __restrict__ dst, float* __restrict__ inv, int rows) {
    for (int row = c.bid * 8 + c.wave; row < rows; row += c.G * 8) {
        const float* rp = src + (size_t)row * DM + c.lane * 16;
        f32x4 v[16]; float mx = 0.f;
#pragma unroll
        for (int i = 0; i < 4; ++i)
#pragma unroll
            for (int q = 0; q < 4; ++q) { v[4 * i + q] = *(const f32x4*)(rp + i * 1024 + 4 * q);
                mx = fmaxf(mx, fmaxf(fmaxf(fabsf(v[4 * i + q][0]), fabsf(v[4 * i + q][1])), fmaxf(fabsf(v[4 * i + q][2]), fabsf(v[4 * i + q][3])))); }
        mx = wave_max(mx);
        const unsigned ex = (__float_as_uint(mx) >> 23) & 0xffu;
        const bool ok = (ex > 8u) && (ex < 250u);
        const float scale = ok ? __uint_as_float((261u - ex) << 23) : 1.0f, iscale = ok ? __uint_as_float((ex - 7u) << 23) : 1.0f;
        if (c.lane == 0) inv[row] = iscale;
        unsigned char* op = dst + ((size_t)(c.lane >> 3) * 16384 + row) * 128 + (c.lane & 7) * 16;
#pragma unroll
        for (int i = 0; i < 4; ++i) { u32x4 w;
#pragma unroll
            for (int q = 0; q < 4; ++q) { const f32x4 a = v[4 * i + q] * scale; int t = 0; t = __builtin_amdgcn_cvt_pk_fp8_f32(a[0], a[1], t, false); t = __builtin_amdgcn_cvt_pk_fp8_f32(a[2], a[3], t, true); w[q] = (unsigned)t; }
            *(u32x4*)(op + (size_t)i * 8 * 16384 * 128) = w; }
    }
}

__device__ __forceinline__ unsigned pack_i8x4(f32x4 a) {
    const int q0 = (int)__builtin_rintf(a[0]), q1 = (int)__builtin_rintf(a[1]), q2 = (int)__builtin_rintf(a[2]), q3 = (int)__builtin_rintf(a[3]);
    return ((unsigned)q0 & 0xffu) | (((unsigned)q1 & 0xffu) << 8) | (((unsigned)q2 & 0xffu) << 16) | ((unsigned)q3 << 24);
}
__device__ __forceinline__ void convert_rows_i8(const Ctx& c, const float* __restrict__ src, unsigned char* __restrict__ dst, float* __restrict__ inv, int row_begin, int row_end, int row_step) {
    for (int row = row_begin; row < row_end; row += row_step) {
        const float* rp = src + (size_t)row * DM + c.lane * 16;
        f32x4 v[16]; float mx = 0.f;
#pragma unroll
        for (int i = 0; i < 4; ++i)
#pragma unroll
            for (int q = 0; q < 4; ++q) { v[4 * i + q] = *(const f32x4*)(rp + i * 1024 + 4 * q);
                mx = fmaxf(mx, fmaxf(fmaxf(fabsf(v[4 * i + q][0]), fabsf(v[4 * i + q][1])), fmaxf(fabsf(v[4 * i + q][2]), fabsf(v[4 * i + q][3])))); }
        mx = wave_max(mx);
        const bool ok = (mx > 1e-30f) && (mx < 1e30f);
        const float scale = ok ? 127.0f / mx : 1.0f, iscale = ok ? mx * (1.0f / 127.0f) : 1.0f;
        if (c.lane == 0) inv[row] = iscale;
        unsigned char* op = dst + ((size_t)(c.lane >> 3) * 16384 + row) * 128 + (c.lane & 7) * 16;
#pragma unroll
        for (int i = 0; i < 4; ++i) { u32x4 w;
#pragma unroll
            for (int q = 0; q < 4; ++q) w[q] = pack_i8x4(v[4 * i + q] * scale);
            *(u32x4*)(op + (size_t)i * 8 * 16384 * 128) = w; }
    }
}

template <int KK>
__device__ __forceinline__ void quant_rows_bf16_i8(const Ctx& c, const bf16_t* __restrict__ src, unsigned char* __restrict__ dst, float* __restrict__ sc, int rows) {
    constexpr int NCH = KK / 512;
    for (int row = c.bid * 8 + c.wave; row < rows; row += c.G * 8) {
        int ln = c.lane; asm volatile("" : "+v"(ln));
        const bf16_t* rp = src + (size_t)row * KK + ln * 8;
        u32x4 v[NCH]; float mx = 0.f;
#pragma unroll
        for (int i = 0; i < NCH; ++i) { v[i] = *(const u32x4*)(rp + i * 512);
#pragma unroll
            for (int j = 0; j < 4; ++j) mx = fmaxf(mx, fmaxf(fabsf(bf_lo(v[i][j])), fabsf(bf_hi(v[i][j])))); }
        mx = wave_max(mx);
        const bool ok = (mx > 1e-30f) && (mx < 1e30f);
        const float scale = ok ? 127.0f / mx : 0.f;
        if (ln == 0) sc[row] = ok ? mx * (1.0f / 127.0f) : 0.f;
        unsigned char* op = dst + (size_t)row * KK + ln * 8;
#pragma unroll
        for (int i = 0; i < NCH; ++i) { u32x2 w;
            w[0] = pack_i8x4((f32x4){bf_lo(v[i][0]), bf_hi(v[i][0]), bf_lo(v[i][1]), bf_hi(v[i][1])} * scale);
            w[1] = pack_i8x4((f32x4){bf_lo(v[i][2]), bf_hi(v[i][2]), bf_lo(v[i][3]), bf_hi(v[i][3])} * scale);
            *(u32x2*)(op + i * 512) = w; }
    }
}

__device__ __forceinline__ void quant_rows_f32_i8(const Ctx& c, const float* __restrict__ src, unsigned char* __restrict__ dst, float* __restrict__ sc, int rows) {
    for (int row = c.bid * 8 + c.wave; row < rows; row += c.G * 8) {
        int ln = c.lane; asm volatile("" : "+v"(ln));
        const size_t off = (size_t)row * DM + 4 * ln;
        f32x4 v[16]; float mx = 0.f;
#pragma unroll
        for (int j = 0; j < 16; ++j) { v[j] = *(const f32x4*)(src + off + 256 * j); mx = fmaxf(mx, fmaxf(fmaxf(fabsf(v[j][0]), fabsf(v[j][1])), fmaxf(fabsf(v[j][2]), fabsf(v[j][3])))); }
        mx = wave_max(mx);
        const bool ok = (mx > 1e-30f) && (mx < 1e30f);
        const float scale = ok ? 127.0f / mx : 0.f;
        if (ln == 0) sc[row] = ok ? mx * (1.0f / 127.0f) : 0.f;
#pragma unroll
        for (int j = 0; j < 16; ++j) *(unsigned*)(dst + off + 256 * j) = pack_i8x4(v[j] * scale);
    }
}

__device__ __forceinline__ void ln_phase(const Ctx& c, const bf16_t* Hf, float* dst, bf16_t* Hb, const float* __restrict__ g, const float* __restrict__ b, unsigned char* X8 = nullptr, float* XS = nullptr) {
    for (int row = c.bid * 8 + c.wave; row < T; row += c.G * 8) {
        int ln = c.lane; asm volatile("" : "+v"(ln));
        const size_t off = (size_t)row * DM + 4 * ln;
        f32x4 v[16]; float s = 0.f;
#pragma unroll
        for (int j = 0; j < 16; ++j) { const u32x2 hw = *(const u32x2*)(Hf + off + 256 * j); v[j] = (f32x4){bf_lo(hw[0]), bf_hi(hw[0]), bf_lo(hw[1]), bf_hi(hw[1])}; s += (v[j][0] + v[j][1]) + (v[j][2] + v[j][3]); }
        const float mean = wave_sum(s) * (1.f / DM); float q = 0.f;
#pragma unroll
        for (int j = 0; j < 16; ++j) { v[j] = v[j] - mean; q += (v[j][0] * v[j][0] + v[j][1] * v[j][1]) + (v[j][2] * v[j][2] + v[j][3] * v[j][3]); }
        const float rstd = 1.0f / sqrtf(wave_sum(q) * (1.f / DM) + LN_EPS);
#pragma unroll
        for (int j = 0; j < 16; ++j) { if ((j & 3) == 0) asm volatile("" ::: "memory");
            const f32x4 gg = *(const f32x4*)(g + 4 * ln + 256 * j), bb = *(const f32x4*)(b + 4 * ln + 256 * j);
            const f32x4 o = v[j] * rstd * gg + bb; if (dst) *(f32x4*)(dst + off + 256 * j) = o; v[j] = o;
            if (Hb) { u32x2 w = {pk2(o[0], o[1]), pk2(o[2], o[3])}; *(u32x2*)(Hb + off + 256 * j) = w; } }
        if (X8) {
            float mx = 0.f;
#pragma unroll
            for (int j = 0; j < 16; ++j) mx = fmaxf(mx, fmaxf(fmaxf(fabsf(v[j][0]), fabsf(v[j][1])), fmaxf(fabsf(v[j][2]), fabsf(v[j][3]))));
            mx = wave_max(mx);
            const bool ok = (mx > 1e-30f) && (mx < 1e30f);
            const float scale = ok ? 127.0f / mx : 1.0f;
            if (ln == 0) XS[row] = ok ? mx * (1.0f / 127.0f) : 1.0f;
#pragma unroll
            for (int j = 0; j < 16; ++j) *(unsigned*)(X8 + off + 256 * j) = pack_i8x4(v[j] * scale);
        }
    }
}

__device__ __forceinline__ void merge_phase(const Ctx& c, const bf16_t* __restrict__ OG, const float* __restrict__ LSE, unsigned char* __restrict__ A28, float* __restrict__ SA2) {
    for (int tok = c.bid * 8 + c.wave; tok < T; tok += c.G * 8) {
        int ln = c.lane; asm volatile("" : "+v"(ln));
        float o[32]; float mx = 0.f;
#pragma unroll
        for (int j = 0; j < 4; ++j) { const int col = 8 * ln + 512 * j, head = col >> 7;
            const float l0 = LSE[(0 * (size_t)T + tok) * 16 + head], l1 = LSE[(1 * (size_t)T + tok) * 16 + head], l2 = LSE[(2 * (size_t)T + tok) * 16 + head];
            const float lm = fmaxf(l0, fmaxf(l1, l2));
            float e0 = __expf(l0 - lm), e1 = __expf(l1 - lm), e2 = __expf(l2 - lm); const float inv = 1.0f / (e0 + e1 + e2); e0 *= inv; e1 *= inv; e2 *= inv;
            const u32x4 a = *(const u32x4*)(OG + (0 * (size_t)T + tok) * 2048 + col), b = *(const u32x4*)(OG + (1 * (size_t)T + tok) * 2048 + col), d = *(const u32x4*)(OG + (2 * (size_t)T + tok) * 2048 + col);
#pragma unroll
            for (int w = 0; w < 4; ++w) { const float lo = e0 * bf_lo(a[w]) + e1 * bf_lo(b[w]) + e2 * bf_lo(d[w]), hi = e0 * bf_hi(a[w]) + e1 * bf_hi(b[w]) + e2 * bf_hi(d[w]);
                o[8 * j + 2 * w] = lo; o[8 * j + 2 * w + 1] = hi; mx = fmaxf(mx, fmaxf(fabsf(lo), fabsf(hi))); } }
        mx = wave_max(mx);
        const bool ok = (mx > 1e-30f) && (mx < 1e30f);
        const float scale = ok ? 127.0f / mx : 0.f;
        if (ln == 0) SA2[tok] = ok ? mx * (1.0f / 127.0f) : 0.f;
#pragma unroll
        for (int j = 0; j < 4; ++j) { u32x2 w;
            w[0] = pack_i8x4((f32x4){o[8 * j], o[8 * j + 1], o[8 * j + 2], o[8 * j + 3]} * scale); w[1] = pack_i8x4((f32x4){o[8 * j + 4], o[8 * j + 5], o[8 * j + 6], o[8 * j + 7]} * scale);
            *(u32x2*)(A28 + (size_t)tok * 2048 + 8 * ln + 512 * j) = w; }
    }
}

__device__ __forceinline__ void cumsum_phase(const Ctx& c, const float* __restrict__ FG, const float* __restrict__ fbias, float* __restrict__ C2, float* __restrict__ C2N) {
    LAS float* wtot = (LAS float*)c.lds;
    for (int seq = c.bid; seq < NBATCH * 32; seq += c.G) {
        const int b = seq >> 5, hd = seq & 31; const float bias = fbias[hd];
        float p[4]; float run = 0.f;
#pragma unroll
        for (int i = 0; i < 4; ++i) { const float z = FG[((size_t)b * SEQ + 4 * c.tid + i) * 32 + hd] + bias; const float lf = fminf(z, 0.f) - log1pf(__expf(-fabsf(z))); run += lf; p[i] = run; }
        float v = run;
#pragma unroll
        for (int o = 1; o < 64; o <<= 1) { const float nb = __shfl_up(v, o); if (c.lane >= o) v += nb; }
        if (c.lane == 63) wtot[c.wave] = v;
        __syncthreads();
        float woff = 0.f;
        for (int w = 0; w < c.wave; ++w) woff += wtot[w];
        const float excl = woff + v - run;
        f32x4 o = {(excl + p[0]) * LOG2E, (excl + p[1]) * LOG2E, (excl + p[2]) * LOG2E, (excl + p[3]) * LOG2E};
        *(f32x4*)(C2 + (size_t)seq * SEQ + 4 * c.tid) = o; *(f32x4*)(C2N + (size_t)seq * SEQ + 4 * c.tid) = -o;
        __syncthreads();
    }
}

constexpr float ATT_THR = 8.0f;
constexpr int KT_PITCH = 272, KT_BYTES = 64 * KT_PITCH;
constexpr int VT_PITCH = 144, VT_BYTES = 128 * VT_PITCH;
constexpr int ABUF_BYTES = KT_BYTES + VT_BYTES;
constexpr int AHALF_BYTES = 2 * ABUF_BYTES + 512;
static_assert(2 * AHALF_BYTES <= LDS_BARW, "attention LDS");

struct AttnHalf { const bf16_t* q; const bf16_t* k; const bf16_t* v; bf16_t* o; float* lse; const float* c2; const float* c2n; float sd2; };
struct AttnTile { size_t rstride, ostride, lstride; int q0, kt_lo, kt_hi; unsigned Wn; int desc; };

__device__ __forceinline__ void half_barrier(LAS unsigned* cnt, int& gen, int lane) {
    asm volatile("s_waitcnt lgkmcnt(0)" ::: "memory");
    if (lane == 0) __hip_atomic_fetch_add((unsigned*)cnt, 1u, __ATOMIC_RELAXED, __HIP_MEMORY_SCOPE_WORKGROUP);
    ++gen; const unsigned target = 4u * (unsigned)gen;
    for (unsigned spins = 0; spins < (1u << 22); ++spins) {
        const unsigned v = __hip_atomic_load((unsigned*)cnt, __ATOMIC_RELAXED, __HIP_MEMORY_SCOPE_WORKGROUP);
        if ((unsigned)__builtin_amdgcn_readfirstlane((int)v) >= target) break;
        __builtin_amdgcn_s_sleep(1);
    }
    asm volatile("s_waitcnt lgkmcnt(0)" ::: "memory");
}
constexpr int ATT_CNT_OFF = 2 * AHALF_BYTES;
static_assert(ATT_CNT_OFF + 128 <= LDS_BARW, "attention counters");
template <int MODE, int VAR = 0>
__device__ __forceinline__ void attn_tile(const Ctx& c, const AttnHalf& H, const AttnTile& A, int& gen) {
    int lane = c.lane; asm volatile("" : "+v"(lane));
    const int hw = c.wave & 3, ht = (c.wave & 3) * 64 + lane, h = lane >> 5, cc = lane & 31;
    LAS unsigned char* base = c.lds + (c.wave >> 2) * AHALF_BYTES;
    LAS unsigned* hcnt = (LAS unsigned*)(c.lds + ATT_CNT_OFF + (c.wave >> 2) * 64);
    const int qlo = A.q0 + 32 * hw, qm = qlo + cc;
    bf16x8 qf[8];
    { const bf16_t* qp = H.q + (size_t)qm * A.rstride + 8 * h;
#pragma unroll
      for (int ks = 0; ks < 8; ++ks) { const u32x4 w = *(const u32x4*)(qp + 16 * ks); u32x4 o;
#pragma unroll
          for (int j = 0; j < 4; ++j) o[j] = pk2(bf_lo(w[j]) * QSCALE2, bf_hi(w[j]) * QSCALE2);
          qf[ks] = __builtin_bit_cast(bf16x8, o); } }
    const float rowterm = MODE ? H.c2[qm] : -H.sd2 * (float)qm;
    f32x16 oacc[4];
#pragma unroll
    for (int d = 0; d < 4; ++d)
#pragma unroll
        for (int r = 0; r < 16; ++r) oacc[d][r] = 0.f;
    float m_run = 0.f, l_run = 0.f;

    u32x4 kst[4], vst[4]; float ctv = 0.f;
    const int s_key = ht >> 4, s_c16 = ht & 15;
    const int v_kq = ht & 15, v_do = ht >> 4;
    const int v_kqs = (v_kq & ~3) | ((v_kq & 1) << 1) | ((v_kq >> 1) & 1);
#define MK_ATT_LOAD(kt) do { const int k0_ = 64 * (kt); \
        _Pragma("unroll") for (int i_ = 0; i_ < 4; ++i_) kst[i_] = *(const u32x4*)(H.k + (size_t)(k0_ + s_key + 16 * i_) * A.rstride + s_c16 * 8); \
        _Pragma("unroll") for (int i_ = 0; i_ < 4; ++i_) vst[i_] = *(const u32x4*)(H.v + (size_t)(k0_ + 4 * v_kq + i_) * A.rstride + v_do * 8); \
        if (ht < 64) ctv = MODE ? H.c2n[k0_ + ht] : H.sd2 * (float)(k0_ + ht); } while (0)
#define MK_ATT_WRITE(b) do { LAS unsigned char* kb_ = base + (b) * ABUF_BYTES; LAS unsigned char* vb_ = kb_ + KT_BYTES; \
        _Pragma("unroll") for (int i_ = 0; i_ < 4; ++i_) *(LAS u32x4*)(kb_ + (s_key + 16 * i_) * KT_PITCH + s_c16 * 16) = kst[i_]; \
        _Pragma("unroll") for (int w_ = 0; w_ < 4; ++w_) { \
            u32x2 e_ = {(vst[0][w_] & 0xffffu) | (vst[1][w_] << 16), (vst[2][w_] & 0xffffu) | (vst[3][w_] << 16)}; \
            u32x2 o_ = {(vst[0][w_] >> 16) | (vst[1][w_] & 0xffff0000u), (vst[2][w_] >> 16) | (vst[3][w_] & 0xffff0000u)}; \
            *(LAS u32x2*)(vb_ + (v_do * 8 + 2 * w_) * VT_PITCH + v_kqs * 8) = e_; \
            *(LAS u32x2*)(vb_ + (v_do * 8 + 2 * w_ + 1) * VT_PITCH + v_kqs * 8) = o_; } \
        if (ht < 64) ((LAS float*)(base + 2 * ABUF_BYTES + (b) * 256))[ht] = ctv; } while (0)

#define MK_KT(t_) (A.desc ? (A.kt_hi - 1 - (t_)) : (A.kt_lo + (t_)))
    const int nt = A.kt_hi - A.kt_lo;
    MK_ATT_LOAD(MK_KT(0)); MK_ATT_WRITE(0);
    half_barrier(hcnt, gen, lane);
    for (int t = 0; t < nt; ++t) {
        const bool more = (t + 1 < nt);
        if (more && VAR != 2 && VAR != 3) MK_ATT_LOAD(MK_KT(t + 1));
#ifdef MK_TEST_WAIT
        if (MODE) asm volatile("s_waitcnt vmcnt(0)" ::: "memory");
#endif
        const int k0 = 64 * MK_KT(t), qhi = qlo + 31;
        const bool need = (VAR != 1) && (k0 <= qhi) && (MODE || (k0 + 63 + (int)A.Wn >= qlo));
        if (need) {
            const LAS unsigned char* kb = base + (t & 1) * ABUF_BYTES; const LAS unsigned char* vb = kb + KT_BYTES;
            const LAS float* ctp = (const LAS float*)(base + 2 * ABUF_BYTES + (t & 1) * 256) + 4 * h;
            f32x16 s0, s1;
            { const float rb = rowterm - m_run;
#pragma unroll
              for (int q4 = 0; q4 < 4; ++q4) { const f32x4 c0 = *(const LAS f32x4*)(ctp + 8 * q4), c1 = *(const LAS f32x4*)(ctp + 32 + 8 * q4);
#pragma unroll
                  for (int i = 0; i < 4; ++i) { s0[4 * q4 + i] = rb + c0[i]; s1[4 * q4 + i] = rb + c1[i]; } } }
            bf16x8 fr[8];
            const LAS unsigned char* ka = kb + cc * KT_PITCH + 16 * h;
            const LAS unsigned char* va = vb + cc * VT_PITCH + 16 * h;
#pragma unroll
            for (int ks = 0; ks < 4; ++ks) { fr[2 * ks] = *(const LAS bf16x8*)(ka + 32 * ks); fr[2 * ks + 1] = *(const LAS bf16x8*)(ka + 32 * KT_PITCH + 32 * ks); }
            __builtin_amdgcn_sched_barrier(0);
#pragma unroll
            for (int ks = 0; ks < 8; ++ks) {
                s0 = __builtin_amdgcn_mfma_f32_32x32x16_bf16(fr[2 * (ks & 3)], qf[ks], s0, 0, 0, 0);
                s1 = __builtin_amdgcn_mfma_f32_32x32x16_bf16(fr[2 * (ks & 3) + 1], qf[ks], s1, 0, 0, 0);
                __builtin_amdgcn_sched_barrier(0);
                if (ks < 4) { fr[2 * ks] = *(const LAS bf16x8*)(ka + 32 * (ks + 4)); fr[2 * ks + 1] = *(const LAS bf16x8*)(ka + 32 * KT_PITCH + 32 * (ks + 4)); }
                else {
#pragma unroll
                    for (int e = 0; e < 2; ++e) { const int f = 2 * (ks - 4) + e; fr[f] = *(const LAS bf16x8*)(va + (f >> 2) * 32 * VT_PITCH + (f & 3) * 32); } }
                __builtin_amdgcn_sched_barrier(0);
            }
            const bool full = (VAR == 3) || ((k0 + 63 <= qlo) && (MODE || (k0 + (int)A.Wn >= qhi)));
            if (!full) { const int dq = qm - k0 - 4 * h; const float NEG = -__builtin_inff();
#pragma unroll
                for (int r = 0; r < 16; ++r) { const int ko = (r & 3) + 8 * (r >> 2);
                    if ((unsigned)(dq - ko) > A.Wn) s0[r] = NEG;
                    if ((unsigned)(dq - ko - 32) > A.Wn) s1[r] = NEG; } }
            float mx = fmaxf(s0[0], s1[0]);
            if (VAR != 3) {
#pragma unroll
            for (int r = 1; r < 16; ++r) mx = fmaxf(mx, fmaxf(s0[r], s1[r]));
            mx = pair_max(mx); }
            if (VAR != 3 && !__all(mx <= ATT_THR)) {
                const float shift = (mx > ATT_THR) ? mx : 0.f, alpha = __builtin_amdgcn_exp2f(-shift);
                m_run += shift; l_run *= alpha;
#pragma unroll
                for (int r = 0; r < 16; ++r) { s0[r] -= shift; s1[r] -= shift; }
#pragma unroll
                for (int d = 0; d < 4; ++d)
#pragma unroll
                    for (int r = 0; r < 16; ++r) oacc[d][r] *= alpha;
            }
            float ps = 0.f;
#pragma unroll
            for (int r = 0; r < 16; ++r) { if (VAR != 3) { s0[r] = __builtin_amdgcn_exp2f(s0[r]); s1[r] = __builtin_amdgcn_exp2f(s1[r]); ps += s0[r] + s1[r]; } }
            if (VAR == 3) ps = s0[0];
            l_run += ps;
            bf16x8 pb[4];
            pb[0] = pack8(s0[0], s0[1], s0[2], s0[3], s0[4], s0[5], s0[6], s0[7]);
            pb[1] = pack8(s0[8], s0[9], s0[10], s0[11], s0[12], s0[13], s0[14], s0[15]);
            pb[2] = pack8(s1[0], s1[1], s1[2], s1[3], s1[4], s1[5], s1[6], s1[7]);
            pb[3] = pack8(s1[8], s1[9], s1[10], s1[11], s1[12], s1[13], s1[14], s1[15]);
            __builtin_amdgcn_sched_barrier(0);
#pragma unroll
            for (int d = 0; d < 4; ++d) {
#pragma unroll
                for (int kk = 0; kk < 4; ++kk) oacc[d] = __builtin_amdgcn_mfma_f32_32x32x16_bf16(fr[4 * (d & 1) + kk], pb[kk], oacc[d], 0, 0, 0);
                __builtin_amdgcn_sched_barrier(0);
                if (d < 2) {
#pragma unroll
                    for (int kk = 0; kk < 4; ++kk) fr[4 * d + kk] = *(const LAS bf16x8*)(va + (d + 2) * 32 * VT_PITCH + kk * 32); }
                __builtin_amdgcn_sched_barrier(0);
            }
        }
        if (more && VAR != 2 && VAR != 3) MK_ATT_WRITE((t + 1) & 1);
        half_barrier(hcnt, gen, lane);
    }
#undef MK_ATT_LOAD
#undef MK_KT
#undef MK_ATT_WRITE
    const float lt = pair_sum(l_run), inv = 1.0f / lt;
    bf16_t* op = H.o + (size_t)qm * A.ostride + 8 * h;
#pragma unroll
    for (int d = 0; d < 4; ++d)
#pragma unroll
        for (int rq = 0; rq < 4; rq += 2) {
            const unsigned a0 = pk2(oacc[d][4 * rq] * inv, oacc[d][4 * rq + 1] * inv), a1 = pk2(oacc[d][4 * rq + 2] * inv, oacc[d][4 * rq + 3] * inv);
            const unsigned b0 = pk2(oacc[d][4 * rq + 4] * inv, oacc[d][4 * rq + 5] * inv), b1 = pk2(oacc[d][4 * rq + 6] * inv, oacc[d][4 * rq + 7] * inv);
            auto r0 = __builtin_amdgcn_permlane32_swap(a0, b0, false, false); auto r1 = __builtin_amdgcn_permlane32_swap(a1, b1, false, false);
            u32x4 w = {r0[0], r1[0], r0[1], r1[1]};
            *(u32x4*)(op + 32 * d + 8 * rq) = w;
        }
    if (MODE == 0 && h == 0) H.lse[(size_t)qm * A.lstride] = (m_run + log2f(lt)) * LN2;
}

__device__ __forceinline__ void dil_attn_phase(const Ctx& c, const bf16_t* QKV, bf16_t* OG, float* LSE) {
    const int hf = c.wave >> 2; int gen = 0;
    if (c.tid < 32) ((LAS unsigned*)(c.lds + ATT_CNT_OFF))[c.tid] = 0u;
    __syncthreads();
    if (hf) { __builtin_amdgcn_s_sleep(24); }
#pragma unroll 1
    for (int it = c.bid; it < NBATCH * 3 * 8 * 16; it += c.G) {
        const int rq = (it + (it >> 8)) & 15, hp = (it >> 4) & 7, rest = it >> 7, g = rest % 3, b = rest / 3;
        const int dil = (g == 0) ? 1 : (g == 1 ? 4 : 16), ntile = 16 / dil, r = rq / ntile, qt = rq - r * ntile;
        const int head = 2 * hp + hf;
        const size_t row0 = (size_t)b * SEQ + r;
        AttnHalf H; AttnTile A;
        const bf16_t* base = QKV + row0 * A_COLS + g * 6144 + head * 128;
        H.q = base; H.k = base + 2048; H.v = base + 4096;
        H.o = OG + ((size_t)g * T + row0) * 2048 + head * 128;
        H.lse = LSE + ((size_t)g * T + row0) * 16 + head;
        H.c2 = nullptr; H.c2n = nullptr;
        H.sd2 = exp2f(-0.5f * (float)(head + 1)) * (float)dil * LOG2E;
        A.rstride = (size_t)dil * A_COLS; A.ostride = (size_t)dil * 2048; A.lstride = (size_t)dil * 16;
        A.q0 = 128 * qt; A.kt_lo = qt ? (2 * qt - 2) : 0; A.kt_hi = 2 * qt + 2; A.Wn = 128u; A.desc = 0;
        attn_tile<0>(c, H, A, gen);
    }
    __syncthreads();
}
template <int VAR = 0>
__device__ __forceinline__ void fox_attn_phase(const Ctx& c, const bf16_t* QKV, const float* C2, const float* C2N, bf16_t* O, bool xmode, int xx, int xr) {
    const int hf = c.wave >> 2; int gen = 0;
    if (c.tid < 32) ((LAS unsigned*)(c.lds + ATT_CNT_OFF))[c.tid] = 0u;
    __syncthreads();
    if (hf) { __builtin_amdgcn_s_sleep(24); }
#pragma unroll 1
    for (int n = 0;; ++n) {
        const int i = n >> 1; int it;
        if (xmode) { if (i >= 4) break; it = ((xx * 4 + (xr >> 3)) + 32 * i) * 8 + (xr & 7); }
        else { it = c.bid + i * c.G; if (it >= NBATCH * 16 * 8) break; }
        const int x0 = it & 7, hp = (it >> 3) & 15, b = it >> 7;
        const int x = (n & 1) ? 15 - x0 : x0;
        const int head = 2 * hp + hf;
        const size_t row0 = (size_t)b * SEQ;
        AttnHalf H; AttnTile A;
        const bf16_t* base = QKV + row0 * FOXW + head * 128;
        H.q = base; H.k = base + 4096; H.v = base + 8192;
        H.o = O + row0 * 4096 + head * 128; H.lse = nullptr; H.c2 = C2 + ((size_t)b * 32 + head) * SEQ; H.c2n = C2N + ((size_t)b * 32 + head) * SEQ; H.sd2 = 0.f;
        A.rstride = FOXW; A.ostride = 4096; A.lstride = 0; A.Wn = 0x7fffffffu; A.kt_lo = 0;
        A.q0 = 128 * x; A.kt_hi = 2 * x + 2; A.desc = (n & 1);
        attn_tile<1, VAR>(c, H, A, gen);
    }
    __syncthreads();
}

template <bool F32BASE>
struct EpiRes {
    static constexpr bool PERM = true, AFTER_DRAIN = false;
    const void* base; bf16_t* C; int ldc; float alpha;
    __device__ __forceinline__ void operator()(const f32x4 (&acc)[2][2][4][2], const pg8::Unit& u, int wr, int wc, int fr, int fq) const {
        const int row0 = u.pm * 256 + wr * 64 + fr, col0 = u.pn * 256 + wc * 32 + 8 * fq;
#pragma unroll
        for (int ai = 0; ai < 2; ++ai)
#pragma unroll
            for (int m = 0; m < 4; ++m) { const size_t off = (size_t)(row0 + ai * 128 + m * 16) * ldc + col0;
#pragma unroll
                for (int bj = 0; bj < 2; ++bj) { f32x4 b0, b1;
                    if (F32BASE) { b0 = *(const f32x4*)((const float*)base + off + bj * 128); b1 = *(const f32x4*)((const float*)base + off + bj * 128 + 4); }
                    else { const u32x4 w = *(const u32x4*)((const bf16_t*)base + off + bj * 128); b0 = (f32x4){bf_lo(w[0]), bf_hi(w[0]), bf_lo(w[1]), bf_hi(w[1])}; b1 = (f32x4){bf_lo(w[2]), bf_hi(w[2]), bf_lo(w[3]), bf_hi(w[3])}; }
                    const f32x4 o0 = b0 * alpha + acc[ai][bj][m][0], o1 = b1 * alpha + acc[ai][bj][m][1];
                    u32x4 w = {pk2(o0[0], o0[1]), pk2(o0[2], o0[3]), pk2(o1[0], o1[1]), pk2(o1[2], o1[3])};
                    *(u32x4*)(C + off + bj * 128) = w; } }
    }
};
struct EpiFox {
    static constexpr bool PERM = true, AFTER_DRAIN = false;
    bf16_t* O; float* FG;
    __device__ __forceinline__ void operator()(const f32x4 (&acc)[2][2][4][2], const pg8::Unit& u, int wr, int wc, int fr, int fq) const {
        const int row0 = u.pm * 256 + wr * 64 + fr;
        if (u.pn < 48) {
            const int col0 = u.pn * 256 + wc * 32 + 8 * fq;
#pragma unroll
            for (int ai = 0; ai < 2; ++ai)
#pragma unroll
                for (int m = 0; m < 4; ++m) { bf16_t* rowp = O + (size_t)(row0 + ai * 128 + m * 16) * FOXW + col0;
#pragma unroll
                    for (int bj = 0; bj < 2; ++bj) { const f32x4 v0 = acc[ai][bj][m][0], v1 = acc[ai][bj][m][1];
                        u32x4 w = {pk2(v0[0], v0[1]), pk2(v0[2], v0[3]), pk2(v1[0], v1[1]), pk2(v1[2], v1[3])};
                        *(u32x4*)(rowp + bj * 128) = w; } }
        } else if (wc == 0) {
#pragma unroll
            for (int ai = 0; ai < 2; ++ai)
#pragma unroll
                for (int m = 0; m < 4; ++m) { float* rowp = FG + (size_t)(row0 + ai * 128 + m * 16) * 32 + 8 * fq;
                    *(f32x4*)(rowp) = acc[ai][0][m][0]; *(f32x4*)(rowp + 4) = acc[ai][0][m][1]; }
        }
    }
};

constexpr int SK_PITCH = 272, SK_BYTES = 2 * 128 * SK_PITCH;
constexpr int SEL_IDX_OFF = SK_BYTES, SEL_GATE_OFF = SEL_IDX_OFF + 32 * 128 * 4, WBUF_OFF = SEL_GATE_OFF + 32 * 128 * 4, PEER_LDS_END = WBUF_OFF + 8 * 128 * 4;
static_assert(PEER_LDS_END <= LDS_BARW, "peer LDS");
struct CandTab { int i[50], j[50]; };
__host__ __device__ constexpr CandTab make_cand() { CandTab t{}; int s = 0; for (int i = 0; i < 16; ++i) for (int j = 0; j < 16; ++j) if ((i + 1) * (j + 1) <= 16) { t.i[s] = i; t.j[s] = j; ++s; } return t; }
__device__ __forceinline__ int f2ord(float f) { const int b = __float_as_int(f); return b ^ ((b >> 31) & 0x7fffffff); }
__device__ __forceinline__ float ord2f(int o) { return __int_as_float(o ^ ((o >> 31) & 0x7fffffff)); }
__device__ __forceinline__ float gelu_exact(float v) { return 0.5f * v * (1.0f + erff(v * 0.70710678118654752f)); }

#define MK_CE(a, b) do { const int hi_ = (a) > (b) ? (a) : (b), lo_ = (a) > (b) ? (b) : (a); (a) = hi_; (b) = lo_; } while (0)
template <int BASE> __device__ __forceinline__ void sort16_desc(int (&v)[64]) {
#pragma unroll
    for (int k = 2; k <= 16; k <<= 1)
#pragma unroll
        for (int j = k >> 1; j > 0; j >>= 1)
#pragma unroll
            for (int i = 0; i < 16; ++i) { const int l = i ^ j; if (l > i) { if ((i & k) == 0) MK_CE(v[BASE + i], v[BASE + l]); else MK_CE(v[BASE + l], v[BASE + i]); } }
}
template <int A, int B> __device__ __forceinline__ void merge_top16(int (&v)[64]) {
#pragma unroll
    for (int i = 0; i < 16; ++i) v[A + i] = v[A + i] > v[B + 15 - i] ? v[A + i] : v[B + 15 - i];
#pragma unroll
    for (int j = 8; j > 0; j >>= 1)
#pragma unroll
        for (int i = 0; i < 16; ++i) { const int l = i ^ j; if (l > i) MK_CE(v[A + i], v[A + l]); }
}
__device__ __forceinline__ void top16_of_64(int (&v)[64]) {
    sort16_desc<0>(v); sort16_desc<16>(v); sort16_desc<32>(v); sort16_desc<48>(v);
    merge_top16<0, 16>(v); merge_top16<32, 48>(v); merge_top16<0, 32>(v);
}
constexpr int LTAB_OFF = WBUF_OFF + 8 * 128 * 4, PEER_LDS_END2 = LTAB_OFF + 8 * 32 * 32;
static_assert(PEER_LDS_END2 <= LDS_BARW, "peer LDS 2");

__device__ __forceinline__ void peer_select(const Ctx& c, const bf16_t* __restrict__ QP, int tok0, unsigned short* __restrict__ IDXg, float* __restrict__ GATEg) {
    int lane = c.lane; asm volatile("" : "+v"(lane));
    const int h = lane >> 5, cc = lane & 31, head = c.wave;
    const bf16_t* qrow = QP + (size_t)(tok0 + cc) * 2048 + head * 256 + 8 * h;
    int L[2][16];
#pragma unroll
    for (int p = 0; p < 2; ++p) {
        bf16x8 qf[8];
#pragma unroll
        for (int ks = 0; ks < 8; ++ks) qf[ks] = *(const bf16x8*)(qrow + p * 128 + 16 * ks);
        f32x16 acc[4];
#pragma unroll
        for (int kb = 0; kb < 4; ++kb)
#pragma unroll
            for (int r = 0; r < 16; ++r) acc[kb][r] = 0.f;
        const LAS unsigned char* ska = c.lds + p * (128 * SK_PITCH) + cc * SK_PITCH + 16 * h;
#pragma unroll
        for (int kb = 0; kb < 4; ++kb)
#pragma unroll
            for (int ks = 0; ks < 8; ++ks) { const bf16x8 a = *(const LAS bf16x8*)(ska + kb * 32 * SK_PITCH + 32 * ks); acc[kb] = __builtin_amdgcn_mfma_f32_32x32x16_bf16(a, qf[ks], acc[kb], 0, 0, 0); }
        int pk[64];
#pragma unroll
        for (int kb = 0; kb < 4; ++kb)
#pragma unroll
            for (int r = 0; r < 16; ++r) { const int n = 32 * kb + (r & 3) + 8 * (r >> 2); pk[16 * kb + r] = (f2ord(acc[kb][r]) & ~127) | (127 - n - 4 * h); }
        top16_of_64(pk);
        int lo16[16], up16[16];
#pragma unroll
        for (int i = 0; i < 16; ++i) { auto t = __builtin_amdgcn_permlane32_swap((unsigned)pk[i], (unsigned)pk[i], false, false); lo16[i] = (int)t[0]; up16[i] = (int)t[1]; }
#pragma unroll
        for (int i = 0; i < 16; ++i) L[p][i] = lo16[i] > up16[15 - i] ? lo16[i] : up16[15 - i];
#pragma unroll
        for (int j = 8; j > 0; j >>= 1)
#pragma unroll
            for (int i = 0; i < 16; ++i) { const int l = i ^ j; if (l > i) MK_CE(L[p][i], L[p][l]); }
    }
    LAS unsigned char* tab = c.lds + LTAB_OFF + (c.wave * 32 + cc) * 32;
    if (h == 0) {
        u32x4 w0, w1;
#pragma unroll
        for (int q4 = 0; q4 < 4; ++q4) {
            w0[q4] = (unsigned)(127 - (L[0][4 * q4] & 127)) | ((unsigned)(127 - (L[0][4 * q4 + 1] & 127)) << 8) | ((unsigned)(127 - (L[0][4 * q4 + 2] & 127)) << 16) | ((unsigned)(127 - (L[0][4 * q4 + 3] & 127)) << 24);
            w1[q4] = (unsigned)(127 - (L[1][4 * q4] & 127)) | ((unsigned)(127 - (L[1][4 * q4 + 1] & 127)) << 8) | ((unsigned)(127 - (L[1][4 * q4 + 2] & 127)) << 16) | ((unsigned)(127 - (L[1][4 * q4 + 3] & 127)) << 24); }
        *(LAS u32x4*)(tab) = w0; *(LAS u32x4*)(tab + 16) = w1;
    }
    constexpr CandTab CT = make_cand();
    int pk2v[64];
#pragma unroll
    for (int s = 0; s < 64; ++s) {
        if (s < 50) { const int i = CT.i[s], j = CT.j[s];
            const float sum = ord2f(L[0][i] & ~127) + ord2f(L[1][j] & ~127);
            pk2v[s] = (f2ord(sum) & ~255) | (255 - (16 * i + j)); }
        else pk2v[s] = (int)0x80000000;
    }
    top16_of_64(pk2v);
    MK_LDS_WAIT();
    float tops[16]; int eidx[16];
#pragma unroll
    for (int it = 0; it < 16; ++it) { const int code = 255 - (pk2v[it] & 255); tops[it] = ord2f(pk2v[it] & ~255);
        eidx[it] = (int)tab[code >> 4] * 128 + (int)tab[16 + (code & 15)]; }
    { const float t0 = tops[0]; float den = 0.f;
#pragma unroll
      for (int it = 0; it < 16; ++it) { tops[it] = __expf(tops[it] - t0); den += tops[it]; }
      const float rden = 1.0f / den;
#pragma unroll
      for (int it = 0; it < 16; ++it) tops[it] *= rden; }
    unsigned short* si = IDXg + (size_t)(tok0 + cc) * 128 + head * 16;
    float* sg = GATEg + (size_t)(tok0 + cc) * 128 + head * 16;
    if (h == 0) {
        u32x4 w0, w1;
#pragma unroll
        for (int q4 = 0; q4 < 4; ++q4) { w0[q4] = (unsigned)eidx[2 * q4] | ((unsigned)eidx[2 * q4 + 1] << 16); w1[q4] = (unsigned)eidx[8 + 2 * q4] | ((unsigned)eidx[8 + 2 * q4 + 1] << 16); }
        *(u32x4*)(si) = w0; *(u32x4*)(si + 8) = w1;
    } else {
#pragma unroll
        for (int q4 = 0; q4 < 4; ++q4) { f32x4 w = {tops[4 * q4], tops[4 * q4 + 1], tops[4 * q4 + 2], tops[4 * q4 + 3]}; *(f32x4*)(sg + 4 * q4) = w; }
    }
}

typedef float f32x2 __attribute__((ext_vector_type(2)));
constexpr int NSLICE = 32, TOKBLK = 512;
#define MK_P_LOAD_ROWS(R, tl, Tb) do { const u32x4 j0_ = *(const LAS u32x4*)(ilds + (tl) * 256), j1_ = *(const LAS u32x4*)(ilds + (tl) * 256 + 16); \
        _Pragma("unroll") for (int w_ = 0; w_ < 4; ++w_) { R[2 * w_] = *(const u32x4*)((Tb) + (size_t)(j0_[w_] & 0xffffu) * 128); R[2 * w_ + 1] = *(const u32x4*)((Tb) + (size_t)(j0_[w_] >> 16) * 128); \
                                                           R[8 + 2 * w_] = *(const u32x4*)((Tb) + (size_t)(j1_[w_] & 0xffffu) * 128); R[8 + 2 * w_ + 1] = *(const u32x4*)((Tb) + (size_t)(j1_[w_] >> 16) * 128); } } while (0)
#define MK_P_FILL_IDX() do { const u32x4* src_ = (const u32x4*)(IDX + (size_t)tok0 * 128) + lane; LAS u32x4* dl_ = (LAS u32x4*)(c.lds + c.wave * 16384) + lane; \
        u32x4 tmp_[16]; _Pragma("unroll") for (int i_ = 0; i_ < 16; ++i_) tmp_[i_] = src_[64 * i_]; \
        _Pragma("unroll") for (int i_ = 0; i_ < 16; ++i_) dl_[64 * i_] = tmp_[i_]; MK_LDS_WAIT(); } while (0)

__device__ __forceinline__ void peer_pass1_unit(const Ctx& c, int slice, int tok0, const unsigned char* __restrict__ Us, const unsigned short* __restrict__ IDX, const unsigned char* __restrict__ X8, unsigned* __restrict__ PART, bool fill) {
    int lane = c.lane; asm volatile("" : "+v"(lane));
    const int p = lane >> 3, q = lane & 7;
    const unsigned char* Tb = Us + (size_t)slice * 16384 * 128 + q * 16;
    const LAS unsigned char* ilds = c.lds + c.wave * 16384 + p * 32;
    const unsigned char* xp = X8 + (size_t)tok0 * DM + slice * 128 + 16 * q;
    unsigned* pp = PART + ((size_t)slice * T + tok0) * 64 + 8 * p + q;
    if (fill) MK_P_FILL_IDX();
    u32x4 XA[2], XB[2], RA[16], RB[16];
#define MK_P1_LOAD_X(X, t) do { X[0] = *(const u32x4*)(xp + (size_t)(t) * DM); X[1] = *(const u32x4*)(xp + (size_t)((t) + 1) * DM); } while (0)
#define MK_P1_COMPUTE(R, Xv, t) do { int r_[16]; \
        _Pragma("unroll") for (int i_ = 0; i_ < 16; ++i_) { int a_ = 0; \
            _Pragma("unroll") for (int w_ = 0; w_ < 4; ++w_) a_ = __builtin_amdgcn_sdot4((int)R[i_][w_], (int)Xv[w_], a_, false); \
            a_ += __builtin_amdgcn_mov_dpp(a_, 0xB1, 0xf, 0xf, true); a_ += __builtin_amdgcn_mov_dpp(a_, 0x4E, 0xf, 0xf, true); a_ += __builtin_amdgcn_mov_dpp(a_, 0x141, 0xf, 0xf, true); r_[i_] = a_; } \
        int v0_ = r_[0], v1_ = r_[1]; \
        _Pragma("unroll") for (int i_ = 1; i_ < 8; ++i_) { v0_ = (q == i_) ? r_[2 * i_] : v0_; v1_ = (q == i_) ? r_[2 * i_ + 1] : v1_; } \
        pp[(size_t)(t) * 64] = pk2((float)v0_, (float)v1_); } while (0)
    constexpr int NT = TOKBLK / 8;
    MK_P1_LOAD_X(XA, 0);
    MK_P_LOAD_ROWS(RA, 0, Tb);
#pragma unroll 1
    for (int t = 0; t < NT; t += 4) {
        MK_P1_LOAD_X(XB, t + 2);
        MK_P_LOAD_ROWS(RB, t + 1, Tb); MK_P1_COMPUTE(RA, XA[0], t);
        MK_P_LOAD_ROWS(RA, t + 2, Tb); MK_P1_COMPUTE(RB, XA[1], t + 1);
        if (t + 4 < NT) MK_P1_LOAD_X(XA, t + 4);
        MK_P_LOAD_ROWS(RB, t + 3, Tb); MK_P1_COMPUTE(RA, XB[0], t + 2);
        if (t + 4 < NT) MK_P_LOAD_ROWS(RA, t + 4, Tb);
        MK_P1_COMPUTE(RB, XB[1], t + 3);
    }
#undef MK_P1_LOAD_X
#undef MK_P1_COMPUTE
}
__device__ __forceinline__ void peer_pass2_unit(const Ctx& c, int slice, int tok0, const unsigned char* __restrict__ Vs, const unsigned short* __restrict__ IDX, const unsigned char* __restrict__ W8, const float* __restrict__ WS, unsigned* __restrict__ OUT, bool fill) {
    int lane = c.lane; asm volatile("" : "+v"(lane));
    const int p = lane >> 3, q = lane & 7;
    const unsigned char* Tb = Vs + (size_t)slice * 16384 * 128 + q * 16;
    const LAS unsigned char* ilds = c.lds + c.wave * 16384 + p * 32;
    const unsigned char* wp = W8 + (size_t)tok0 * 128 + 16 * p;
    const float* wsp = WS + tok0;
    unsigned* op = OUT + (size_t)tok0 * (DM / 2) + slice * 64 + 8 * q + p;
    const bool b3 = (lane & 8) != 0;
    if (fill) MK_P_FILL_IDX();
    u32x4 WA[2], WB[2], RA[16], RB[16]; float SA[2], SB[2];
#define MK_P2_LOAD_W(Wt, St, t) do { Wt[0] = *(const u32x4*)(wp + (size_t)(t) * 128); Wt[1] = *(const u32x4*)(wp + (size_t)((t) + 1) * 128); St[0] = wsp[(t)]; St[1] = wsp[(t) + 1]; } while (0)
#define MK_P2_COMPUTE(R, Wv, sc, t) do { int acc_[16]; \
        _Pragma("unroll") for (int m_ = 0; m_ < 16; ++m_) acc_[m_] = 0; \
        _Pragma("unroll") for (int g_ = 0; g_ < 4; ++g_) { const int wq_ = (int)Wv[g_];     \
            _Pragma("unroll") for (int w_ = 0; w_ < 4; ++w_) { const unsigned a_ = R[4 * g_][w_], b_ = R[4 * g_ + 1][w_], c_ = R[4 * g_ + 2][w_], d_ = R[4 * g_ + 3][w_]; \
                const unsigned p0_ = __builtin_amdgcn_perm(b_, a_, 0x05010400u), p1_ = __builtin_amdgcn_perm(b_, a_, 0x07030602u), p2_ = __builtin_amdgcn_perm(d_, c_, 0x05010400u), p3_ = __builtin_amdgcn_perm(d_, c_, 0x07030602u); \
                acc_[4 * w_ + 0] = __builtin_amdgcn_sdot4((int)__builtin_amdgcn_perm(p2_, p0_, 0x05040100u), wq_, acc_[4 * w_ + 0], false); \
                acc_[4 * w_ + 1] = __builtin_amdgcn_sdot4((int)__builtin_amdgcn_perm(p2_, p0_, 0x07060302u), wq_, acc_[4 * w_ + 1], false); \
                acc_[4 * w_ + 2] = __builtin_amdgcn_sdot4((int)__builtin_amdgcn_perm(p3_, p1_, 0x05040100u), wq_, acc_[4 * w_ + 2], false); \
                acc_[4 * w_ + 3] = __builtin_amdgcn_sdot4((int)__builtin_amdgcn_perm(p3_, p1_, 0x07060302u), wq_, acc_[4 * w_ + 3], false); } } \
          \
        int u_[8]; _Pragma("unroll") for (int i_ = 0; i_ < 8; ++i_) { auto s_ = __builtin_amdgcn_permlane32_swap((unsigned)acc_[i_], (unsigned)acc_[i_ + 8], false, false); u_[i_] = (int)s_[0] + (int)s_[1]; } \
        int t_[4]; _Pragma("unroll") for (int i_ = 0; i_ < 4; ++i_) { auto s_ = __builtin_amdgcn_permlane16_swap((unsigned)u_[i_], (unsigned)u_[i_ + 4], false, false); t_[i_] = (int)s_[0] + (int)s_[1]; } \
        const int k0_ = b3 ? t_[2] : t_[0], s0_ = b3 ? t_[0] : t_[2], k1_ = b3 ? t_[3] : t_[1], s1_ = b3 ? t_[1] : t_[3]; \
        const int rx_ = k0_ + __builtin_amdgcn_mov_dpp(s0_, 0x128, 0xf, 0xf, true), ry_ = k1_ + __builtin_amdgcn_mov_dpp(s1_, 0x128, 0xf, 0xf, true); \
        op[(size_t)(t) * (DM / 2)] = pk2((float)rx_ * (sc), (float)ry_ * (sc)); } while (0)
    constexpr int NT = TOKBLK / 8;
    MK_P2_LOAD_W(WA, SA, 0);
    MK_P_LOAD_ROWS(RA, 0, Tb);
#pragma unroll 1
    for (int t = 0; t < NT; t += 4) {
        MK_P2_LOAD_W(WB, SB, t + 2);
        MK_P_LOAD_ROWS(RB, t + 1, Tb); MK_P2_COMPUTE(RA, WA[0], SA[0], t);
        MK_P_LOAD_ROWS(RA, t + 2, Tb); MK_P2_COMPUTE(RB, WA[1], SA[1], t + 1);
        if (t + 4 < NT) MK_P2_LOAD_W(WA, SA, t + 4);
        MK_P_LOAD_ROWS(RB, t + 3, Tb); MK_P2_COMPUTE(RA, WB[0], SB[0], t + 2);
        if (t + 4 < NT) MK_P_LOAD_ROWS(RA, t + 4, Tb);
        MK_P2_COMPUTE(RB, WB[1], SB[1], t + 3);
    }
#undef MK_P2_LOAD_W
#undef MK_P2_COMPUTE
}
#undef MK_P_LOAD_ROWS
#undef MK_P_FILL_IDX

struct PeerDeal { bool xcd_mode; int x, r; };
__device__ __forceinline__ int deal_xcd(const PeerDeal& d) { return d.x; }
__device__ __forceinline__ int deal_rank(const PeerDeal& d) { return d.r; }
__device__ __forceinline__ PeerDeal peer_deal(const Ctx& c, unsigned* xc, unsigned myx, unsigned myrank, bool census_done) {
    bool ok = census_done && (c.G == 256);
#pragma unroll
    for (int j = 0; j < 16; ++j) { const unsigned n = __hip_atomic_load(xc + j, __ATOMIC_RELAXED, __HIP_MEMORY_SCOPE_AGENT); ok = ok && (n == ((j < 8) ? 32u : 0u)); }
    PeerDeal d; d.xcd_mode = ok && myx < 8u && myrank < 32u; d.x = (int)myx; d.r = (int)myrank; return d;
}
template <int PASS>
__device__ __forceinline__ void peer_pass_phase(const Ctx& c, const PeerDeal& d, const unsigned char* Ts, const unsigned short* IDX, const unsigned char* X8, const unsigned char* W8, const float* WS, void* DST) {
#pragma unroll 1
    for (int i = 0;; ++i) {
        int slice, blk;
        if (d.xcd_mode) { if (i >= 4) break; slice = d.x + 8 * i; blk = d.r; }
        else { const int u = c.bid + i * c.G; if (u >= NSLICE * (T / TOKBLK)) break; slice = u / (T / TOKBLK); blk = u % (T / TOKBLK); }
        const int tok0 = blk * TOKBLK + c.wave * (TOKBLK / 8);
        const bool fill = !(d.xcd_mode && i > 0);
        if (PASS == 1) peer_pass1_unit(c, slice, tok0, Ts, IDX, X8, (unsigned*)DST, fill); else peer_pass2_unit(c, slice, tok0, Ts, IDX, W8, WS, (unsigned*)DST, fill);
    }
}
__device__ __forceinline__ void peer_act_phase(const Ctx& c, const unsigned* __restrict__ PART, const unsigned short* __restrict__ IDX, const float* __restrict__ GATE, const float* __restrict__ SU, const float* __restrict__ SV, const float* __restrict__ XS, unsigned short* __restrict__ W8, float* __restrict__ WS) {
    const size_t n2 = (size_t)T * 64, stride = (size_t)c.G * NTHREADS;
    for (size_t id = (size_t)c.bid * NTHREADS + c.tid; id < n2; id += stride) {
        float s0 = 0.f, s1 = 0.f;
#pragma unroll 8
        for (int j = 0; j < NSLICE; ++j) { const unsigned w = PART[(size_t)j * n2 + id]; s0 += bf_lo(w); s1 += bf_hi(w); }
        const unsigned ee = *(const unsigned*)(IDX + 2 * id); const unsigned e0 = ee & 0xffffu, e1 = ee >> 16;
        const float g0 = GATE[2 * id], g1 = GATE[2 * id + 1];
        const size_t tok = id >> 6; const float xs = XS[tok];
        const float w0 = g0 * gelu_exact(s0 * SU[e0] * xs) * SV[e0], w1 = g1 * gelu_exact(s1 * SU[e1] * xs) * SV[e1];
        const float mx = wave_max(fmaxf(fabsf(w0), fabsf(w1)));
        const bool ok = (mx > 1e-30f) && (mx < 1e30f);
        const float scale = ok ? 127.0f / mx : 0.f;
        if (c.lane == 0) WS[tok] = ok ? mx * (1.0f / 127.0f) : 0.f;
        const int q0 = (int)__builtin_rintf(w0 * scale), q1 = (int)__builtin_rintf(w1 * scale);
        W8[id] = (unsigned short)(((unsigned)q0 & 0xffu) | (((unsigned)q1 & 0xffu) << 8));
    }
}
__device__ __forceinline__ void ln_add_phase(const Ctx& c, const bf16_t* Y, const float* __restrict__ g1, const float* __restrict__ b1, const bf16_t* __restrict__ ADD, float* dst, bf16_t* Hb, const float* __restrict__ g, const float* __restrict__ b, unsigned char* X8 = nullptr, float* XS = nullptr) {
    for (int row = c.bid * 8 + c.wave; row < T; row += c.G * 8) {
        int ln = c.lane; asm volatile("" : "+v"(ln));
        const size_t off = (size_t)row * DM + 4 * ln;
        f32x4 v[16]; float s = 0.f;
#pragma unroll
        for (int j = 0; j < 16; ++j) { const u32x2 hw = *(const u32x2*)(Y + off + 256 * j); v[j] = (f32x4){bf_lo(hw[0]), bf_hi(hw[0]), bf_lo(hw[1]), bf_hi(hw[1])}; s += (v[j][0] + v[j][1]) + (v[j][2] + v[j][3]); }
        float mean = wave_sum(s) * (1.f / DM), qq = 0.f;
#pragma unroll
        for (int j = 0; j < 16; ++j) { v[j] = v[j] - mean; qq += (v[j][0] * v[j][0] + v[j][1] * v[j][1]) + (v[j][2] * v[j][2] + v[j][3] * v[j][3]); }
        float rstd = 1.0f / sqrtf(wave_sum(qq) * (1.f / DM) + LN_EPS);
        s = 0.f;
#pragma unroll
        for (int j = 0; j < 16; ++j) { if ((j & 1) == 0) asm volatile("" ::: "memory");
            const f32x4 gg = *(const f32x4*)(g1 + 4 * ln + 256 * j), bb = *(const f32x4*)(b1 + 4 * ln + 256 * j);
            const u32x2 aw = *(const u32x2*)(ADD + off + 256 * j); const f32x4 av = {bf_lo(aw[0]), bf_hi(aw[0]), bf_lo(aw[1]), bf_hi(aw[1])};
            v[j] = (v[j] * rstd * gg + bb) * DN_ALPHA + av; s += (v[j][0] + v[j][1]) + (v[j][2] + v[j][3]); }
        mean = wave_sum(s) * (1.f / DM); qq = 0.f;
#pragma unroll
        for (int j = 0; j < 16; ++j) { v[j] = v[j] - mean; qq += (v[j][0] * v[j][0] + v[j][1] * v[j][1]) + (v[j][2] * v[j][2] + v[j][3] * v[j][3]); }
        rstd = 1.0f / sqrtf(wave_sum(qq) * (1.f / DM) + LN_EPS);
#pragma unroll
        for (int j = 0; j < 16; ++j) { if ((j & 1) == 0) asm volatile("" ::: "memory");
            const f32x4 gg = *(const f32x4*)(g + 4 * ln + 256 * j), bb = *(const f32x4*)(b + 4 * ln + 256 * j);
            const f32x4 o = v[j] * rstd * gg + bb; if (dst) *(f32x4*)(dst + off + 256 * j) = o; v[j] = o;
            if (Hb) { u32x2 w = {pk2(o[0], o[1]), pk2(o[2], o[3])}; *(u32x2*)(Hb + off + 256 * j) = w; } }
        if (X8) {
            float mx = 0.f;
#pragma unroll
            for (int j = 0; j < 16; ++j) mx = fmaxf(mx, fmaxf(fmaxf(fabsf(v[j][0]), fabsf(v[j][1])), fmaxf(fabsf(v[j][2]), fabsf(v[j][3]))));
            mx = wave_max(mx);
            const bool ok = (mx > 1e-30f) && (mx < 1e30f);
            const float scale = ok ? 127.0f / mx : 0.f;
            if (ln == 0) XS[row] = ok ? mx * (1.0f / 127.0f) : 0.f;
#pragma unroll
            for (int j = 0; j < 16; ++j) *(unsigned*)(X8 + off + 256 * j) = pack_i8x4(v[j] * scale);
        }
    }
}

__device__ __forceinline__ void peer_select_phase(const Ctx& c, const bf16_t* QP, const float* __restrict__ subk, unsigned short* IDXg, float* GATEg) {
    for (int i = c.tid; i < 2 * 128 * 16; i += NTHREADS) { const int row = i >> 4, ch = i & 15;
        const f32x4 a = *(const f32x4*)(subk + row * 128 + ch * 8), bq = *(const f32x4*)(subk + row * 128 + ch * 8 + 4);
        u32x4 w = {pk2(a[0], a[1]), pk2(a[2], a[3]), pk2(bq[0], bq[1]), pk2(bq[2], bq[3])};
        *(LAS u32x4*)(c.lds + row * SK_PITCH + ch * 16) = w; }
    __syncthreads();
#pragma unroll 1
    for (int unit = c.bid; unit < T / 32; unit += c.G) peer_select(c, QP, unit * 32, IDXg, GATEg);
    __syncthreads();
}

constexpr int NPHASES = 27;
struct Args { const float* in[14]; float* out; unsigned char* ws; int ph_lo, ph_hi, li, pad; };

__global__ void __launch_bounds__(NTHREADS, 2) mk_fwd(Args args) {
    extern __shared__ __attribute__((aligned(16))) unsigned char lds_raw[];
    Ctx c; c.lds = (LAS unsigned char*)lds_raw; c.wave = __builtin_amdgcn_readfirstlane((int)(threadIdx.x >> 6)); c.G = gridDim.x; c.bid = blockIdx.x; c.lane = mk_hw_lane(); c.tid = c.wave * 64 + c.lane;
#define RELANE() do { c.lane = mk_hw_lane(); c.tid = c.wave * 64 + c.lane; } while (0)
    if (c.tid < 4) ((LAS unsigned*)(c.lds + LDS_BARW))[c.tid] = 0u;
    __syncthreads();
    unsigned char* ws = args.ws;
    XcdBarrier bar = xcd_barrier_post((unsigned*)(ws + WS_CTL) + (size_t)args.li * BAR_REGION_WORDS, (volatile LAS unsigned*)(c.lds + LDS_BARW), c.wave);
    const int lo = args.ph_lo, hi = args.ph_hi; const int rep_ = 1; (void)rep_;
#ifndef MK_ONLY
#define MK_ONLY -1
#endif
#define IN(k) ((MK_ONLY < 0 || MK_ONLY == (k)) && lo <= (k) && (k) < hi)
#define SEAM(k) do { if (IN((k) + 1) && !((MK_DUP == (k) || MK_DUP2 == (k)) && rep_ == 0)) xcd_barrier(bar); } while (0)
#ifndef MK_DUP
#define MK_DUP -1
#endif
#ifndef MK_DUPS
#define MK_DUPS -1
#endif
#ifndef MK_FOXVAR
#define MK_FOXVAR 0
#endif
#ifndef MK_DUP2
#define MK_DUP2 -1
#endif
#define REP(k) for (int rep_ = 0; rep_ < ((MK_DUP == (k) || MK_DUP2 == (k)) ? 2 : 1); ++rep_)
#define INP(k) ([&]() { int k_ = (k); asm volatile("" : "+s"(k_)); return args.in[k_]; }())
#define x INP(0)
#define a_w_in INP(1)
#define a_w_out INP(2)
#define b_w_in INP(3)
#define b_f_bias INP(4)
#define b_w_out INP(5)
#define peer_w_q INP(6)
#define peer_sk INP(7)
#define peer_u INP(8)
#define peer_v INP(9)
#define ln_mix_g INP(10)
#define ln_mix_b INP(11)
#define ln_ffn_g INP(12)
#define ln_ffn_b INP(13)
    bf16_t* W_IN = (bf16_t*)(ws + WS_WIN); bf16_t* W_OUT = (bf16_t*)(ws + WS_WOUT); bf16_t* W_Q = (bf16_t*)(ws + WS_WQ); unsigned char* UB = ws + WS_U; unsigned char* VB = ws + WS_V; float* SU = (float*)(ws + WS_SC); float* SV = SU + 16384;
    bf16_t* HF = (bf16_t*)(ws + WS_HF);     bf16_t* HB = (bf16_t*)(ws + WS_HB); bf16_t* QKV = (bf16_t*)(ws + WS_QKV); bf16_t* OG = (bf16_t*)(ws + WS_OG);
    float* LSE = (float*)(ws + WS_LSE); float* FG = (float*)(ws + WS_FG); float* C2 = (float*)(ws + WS_C2); bf16_t* A2 = (bf16_t*)(ws + WS_A2); bf16_t* QP = (bf16_t*)(ws + WS_QP);
    const size_t EU = (size_t)16384 * DM;

    unsigned* XC = (unsigned*)(ws + WS_CTL) + (MAX_LAUNCHES * BAR_REGION_WORDS) + (size_t)args.li * 64;
    const unsigned myx = xb_xcc_id(); unsigned myrank = 0;
    { unsigned r0 = 0; if (c.tid == 0) r0 = __hip_atomic_fetch_add(XC + myx, 1u, __ATOMIC_RELAXED, __HIP_MEMORY_SCOPE_AGENT); myrank = (unsigned)__builtin_amdgcn_readfirstlane((int)r0); }
    if (c.tid == 0) ((LAS unsigned*)(c.lds + LDS_BARW))[2] = myrank;
    __syncthreads();
    myrank = (unsigned)__builtin_amdgcn_readfirstlane((int)((LAS unsigned*)(c.lds + LDS_BARW))[2]);
    unsigned short* PIDX = (unsigned short*)(ws + WS_PIDX); float* PGATE = (float*)(ws + WS_PGATE); unsigned short* PW = (unsigned short*)(ws + WS_PW); float* WSC = (float*)(ws + WS_WS); unsigned char* WQ8 = ws + WS_WQ8; unsigned* PART = (unsigned*)(ws + WS_PART); bf16_t* POUT = (bf16_t*)(ws + WS_POUT); unsigned char* X8 = ws + WS_X8; float* XS = (float*)(ws + WS_XS);

    unsigned char* WIN8 = ws + WS_WIN8; unsigned char* WOUT8 = ws + WS_WOUT8; unsigned char* X8A = ws + WS_X8A; unsigned char* X8B = ws + WS_X8B; unsigned char* A28 = ws + WS_A28; unsigned char* OG8 = ws + WS_OG8;
    float* SBIN = (float*)(ws + WS_SC2); float* SBOUT = SBIN + 32768; float* SBQ = SBOUT + 8192; float* XSA = SBQ + 8192; float* XSB = XSA + 16384; float* SA2 = XSB + 16384; float* SOG = SA2 + 16384;

    if (IN(0)) { RELANE();
        const int r1 = (A_COLS / 32) % c.G, r2 = (A_COLS / 32 + DM / 32) % c.G;
        transpose_quant<4096>(c, a_w_in, A_COLS, WIN8, SBIN, 0); transpose_quant<2048>(c, a_w_out, DM, WOUT8, SBOUT, r1); transpose_quant<4096>(c, peer_w_q, 2048, WQ8, SBQ, r2);
        RELANE();
        const ConvDeal cd = conv_deal(c.G, c.bid, A_COLS / 32, 32, DM / 32, r1, 16, 2048 / 32, r2, 32, 16384);
        convert_rows_i8(c, peer_u, UB, SU, cd.lo + c.wave, cd.hi, 8); convert_rows_i8(c, peer_u, UB, SU, cd.covered + c.bid * 8 + c.wave, 16384, c.G * 8);
        convert_rows_i8(c, peer_v, VB, SV, c.bid * 8 + c.wave, 16384, c.G * 8); quant_rows_f32_i8(c, x, X8A, XSA, T);
        SEAM(0);
    }
    if (IN(2)) { RELANE();
        pg8::Gemm g{(const bf16_t*)X8A, (const bf16_t*)WIN8, T, A_COLS, DM / 2, c.wave, XSA, SBIN}; pg8::StaticOrder S; S.init(T, A_COLS, c.G, c.bid);
        pg8::EpiBf16<0> E{QKV, A_COLS, nullptr, 0, 0};
        pg8::gemm_phase<pg8::EpiBf16<0>, pg8::StaticOrder, false, true>(c.lds, g, S, E, nullptr);
        SEAM(2);
    }
    if (IN(3)) { RELANE(); dil_attn_phase(c, QKV, OG, LSE); SEAM(3); }
    if (IN(4)) { RELANE(); merge_phase(c, OG, LSE, A28, SA2); SEAM(4); }
    if (IN(5)) { RELANE();
        pg8::Gemm g{(const bf16_t*)A28, (const bf16_t*)WOUT8, T, DM, 2048 / 2, c.wave, SA2, SBOUT}; pg8::StaticOrder S; S.init(T, DM, c.G, c.bid);
        EpiRes<true> E{x, HF, DM, DN_ALPHA};
        pg8::gemm_phase<EpiRes<true>, pg8::StaticOrder, false, true>(c.lds, g, S, E, nullptr);
        SEAM(5);
    }
    if (IN(6)) { RELANE(); ln_phase(c, HF, nullptr, nullptr, ln_mix_g, ln_mix_b, X8, XS); SEAM(6);     }
    if (IN(7)) { RELANE();
        pg8::Gemm g{(const bf16_t*)X8, (const bf16_t*)WQ8, T, 2048, DM / 2, c.wave, XS, SBQ}; pg8::StaticOrder S; S.init(T, 2048, c.G, c.bid);
        pg8::EpiBf16<0> E{QP, 2048, nullptr, 0, 0};
        pg8::gemm_phase<pg8::EpiBf16<0>, pg8::StaticOrder, false, true>(c.lds, g, S, E, nullptr);
        SEAM(7);
    }
    if (IN(8)) { RELANE(); peer_select_phase(c, QP, peer_sk, PIDX, PGATE); SEAM(8); }
    if (IN(9)) { RELANE(); const PeerDeal d = peer_deal(c, XC, myx, myrank, IN(8)); peer_pass_phase<1>(c, d, UB, PIDX, X8, nullptr, nullptr, PART);
#if MK_DUPS == 9
        peer_pass_phase<1>(c, d, UB, PIDX, X8, nullptr, nullptr, PART);
#endif
        SEAM(9); }
    if (IN(10)) { RELANE(); peer_act_phase(c, PART, PIDX, PGATE, SU, SV, XS, PW, WSC); SEAM(10); }
    if (IN(11)) { RELANE(); const PeerDeal d = peer_deal(c, XC, myx, myrank, IN(10)); peer_pass_phase<2>(c, d, VB, PIDX, nullptr, (const unsigned char*)PW, WSC, POUT);
#if MK_DUPS == 11
        peer_pass_phase<2>(c, d, VB, PIDX, nullptr, (const unsigned char*)PW, WSC, POUT);
#endif
        SEAM(11); }
    if (IN(12)) { RELANE(); ln_add_phase(c, HF, ln_mix_g, ln_mix_b, POUT, nullptr, HF, ln_ffn_g, ln_ffn_b, X8B, XSB);   }
    if (IN(13)) { RELANE();
        const int r1 = (B_COLS / 32) % c.G, r2 = (B_COLS / 32 + DM / 32) % c.G;
        transpose_quant<4096>(c, b_w_in, B_COLS, WIN8, SBIN, 0); transpose_quant<4096>(c, b_w_out, DM, WOUT8, SBOUT, r1); transpose_quant<4096>(c, peer_w_q + (size_t)DM * 2048, 2048, WQ8, SBQ, r2);
        RELANE();
        zero_flat16(c, WIN8 + (size_t)B_COLS * DM, (size_t)(B_COLS_PAD - B_COLS) * DM);
        for (int i = c.bid * NTHREADS + c.tid; i < B_COLS_PAD - B_COLS; i += c.G * NTHREADS) SBIN[B_COLS + i] = 0.f;
        const ConvDeal cd = conv_deal(c.G, c.bid, B_COLS / 32, 32, DM / 32, r1, 32, 2048 / 32, r2, 32, 16384);
        convert_rows_i8(c, peer_u + EU, UB, SU, cd.lo + c.wave, cd.hi, 8); convert_rows_i8(c, peer_u + EU, UB, SU, cd.covered + c.bid * 8 + c.wave, 16384, c.G * 8);
        convert_rows_i8(c, peer_v + EU, VB, SV, c.bid * 8 + c.wave, 16384, c.G * 8);
        SEAM(13);
    }
    if (IN(15)) { RELANE();
        pg8::Gemm g{(const bf16_t*)X8B, (const bf16_t*)WIN8, T, B_COLS_PAD, DM / 2, c.wave, XSB, SBIN}; pg8::StaticOrder S; S.init(T, B_COLS_PAD, c.G, c.bid);
        EpiFox E{QKV, FG};
        pg8::gemm_phase<EpiFox, pg8::StaticOrder, false, true>(c.lds, g, S, E, nullptr);
        SEAM(15);
    }
    if (IN(16)) { RELANE(); cumsum_phase(c, FG, b_f_bias, C2, LSE  ); SEAM(16); }
    if (IN(17)) { RELANE(); const PeerDeal d = peer_deal(c, XC, myx, myrank, IN(16));
#if MK_DUPS == 17
        fox_attn_phase<MK_FOXVAR>(c, QKV, C2, LSE, OG, d.xcd_mode, deal_xcd(d), deal_rank(d));
#endif
        fox_attn_phase<0>(c, QKV, C2, LSE, OG, d.xcd_mode, deal_xcd(d), deal_rank(d));
        SEAM(17); }
    if (IN(18)) { RELANE(); quant_rows_bf16_i8<4096>(c, OG, OG8, SOG, T); SEAM(18); }
    if (IN(19)) { RELANE();
        pg8::Gemm g{(const bf16_t*)OG8, (const bf16_t*)WOUT8, T, DM, DM / 2, c.wave, SOG, SBOUT}; pg8::StaticOrder S; S.init(T, DM, c.G, c.bid);
        EpiRes<false> E{HF, HF, DM, DN_ALPHA};
        pg8::gemm_phase<EpiRes<false>, pg8::StaticOrder, false, true>(c.lds, g, S, E, nullptr);
        SEAM(19);
    }
    if (IN(20)) { RELANE(); ln_phase(c, HF, nullptr, nullptr, ln_mix_g + DM, ln_mix_b + DM, X8, XS); SEAM(20); }
    if (IN(21)) { RELANE();
        pg8::Gemm g{(const bf16_t*)X8, (const bf16_t*)WQ8, T, 2048, DM / 2, c.wave, XS, SBQ}; pg8::StaticOrder S; S.init(T, 2048, c.G, c.bid);
        pg8::EpiBf16<0> E{QP, 2048, nullptr, 0, 0};
        pg8::gemm_phase<pg8::EpiBf16<0>, pg8::StaticOrder, false, true>(c.lds, g, S, E, nullptr);
        SEAM(21);
    }
    if (IN(22)) { RELANE(); peer_select_phase(c, QP, peer_sk + 2 * 128 * 128, PIDX, PGATE); SEAM(22); }
    if (IN(23)) { RELANE(); const PeerDeal d = peer_deal(c, XC, myx, myrank, IN(22)); peer_pass_phase<1>(c, d, UB, PIDX, X8, nullptr, nullptr, PART); SEAM(23); }
    if (IN(24)) { RELANE(); peer_act_phase(c, PART, PIDX, PGATE, SU, SV, XS, PW, WSC); SEAM(24); }
    if (IN(25)) { RELANE(); const PeerDeal d = peer_deal(c, XC, myx, myrank, IN(24)); peer_pass_phase<2>(c, d, VB, PIDX, nullptr, (const unsigned char*)PW, WSC, POUT); SEAM(25); }
    if (IN(26)) { RELANE(); ln_add_phase(c, HF, ln_mix_g + DM, ln_mix_b + DM, POUT, args.out, nullptr, ln_ffn_g + DM, ln_ffn_b + DM); }
#undef IN
#undef SEAM
#undef x
#undef a_w_in
#undef a_w_out
#undef b_w_in
#undef b_f_bias
#undef b_w_out
#undef peer_w_q
#undef peer_sk
#undef peer_u
#undef peer_v
#undef ln_mix_g
#undef ln_mix_b
#undef ln_ffn_g
#undef ln_ffn_b
#undef INP
}
}

extern "C" void kernel_launch(void* const* d_in, const int* in_sizes, int n_in, void* d_out, int out_size, void* d_ws, size_t ws_size, hipStream_t stream) {
    using namespace mk;
    static int grid = 0;
    if (grid == 0) {
        if (n_in != 14 || out_size != T * DM || ws_size < WS_END2) { fprintf(stderr, "kernel_launch: unexpected shapes (n_in %d out %d ws %zu need %zu); nothing launched\n", n_in, out_size, ws_size, (size_t)WS_END2); grid = -1; return; }
        int dev = 0, cus = 0, per_cu = 0;
        if (hipGetDevice(&dev) != hipSuccess || hipDeviceGetAttribute(&cus, hipDeviceAttributeMultiprocessorCount, dev) != hipSuccess) { grid = -1; return; }
        if (hipFuncSetAttribute((const void*)mk_fwd, hipFuncAttributeMaxDynamicSharedMemorySize, LDS_BYTES) != hipSuccess) { fprintf(stderr, "kernel_launch: hipFuncSetAttribute failed\n"); grid = -1; return; }
        if (hipOccupancyMaxActiveBlocksPerMultiprocessor(&per_cu, (const void*)mk_fwd, NTHREADS, LDS_BYTES) != hipSuccess || per_cu < 1) { fprintf(stderr, "kernel_launch: occupancy query says %d\n", per_cu); per_cu = 1; }
        (void)hipGetLastError();
        grid = cus;
    }
    if (grid < 0) return;
    if (hipMemsetAsync((char*)d_ws + WS_CTL, 0, (size_t)MAX_LAUNCHES * BAR_REGION_WORDS * 4 + MAX_LAUNCHES * 256, stream) != hipSuccess) return;
    Args a{};
    for (int i = 0; i < 14; ++i) a.in[i] = (const float*)d_in[i];
    a.out = (float*)d_out; a.ws = (unsigned char*)d_ws; a.pad = 0;
#if MK_N_LAUNCHES == 1
    a.ph_lo = 0; a.ph_hi = NPHASES; a.li = 0;
    hipLaunchKernelGGL(mk_fwd, dim3(grid), dim3(NTHREADS), LDS_BYTES, stream, a);
#else
    for (int p = 0; p < NPHASES; ++p) { a.ph_lo = p; a.ph_hi = p + 1; a.li = p; hipLaunchKernelGGL(mk_fwd, dim3(grid), dim3(NTHREADS), LDS_BYTES, stream, a); }
#endif
}
```

```cpp
#include <hip/hip_runtime.h>
#include <cstdio>
#include <cstdint>
#ifndef MK_N_LAUNCHES
#define MK_N_LAUNCHES 1
#endif
__device__ __forceinline__ int mk_hw_lane() { int l; asm volatile("v_mbcnt_lo_u32_b32 %0, -1, 0\n\tv_mbcnt_hi_u32_b32 %0, -1, %0" : "=v"(l)); return l; }

#define XB_TMO      128
#define XB_XCNT(j)  (256  + 64 * (j))
#define XB_XSUB(j)  (1280 + 64 * (j))
#define XB_XGEN(j)  (2304 + 64 * (j))
#define XB_TOP      3328
#define XB_TOPGEN   3392
#define XCD_BAR_WORDS 3456
#define XB_SPIN_CAP (1u << 18)
#define LAS __attribute__((address_space(3)))

__device__ __forceinline__ unsigned xb_ld(unsigned* p)              { return __hip_atomic_load(p, __ATOMIC_RELAXED, __HIP_MEMORY_SCOPE_AGENT); }
__device__ __forceinline__ unsigned xb_add(unsigned* p, unsigned v) { return __hip_atomic_fetch_add(p, v, __ATOMIC_RELAXED, __HIP_MEMORY_SCOPE_AGENT); }
__device__ __forceinline__ unsigned xb_xcc_id() { return (unsigned)__builtin_amdgcn_s_getreg((3 << 11) | 20) & 0xFu; }
#define XB_SPIN(cond, bar) do { unsigned _sp = 0; while (cond) { __builtin_amdgcn_s_sleep(1); \
    if ((++_sp & 255u) == 0u) { if (xb_ld(&(bar)[XB_TMO])) break; if (_sp > XB_SPIN_CAP) { atomicAdd(&(bar)[XB_TMO], 1u); break; } } } } while (0)

struct XcdBarrier {
    unsigned* bar; unsigned x; int wave;
    volatile LAS unsigned* st;
};

__device__ __forceinline__ XcdBarrier xcd_barrier_post(unsigned* bar, volatile LAS unsigned* st, int wave) {
    XcdBarrier b; b.bar = bar; b.x = xb_xcc_id(); b.st = st; b.wave = wave;
    if (wave == 0 && mk_hw_lane() == 0) (void)xb_add(&bar[XB_XCNT(b.x)], 1u);
    return b;
}
__device__ __forceinline__ void xcd_barrier_complete(unsigned* bar, unsigned x, unsigned& nloc, unsigned& nx) {
    const unsigned G = gridDim.x * gridDim.y * gridDim.z;
    unsigned sum, cnt, mine, sp = 0u;
    for (;;) {
        sum = 0u; cnt = 0u; mine = 0u;
#pragma unroll
        for (unsigned j = 0; j < 16; ++j) { const unsigned c = xb_ld(&bar[XB_XCNT(j)]); sum += c; cnt += (c > 0u) ? 1u : 0u; mine = (j == x) ? c : mine; }
        if (sum == G) break;
        __builtin_amdgcn_s_sleep(1);
        if ((++sp & 255u) == 0u) { if (xb_ld(&bar[XB_TMO])) break; if (sp > XB_SPIN_CAP) { atomicAdd(&bar[XB_TMO], 1u); break; } }
    }
    nloc = mine > 0u ? mine : 1u; nx = cnt > 0u ? cnt : 1u;
}

__device__ __forceinline__ void xcd_barrier(const XcdBarrier& b) {
    asm volatile("s_waitcnt vmcnt(0)" ::: "memory");
    __syncthreads();
    if (b.wave == 0 && mk_hw_lane() == 0) {
        unsigned* bar = b.bar;
        __builtin_amdgcn_s_waitcnt(0);
        unsigned nloc = b.st[0], nx = b.st[1];
        if (nloc == 0u) { xcd_barrier_complete(bar, b.x, nloc, nx); b.st[0] = nloc; b.st[1] = nx; }
        const unsigned old = xb_add(&bar[XB_XSUB(b.x)], 1u);
        const unsigned gen = old / nloc;
        if (old + 1u == (gen + 1u) * nloc) {
            __builtin_amdgcn_fence(__ATOMIC_RELEASE, "agent");
            asm volatile("s_waitcnt vmcnt(0)" ::: "memory");
            const unsigned og = xb_add(&bar[XB_TOP], 1u);
            const unsigned tg = og / nx;
            if (og + 1u == (tg + 1u) * nx) xb_add(&bar[XB_TOPGEN], 1u);
            else XB_SPIN(xb_ld(&bar[XB_TOPGEN]) == tg, bar);
            __builtin_amdgcn_fence(__ATOMIC_ACQUIRE, "agent");
            xb_add(&bar[XB_XGEN(b.x)], 1u);
            asm volatile("s_waitcnt vmcnt(0)" ::: "memory");
        } else {
            XB_SPIN(xb_ld(&bar[XB_XGEN(b.x)]) == gen, bar);
            __builtin_amdgcn_fence(__ATOMIC_ACQUIRE, "agent");
            asm volatile("s_waitcnt vmcnt(0)" ::: "memory");
        }
    }
    __syncthreads();
}

namespace pg8 {
#define PG8_LAS __attribute__((address_space(3)))
typedef unsigned short bf16_t;
typedef short bf16x8 __attribute__((ext_vector_type(8)));
typedef float f32x4 __attribute__((ext_vector_type(4)));
typedef unsigned u32x4 __attribute__((ext_vector_type(4)));
constexpr int BM = 256, BK = 64, HALF = 128, HTB = HALF * BK * 2  , STAGE_BYTES = 8 * HTB, NXCD = 8, WGM = 8;

__host__ __device__ __forceinline__ int lds_byte(int r, int c) { const int st = (r >> 4) * 2 + (c >> 5), rr = r & 15, cc = c & 31, ob = rr * 64 + cc * 2; return st * 1024 + (ob ^ (((ob >> 9) & 1) << 5)); }
__host__ __device__ __forceinline__ void stage_rc(int b, int& R, int& C) { const int st = b / 1024, sb = b % 1024, swz = sb ^ (((sb >> 9) & 1) << 5); R = (st >> 1) * 16 + swz / 64; C = (st & 1) * 32 + (swz % 64) / 2; }
__host__ __device__ __forceinline__ int perm32(int rho) { const int n = rho >> 4, i = rho & 15; return 8 * (i >> 2) + 4 * n + (i & 3); }

struct Unit { int pm, pn; };
struct Gemm { const bf16_t* A; const bf16_t* Bt; int M, N, K, wave; const float* sa; const float* sb; };

struct StaticOrder {
    int nM, nN, nwg, G, c;
    __host__ __device__ void init(int M, int N, int G_, int c_) { nM = M / BM; nN = N / BM; nwg = nM * nN; G = G_; c = c_; }
    __host__ __device__ bool next(int i, Unit& u) const {
        const long L = (long)i * G + c; if (L >= nwg) return false;
        int wgid = (int)L; { const int q = nwg / NXCD, r = nwg % NXCD, xcd = wgid % NXCD, off = wgid / NXCD; wgid = (xcd < r ? xcd * (q + 1) : r * (q + 1) + (xcd - r) * q) + off; }
        const int nig = WGM * nN, gid = wgid / nig, fm = gid * WGM, gsz = (nM - fm) < WGM ? (nM - fm) : WGM;
        u.pm = fm + ((wgid % nig) % gsz); u.pn = (wgid % nig) / gsz; return true;
    }
    __device__ __forceinline__ void a_ready(const Unit&) const {}
    __device__ __forceinline__ void done(const Unit&) const {}
};
struct CountedOrder : StaticOrder {
    const unsigned* ready; unsigned need; unsigned* tmo;
    __device__ __forceinline__ void a_ready(const Unit& u) const {
        if (threadIdx.x < 64) {
            const unsigned long long t0 = __builtin_amdgcn_s_memrealtime(); unsigned polls = 0;
            while ((unsigned)__builtin_amdgcn_readfirstlane(__hip_atomic_load(ready + 64 * u.pm, __ATOMIC_RELAXED, __HIP_MEMORY_SCOPE_AGENT)) < need) {
                if ((++polls & 255u) == 0u && __builtin_amdgcn_readfirstlane(__hip_atomic_load(tmo, __ATOMIC_RELAXED, __HIP_MEMORY_SCOPE_AGENT)) != 0u) break;
                if (__builtin_amdgcn_s_memrealtime() - t0 > 2000000ull) {
                    if (threadIdx.x == 0) { unsigned expect = 0u; __hip_atomic_compare_exchange_strong(tmo + 1, &expect, 0x600u | (unsigned)(u.pm & 0xff), __ATOMIC_RELAXED, __ATOMIC_RELAXED, __HIP_MEMORY_SCOPE_AGENT); __hip_atomic_store(tmo, 1u, __ATOMIC_RELAXED, __HIP_MEMORY_SCOPE_AGENT); }
                    break; }
                __builtin_amdgcn_s_sleep(2); }
            __builtin_amdgcn_fence(__ATOMIC_ACQUIRE, "agent");
            asm volatile("s_waitcnt vmcnt(0)" ::: "memory");
        }
#if !defined(BROKEN_HOOK_NO_BARRIER)
        asm volatile("" ::: "memory"); __builtin_amdgcn_s_barrier(); asm volatile("" ::: "memory");
#endif
    }
};

__device__ __forceinline__ unsigned cvt_pk_bf16(float lo, float hi) { unsigned r; asm volatile("v_cvt_pk_bf16_f32 %0, %1, %2" : "=v"(r) : "v"(lo), "v"(hi)); return r; }
typedef float f32x2 __attribute__((ext_vector_type(2)));
__device__ __forceinline__ f32x2 gelu_pk(f32x2 v) {
    const f32x2 av = __builtin_elementwise_abs(v), d = av * 0.2316418882f + 1.0f;
    f32x2 t; t.x = __builtin_amdgcn_rcpf(d.x); t.y = __builtin_amdgcn_rcpf(d.y);
    f32x2 q = t * 0.5307027145f + (-0.7265760135f); q = q * t + 0.7107068705f; q = q * t + (-0.142248368f); q = q * t + 0.127414796f; q = q * t;
    const f32x2 s = (v * v) * (-0.72134752044f);
    f32x2 e; e.x = __builtin_amdgcn_exp2f(s.x); e.y = __builtin_amdgcn_exp2f(s.y);
    const f32x2 m = v * (q * e), r = v - m;
    f32x2 o; o.x = v.x < 0.f ? m.x : r.x; o.y = v.y < 0.f ? m.y : r.y; return o;
}

struct EpiF32 {
    static constexpr bool PERM = false, AFTER_DRAIN = false;
    float* C; int ldc; const float* bias;
    __device__ __forceinline__ void operator()(const f32x4 (&acc)[2][2][4][2], const Unit& u, int wr, int wc, int fr, int fq) const {
        const int row0 = u.pm * BM + wr * 64 + fr, col0 = u.pn * BM + wc * 32 + 4 * fq;
        f32x4 bv[2][2];
#pragma unroll
        for (int bj = 0; bj < 2; ++bj)
#pragma unroll
            for (int n = 0; n < 2; ++n) bv[bj][n] = bias ? *(const f32x4*)(bias + col0 + bj * HALF + n * 16) : (f32x4){0.f, 0.f, 0.f, 0.f};
#pragma unroll
        for (int ai = 0; ai < 2; ++ai)
#pragma unroll
            for (int m = 0; m < 4; ++m) { float* rowp = C + (size_t)(row0 + ai * HALF + m * 16) * ldc + col0;
#pragma unroll
                for (int bj = 0; bj < 2; ++bj)
#pragma unroll
                    for (int n = 0; n < 2; ++n) *(f32x4*)(rowp + bj * HALF + n * 16) = acc[ai][bj][m][n] + bv[bj][n]; }
    }
};
template <int ACT  > struct EpiBf16 {
    static constexpr bool PERM = true, AFTER_DRAIN = false;
    bf16_t* O; int ldc; const float* bias; int split_cols; size_t split_stride;
    __device__ __forceinline__ void operator()(const f32x4 (&acc)[2][2][4][2], const Unit& u, int wr, int wc, int fr, int fq) const {
        const int row0 = u.pm * BM + wr * 64 + fr; int colt = u.pn * BM; bf16_t* base = O;
        if (split_cols) { const int t = colt / split_cols; base += (size_t)t * split_stride; colt -= t * split_cols; }
        const int col0 = colt + wc * 32 + 8 * fq, bcol0 = u.pn * BM + wc * 32 + 8 * fq;
        f32x4 bv[2][2];
#pragma unroll
        for (int bj = 0; bj < 2; ++bj)
#pragma unroll
            for (int n = 0; n < 2; ++n) bv[bj][n] = bias ? *(const f32x4*)(bias + bcol0 + bj * HALF + 4 * n) : (f32x4){0.f, 0.f, 0.f, 0.f};
#pragma unroll
        for (int ai = 0; ai < 2; ++ai)
#pragma unroll
            for (int m = 0; m < 4; ++m) { bf16_t* rowp = base + (size_t)(row0 + ai * HALF + m * 16) * ldc + col0;
#pragma unroll
                for (int bj = 0; bj < 2; ++bj) { f32x4 v0 = acc[ai][bj][m][0] + bv[bj][0], v1 = acc[ai][bj][m][1] + bv[bj][1];
                    if (ACT == 1) { f32x2 a = gelu_pk((f32x2){v0[0], v0[1]}), b = gelu_pk((f32x2){v0[2], v0[3]}), c = gelu_pk((f32x2){v1[0], v1[1]}), d = gelu_pk((f32x2){v1[2], v1[3]});
                        v0 = (f32x4){a.x, a.y, b.x, b.y}; v1 = (f32x4){c.x, c.y, d.x, d.y}; }
                    if (ACT == 2) {
#pragma unroll
                        for (int j = 0; j < 4; ++j) { v0[j] = 0.5f * v0[j] * (1.0f + erff(v0[j] * 0.70710678f)); v1[j] = 0.5f * v1[j] * (1.0f + erff(v1[j] * 0.70710678f)); } }
                    u32x4 w; w.x = cvt_pk_bf16(v0[0], v0[1]); w.y = cvt_pk_bf16(v0[2], v0[3]); w.z = cvt_pk_bf16(v1[0], v1[1]); w.w = cvt_pk_bf16(v1[2], v1[3]);
                    *(u32x4*)(rowp + bj * HALF) = w; } }
    }
};

struct PanelStats {
    unsigned* xbuf;
    unsigned* cnt;
    unsigned* tmo;
    int ntn; float eps;
    unsigned code;
    __device__ __forceinline__ bool run(const f32x4 (&v)[2][2][4][2], const Unit& u, int wr, int wc, int fr, int fq, PG8_LAS unsigned char* lds, int wid, int lane) const {
        typedef float f32x2v __attribute__((ext_vector_type(2)));
        PG8_LAS f32x2v* P = (PG8_LAS f32x2v*)lds;
        PG8_LAS f32x2v* S = (PG8_LAS f32x2v*)(lds + 8192);
        PG8_LAS unsigned* flag = (PG8_LAS unsigned*)(lds + 8192 + 2048);
#pragma unroll
        for (int ai = 0; ai < 2; ++ai)
#pragma unroll
            for (int m = 0; m < 4; ++m) {
                float s = 0.f;
#pragma unroll
                for (int bj = 0; bj < 2; ++bj)
#pragma unroll
                    for (int n = 0; n < 2; ++n) { const f32x4 x = v[ai][bj][m][n]; s += (x[0] + x[1]) + (x[2] + x[3]); }
                s += __shfl_xor(s, 16); s += __shfl_xor(s, 32);
                const float mw = s * (1.0f / 64.0f); float q = 0.f;
#pragma unroll
                for (int bj = 0; bj < 2; ++bj)
#pragma unroll
                    for (int n = 0; n < 2; ++n) { const f32x4 d = v[ai][bj][m][n] - mw; q += (d[0] * d[0] + d[1] * d[1]) + (d[2] * d[2] + d[3] * d[3]); }
                q += __shfl_xor(q, 16); q += __shfl_xor(q, 32);
                if (fq == 0) P[(ai * HALF + wr * 64 + m * 16 + fr) * 4 + wc] = (f32x2v){mw, q};
            }
        asm volatile("s_waitcnt lgkmcnt(0)" ::: "memory"); __builtin_amdgcn_s_barrier(); asm volatile("" ::: "memory");
#if defined(BROKEN_NO_WAIT)
        if (blockIdx.x >= 64) { const long long t0 = clock64(); while (clock64() - t0 < 60000) __builtin_amdgcn_s_sleep(8); }
#endif
        const int row = wid * 32 + (lane & 31);
        if (lane < 32) {
            const f32x2v a = P[row * 4 + 0], b = P[row * 4 + 1], c = P[row * 4 + 2], d = P[row * 4 + 3];
            const float mt = (a.x + b.x + c.x + d.x) * 0.25f;
            const float da = a.x - mt, db = b.x - mt, dc = c.x - mt, dd = d.x - mt;
            const float m2 = (a.y + b.y) + (c.y + d.y) + 64.0f * ((da * da + db * db) + (dc * dc + dd * dd));
            unsigned long long* slot = (unsigned long long*)xbuf + ((size_t)(u.pm * BM + row) * 4 + u.pn);
            __hip_atomic_store(slot, ((unsigned long long)__float_as_uint(m2) << 32) | __float_as_uint(mt), __ATOMIC_RELAXED, __HIP_MEMORY_SCOPE_AGENT);
        }
        asm volatile("s_waitcnt vmcnt(0)" ::: "memory");
        if (lane == 0) __hip_atomic_fetch_add(cnt + 64 * u.pm, 1u, __ATOMIC_RELAXED, __HIP_MEMORY_SCOPE_AGENT);
        if (wid == 0) {
            bool dead = false; const unsigned long long t0 = __builtin_amdgcn_s_memrealtime(); const unsigned want = 8u * (unsigned)ntn;
            for (;;) {
#if defined(BROKEN_NO_WAIT)
                break;
#endif
                if ((unsigned)__builtin_amdgcn_readfirstlane(__hip_atomic_load(cnt + 64 * u.pm, __ATOMIC_RELAXED, __HIP_MEMORY_SCOPE_AGENT)) >= want) break;
                if (__builtin_amdgcn_s_memrealtime() - t0 > 2000000ull) {
                    if (lane == 0) { unsigned expect = 0u; __hip_atomic_compare_exchange_strong(tmo + 1, &expect, code | (unsigned)(u.pm & 0xff), __ATOMIC_RELAXED, __ATOMIC_RELAXED, __HIP_MEMORY_SCOPE_AGENT);
                                     __hip_atomic_store(tmo, 1u, __ATOMIC_RELAXED, __HIP_MEMORY_SCOPE_AGENT); }
                    dead = true; break; }
                __builtin_amdgcn_s_sleep(2);
            }
            __builtin_amdgcn_fence(__ATOMIC_ACQUIRE, "agent");
            if (lane == 0) flag[0] = dead ? 1u : 0u;
        }
        asm volatile("s_waitcnt vmcnt(0) lgkmcnt(0)" ::: "memory"); __builtin_amdgcn_s_barrier(); asm volatile("" ::: "memory");
        const bool bad = flag[0] != 0u;
        if (lane < 32) {
            const unsigned long long* slot = (const unsigned long long*)xbuf + (size_t)(u.pm * BM + row) * 4; float mt[4], m2[4]; float ms = 0.f;
#pragma unroll
            for (int t = 0; t < 4; ++t) { if (t < ntn) { const unsigned long long w = __hip_atomic_load(slot + t, __ATOMIC_RELAXED, __HIP_MEMORY_SCOPE_AGENT); mt[t] = __uint_as_float((unsigned)w); m2[t] = __uint_as_float((unsigned)(w >> 32)); } else { mt[t] = 0.f; m2[t] = 0.f; } ms += mt[t]; }
            const float mean = ms / (float)ntn; float q = 0.f;
#pragma unroll
            for (int t = 0; t < 4; ++t) if (t < ntn) { const float dm = mt[t] - mean; q += m2[t] + 256.0f * dm * dm; }
            S[row] = (f32x2v){mean, 1.0f / sqrtf(q / (256.0f * (float)ntn) + eps)};
        }
        asm volatile("s_waitcnt lgkmcnt(0)" ::: "memory"); __builtin_amdgcn_s_barrier(); asm volatile("" ::: "memory");
        return bad;
    }
};
struct EpiLnRes {
    static constexpr bool PERM = false, AFTER_DRAIN = true;
    const float* base; float* out; int ldc; const float* bias; PanelStats st; unsigned poison;
    __device__ __forceinline__ void refuse(size_t i0, size_t stride, int M, int N) const { const float q = __builtin_nanf(""); for (size_t i = i0; i < (size_t)M * N; i += stride) out[(i / N) * ldc + i % N] = q;
        if (i0 == 0) { unsigned expect = 0u; __hip_atomic_compare_exchange_strong(st.tmo + 1, &expect, 0x7f0u, __ATOMIC_RELAXED, __ATOMIC_RELAXED, __HIP_MEMORY_SCOPE_AGENT); __hip_atomic_store(st.tmo, 1u, __ATOMIC_RELAXED, __HIP_MEMORY_SCOPE_AGENT); } }
    __device__ __forceinline__ void fused(f32x4 (&acc)[2][2][4][2], const Unit& u, int wr, int wc, int fr, int fq, PG8_LAS unsigned char* lds, int wid, int lane) const {
        typedef float f32x2v __attribute__((ext_vector_type(2)));
        const PG8_LAS f32x2v* S = (const PG8_LAS f32x2v*)(lds + 8192);
        const int col0 = u.pn * BM + wc * 32 + 4 * fq;
#pragma unroll
        for (int bj = 0; bj < 2; ++bj)
#pragma unroll
            for (int n = 0; n < 2; ++n) { const f32x4 bv = bias ? *(const f32x4*)(bias + col0 + bj * HALF + n * 16) : (f32x4){0.f, 0.f, 0.f, 0.f};
#pragma unroll
                for (int ai = 0; ai < 2; ++ai)
#pragma unroll
                    for (int m = 0; m < 4; ++m) acc[ai][bj][m][n] += bv; }
        const bool bad = st.run(acc, u, wr, wc, fr, fq, lds, wid, lane) || poison != 0u;
        const float qnan = __builtin_nanf("");
#pragma unroll
        for (int ai = 0; ai < 2; ++ai)
#pragma unroll
            for (int m = 0; m < 4; ++m) { const int r = ai * HALF + wr * 64 + m * 16 + fr; const f32x2v sr = S[r]; const size_t off = (size_t)(u.pm * BM + r) * ldc + col0;
#pragma unroll
                for (int bj = 0; bj < 2; ++bj)
#pragma unroll
                    for (int n = 0; n < 2; ++n) { const f32x4 bs = *(const f32x4*)(base + off + bj * HALF + n * 16); f32x4 o = bs + (acc[ai][bj][m][n] - sr.x) * sr.y;
                        if (bad) o = (f32x4){qnan, qnan, qnan, qnan}; *(f32x4*)(out + off + bj * HALF + n * 16) = o; }
                asm volatile("" ::: "memory"); }
    }
};
struct EpiLnResLn {
    static constexpr bool PERM = false, AFTER_DRAIN = true;
    const float* base; float* out; bf16_t* xn; int ldc; const float* bias; PanelStats st1, st2; unsigned poison;
    __device__ __forceinline__ void refuse(size_t i0, size_t stride, int M, int N) const { const float q = __builtin_nanf(""); for (size_t i = i0; i < (size_t)M * N; i += stride) { const size_t o = (i / N) * ldc + i % N; out[o] = q; xn[o] = (bf16_t)0x7fc0u; }
        if (i0 == 0) { unsigned expect = 0u; __hip_atomic_compare_exchange_strong(st1.tmo + 1, &expect, 0x7f0u, __ATOMIC_RELAXED, __ATOMIC_RELAXED, __HIP_MEMORY_SCOPE_AGENT); __hip_atomic_store(st1.tmo, 1u, __ATOMIC_RELAXED, __HIP_MEMORY_SCOPE_AGENT); } }
    __device__ __forceinline__ void fused(f32x4 (&acc)[2][2][4][2], const Unit& u, int wr, int wc, int fr, int fq, PG8_LAS unsigned char* lds, int wid, int lane) const {
        typedef float f32x2v __attribute__((ext_vector_type(2))); typedef unsigned u32x2v __attribute__((ext_vector_type(2)));
        const PG8_LAS f32x2v* S = (const PG8_LAS f32x2v*)(lds + 8192);
        const int col0 = u.pn * BM + wc * 32 + 4 * fq;
#pragma unroll
        for (int bj = 0; bj < 2; ++bj)
#pragma unroll
            for (int n = 0; n < 2; ++n) { const f32x4 bv = bias ? *(const f32x4*)(bias + col0 + bj * HALF + n * 16) : (f32x4){0.f, 0.f, 0.f, 0.f};
#pragma unroll
                for (int ai = 0; ai < 2; ++ai)
#pragma unroll
                    for (int m = 0; m < 4; ++m) acc[ai][bj][m][n] += bv; }
        bool bad = st1.run(acc, u, wr, wc, fr, fq, lds, wid, lane) || poison != 0u;
        const float qnan = __builtin_nanf("");
#pragma unroll
        for (int ai = 0; ai < 2; ++ai)
#pragma unroll
            for (int m = 0; m < 4; ++m) { const int r = ai * HALF + wr * 64 + m * 16 + fr; const f32x2v sr = S[r]; const size_t off = (size_t)(u.pm * BM + r) * ldc + col0;
#pragma unroll
                for (int bj = 0; bj < 2; ++bj)
#pragma unroll
                    for (int n = 0; n < 2; ++n) { const f32x4 bs = *(const f32x4*)(base + off + bj * HALF + n * 16); acc[ai][bj][m][n] = bs + (acc[ai][bj][m][n] - sr.x) * sr.y; }
                asm volatile("" : "+v"(acc[ai][0][m][0]), "+v"(acc[ai][0][m][1]), "+v"(acc[ai][1][m][0]), "+v"(acc[ai][1][m][1]));
                if (m & 1) asm volatile("" ::: "memory"); }
        const bool bad1 = bad;
        bad = st2.run(acc, u, wr, wc, fr, fq, lds, wid, lane) || bad;
#pragma unroll
        for (int ai = 0; ai < 2; ++ai)
#pragma unroll
            for (int m = 0; m < 4; ++m) { const int r = ai * HALF + wr * 64 + m * 16 + fr; const f32x2v sr = S[r]; const size_t off = (size_t)(u.pm * BM + r) * ldc + col0;
#pragma unroll
                for (int bj = 0; bj < 2; ++bj)
#pragma unroll
                    for (int n = 0; n < 2; ++n) { const f32x4 x1 = acc[ai][bj][m][n]; *(f32x4*)(out + off + bj * HALF + n * 16) = bad1 ? (f32x4){qnan, qnan, qnan, qnan} : x1;
                        const f32x4 o = (x1 - sr.x) * sr.y; u32x2v w; w.x = cvt_pk_bf16(o[0], o[1]); w.y = cvt_pk_bf16(o[2], o[3]);
                        if (bad) { w.x = 0x7fc07fc0u; w.y = 0x7fc07fc0u; } *(u32x2v*)(xn + off + bj * HALF + n * 16) = w; }
                asm volatile("" ::: "memory"); }
    }
};

typedef int i32x4 __attribute__((ext_vector_type(4)));
template <class Epi, class Sched, bool STAMP = false, bool I8 = false>
__device__ __forceinline__ void gemm_phase(PG8_LAS unsigned char* lds, const Gemm g, const Sched& S, const Epi& E, unsigned long long* stamps) {
    const int lane = mk_hw_lane(), wid = g.wave, tid = wid * 64 + lane, wr = wid >> 2, wc = wid & 3, fr = lane & 15, fq = lane >> 4;
    const int K = g.K, nt = K / BK;
    int ts_lo = 0, ts_hi = 0, nts = 0; const unsigned long long rt_entry = STAMP ? (unsigned long long)wall_clock64() : 0ull;
#define PG8_STAMP() do { if (STAMP && wid == 0 && nts < 64) { const unsigned long long _c = (unsigned long long)clock64(); \
        ts_lo = (lane == nts) ? (int)(unsigned)_c : ts_lo; ts_hi = (lane == nts) ? (int)(unsigned)(_c >> 32) : ts_hi; ++nts; } } while (0)
    PG8_STAMP();
    unsigned voffA[2], voffB[2];
#pragma unroll
    for (int i = 0; i < 2; ++i) { int R, C; stage_rc(tid * 16 + i * 8192, R, C); const int Rb = Epi::PERM ? ((R & ~31) + perm32(R & 31)) : R;
        voffA[i] = (unsigned)(R * K + C) * 2u; voffB[i] = (unsigned)(Rb * K + C) * 2u; }
    const size_t kstep = (size_t)(BK * 2);
    const size_t hstep = (size_t)HALF * K * 2;
    const size_t tstep = 2 * hstep;
    const unsigned ldsw = (unsigned)wid * 1024u;
    const int aoff = lds_byte(wr * 64 + fr, fq * 8), boff = lds_byte(wc * 32 + fr, fq * 8);
#define PG8_SA(b, h) (((b) * 2 + (h)) * HTB)
#define PG8_SB(b, h) ((4 + (b) * 2 + (h)) * HTB)
#define PG8_STAGE(bufoff, gbase, voff) do { _Pragma("unroll") for (int _i = 0; _i < 2; ++_i) \
        __builtin_amdgcn_global_load_lds((const unsigned*)((const char*)(gbase) + (voff)[_i]), (PG8_LAS unsigned*)(lds + (bufoff) + ldsw + _i * 8192), 16, 0, 0); } while (0)
#define PG8_LDA(dst, b, h) do { _Pragma("unroll") for (int m = 0; m < 4; ++m) _Pragma("unroll") for (int k = 0; k < 2; ++k) dst[m][k] = *(const PG8_LAS bf16x8*)(lds + PG8_SA(b, h) + aoff + m * 2048 + k * 1024); } while (0)
#define PG8_LDB(dst, b, h) do { _Pragma("unroll") for (int n = 0; n < 2; ++n) _Pragma("unroll") for (int k = 0; k < 2; ++k) dst[n][k] = *(const PG8_LAS bf16x8*)(lds + PG8_SB(b, h) + boff + n * 2048 + k * 1024); } while (0)
#define PG8_MMA(ai, bj, At, Bt) do { __builtin_amdgcn_s_setprio(1); _Pragma("unroll") for (int m = 0; m < 4; ++m) _Pragma("unroll") for (int n = 0; n < 2; ++n) _Pragma("unroll") for (int k = 0; k < 2; ++k) \
        { if constexpr (I8) acc[ai][bj][m][n] = __builtin_bit_cast(f32x4, __builtin_amdgcn_mfma_i32_16x16x64_i8(__builtin_bit_cast(i32x4, Bt[n][k]), __builtin_bit_cast(i32x4, At[m][k]), __builtin_bit_cast(i32x4, acc[ai][bj][m][n]), 0, 0, 0)); \
          else acc[ai][bj][m][n] = __builtin_amdgcn_mfma_f32_16x16x32_bf16(Bt[n][k], At[m][k], acc[ai][bj][m][n], 0, 0, 0); } __builtin_amdgcn_s_setprio(0); } while (0)
#define PG8_WAIT_V(n) asm volatile("s_waitcnt vmcnt(" #n ")" ::: "memory")
#define PG8_WAIT_L(n) asm volatile("s_waitcnt lgkmcnt(" #n ")" ::: "memory")
#define PG8_BAR __builtin_amdgcn_s_barrier()
#define PG8_SCHED __builtin_amdgcn_sched_barrier(0)
    Unit cur, nxt; int ui = 0;
    if (!S.next(0, cur)) return;
    f32x4 acc[2][2][4][2];
#pragma unroll
    for (int a = 0; a < 2; ++a)
#pragma unroll
        for (int b = 0; b < 2; ++b)
#pragma unroll
            for (int m = 0; m < 4; ++m)
#pragma unroll
                for (int n = 0; n < 2; ++n) acc[a][b][m][n] = (f32x4){0.f, 0.f, 0.f, 0.f};
    bf16x8 At[4][2], B0[2][2], B1[2][2];
    const char* cA = (const char*)g.A + (size_t)cur.pm * tstep; const char* cB = (const char*)g.Bt + (size_t)cur.pn * tstep;
    S.a_ready(cur);
    PG8_STAGE(PG8_SB(0, 0), cB, voffB); PG8_STAGE(PG8_SA(0, 0), cA, voffA); PG8_STAGE(PG8_SB(0, 1), cB + hstep, voffB); PG8_STAGE(PG8_SA(0, 1), cA + hstep, voffA);
    if (wr == 1) PG8_BAR;
    PG8_WAIT_V(4); PG8_BAR;
    PG8_STAGE(PG8_SB(1, 0), cB + kstep, voffB); PG8_STAGE(PG8_SA(1, 0), cA + kstep, voffA); PG8_STAGE(PG8_SB(1, 1), cB + hstep + kstep, voffB);
    PG8_WAIT_V(6); PG8_BAR;
    PG8_STAMP();
    for (;;) {
        const bool has_next = S.next(ui + 1, nxt);
        const char* nA = has_next ? (const char*)g.A + (size_t)nxt.pm * tstep : cA; const char* nB = has_next ? (const char*)g.Bt + (size_t)nxt.pn * tstep : cB;
        for (int t = 0; t < nt; t += 2) {
            const bool last = (t == nt - 2);
            const char* a1 = cA + (size_t)(t + 1) * kstep;
            const char* a2 = last ? nA : cA + (size_t)(t + 2) * kstep; const char* b2 = last ? nB : cB + (size_t)(t + 2) * kstep;
            const char* a3 = a2 + kstep; const char* b3 = b2 + kstep;
            if (last && has_next) S.a_ready(nxt);
            PG8_LDB(B0, 0, 0); PG8_SCHED; PG8_LDA(At, 0, 0); PG8_STAGE(PG8_SA(1, 1), a1 + hstep, voffA);
            PG8_WAIT_L(8); PG8_BAR; PG8_WAIT_L(0); PG8_MMA(0, 0, At, B0); PG8_BAR; PG8_SCHED;
            PG8_LDB(B1, 0, 1); PG8_STAGE(PG8_SB(0, 0), b2, voffB);
            PG8_BAR; PG8_WAIT_L(0); PG8_MMA(0, 1, At, B1); PG8_BAR;
            PG8_LDA(At, 0, 1); PG8_STAGE(PG8_SA(0, 0), a2, voffA);
            PG8_BAR; PG8_WAIT_L(0); PG8_MMA(1, 0, At, B0); PG8_BAR; PG8_SCHED;
            PG8_STAGE(PG8_SB(0, 1), b2 + hstep, voffB);
            PG8_WAIT_V(6); PG8_BAR; PG8_MMA(1, 1, At, B1); PG8_BAR;
            PG8_LDB(B0, 1, 0); PG8_SCHED; PG8_LDA(At, 1, 0); PG8_STAGE(PG8_SA(0, 1), a2 + hstep, voffA);
            PG8_WAIT_L(8); PG8_BAR; PG8_WAIT_L(0); PG8_MMA(0, 0, At, B0); PG8_BAR; PG8_SCHED;
            PG8_LDB(B1, 1, 1); PG8_STAGE(PG8_SB(1, 0), b3, voffB);
            PG8_BAR; PG8_WAIT_L(0); PG8_MMA(0, 1, At, B1); PG8_BAR;
            PG8_LDA(At, 1, 1); PG8_STAGE(PG8_SA(1, 0), a3, voffA);
            PG8_BAR; PG8_WAIT_L(0); PG8_MMA(1, 0, At, B0); PG8_BAR; PG8_SCHED;
            PG8_STAGE(PG8_SB(1, 1), b3 + hstep, voffB);
            PG8_WAIT_V(6); PG8_BAR; PG8_MMA(1, 1, At, B1); PG8_BAR;
        }
        PG8_STAMP();
        if constexpr (I8) {
            const int r0_ = cur.pm * BM + wr * 64 + fr, c0_ = cur.pn * BM + wc * 32 + (Epi::PERM ? 8 * fq : 4 * fq);
#pragma unroll
            for (int bj = 0; bj < 2; ++bj)
#pragma unroll
                for (int n = 0; n < 2; ++n) { const f32x4 sbv = *(const f32x4*)(g.sb + c0_ + bj * HALF + (Epi::PERM ? 4 * n : 16 * n));
#pragma unroll
                    for (int ai = 0; ai < 2; ++ai)
#pragma unroll
                        for (int m = 0; m < 4; ++m) { const float sav = g.sa[r0_ + ai * HALF + m * 16]; const i32x4 iv = __builtin_bit_cast(i32x4, acc[ai][bj][m][n]);
                            acc[ai][bj][m][n] = (f32x4){(float)iv[0] * sav * sbv[0], (float)iv[1] * sav * sbv[1], (float)iv[2] * sav * sbv[2], (float)iv[3] * sav * sbv[3]}; } }
        }
        if constexpr (!Epi::AFTER_DRAIN) { E(acc, cur, wr, wc, fr, fq); S.done(cur); }
        PG8_STAMP();
        if (!has_next) break;
#pragma unroll
        for (int a = 0; a < 2; ++a)
#pragma unroll
            for (int b = 0; b < 2; ++b)
#pragma unroll
                for (int m = 0; m < 4; ++m)
#pragma unroll
                    for (int n = 0; n < 2; ++n) acc[a][b][m][n] = (f32x4){0.f, 0.f, 0.f, 0.f};
        cur = nxt; cA = nA; cB = nB; ++ui;
    }
    PG8_WAIT_V(0);
    if (wr == 0) PG8_BAR;
    PG8_BAR;
    if constexpr (Epi::AFTER_DRAIN) { E.fused(acc, cur, wr, wc, fr, fq, lds, wid, lane); S.done(cur); }
    PG8_STAMP();
    if (STAMP && wid == 0) { stamps[lane] = lane < nts ? (((unsigned long long)(unsigned)ts_hi << 32) | (unsigned)ts_lo) : 0ull;
        if (lane == 62) stamps[62] = rt_entry; if (lane == 63) stamps[63] = (unsigned long long)wall_clock64(); }
#undef PG8_STAMP
#undef PG8_SA
#undef PG8_SB
#undef PG8_STAGE
#undef PG8_LDA
#undef PG8_LDB
#undef PG8_MMA
#undef PG8_WAIT_V
#undef PG8_WAIT_L
#undef PG8_BAR
#undef PG8_SCHED
}
}

namespace mk {
using pg8::bf16_t; using pg8::bf16x8; using pg8::f32x4; using pg8::u32x4;
typedef float f32x16 __attribute__((ext_vector_type(16)));
typedef unsigned u32x2 __attribute__((ext_vector_type(2)));
typedef __bf16 bf16x2 __attribute__((ext_vector_type(2)));

constexpr int T = 16384, DM = 4096, SEQ = 2048, NBATCH = 8;
constexpr int A_COLS = 18432, B_COLS = 12320, B_COLS_PAD = 12544, FOXW = 12288;
constexpr float DN_ALPHA = 1.4142135623730951f;
constexpr float LN_EPS = 1e-5f;
constexpr float LOG2E = 1.4426950408889634f, LN2 = 0.6931471805599453f;
constexpr float QSCALE2 = 0.08838834764831845f * 1.4426950408889634f;

constexpr size_t MB = (size_t)1 << 20;
constexpr size_t WS_CTL = 0;
constexpr size_t WS_WIN = 1 * MB;
constexpr size_t WS_WOUT = WS_WIN + 144 * MB;
constexpr size_t WS_WQ = WS_WOUT + 32 * MB;
constexpr size_t WS_U = WS_WQ + 16 * MB;
constexpr size_t WS_V = WS_U + 128 * MB;
constexpr size_t WS_HF = WS_V + 128 * MB;
constexpr size_t WS_HB = WS_HF + 256 * MB;
constexpr size_t WS_QKV = WS_HB + 128 * MB;
constexpr size_t WS_OG = WS_QKV + 576 * MB;
constexpr size_t WS_LSE = WS_OG + 192 * MB;
constexpr size_t WS_FG = WS_LSE + 3 * MB;
constexpr size_t WS_C2 = WS_FG + 2 * MB;
constexpr size_t WS_SC = WS_C2 + 2 * MB;
constexpr size_t WS_END = WS_SC + 1 * MB;
constexpr size_t WS_A2 = WS_QKV;
constexpr size_t WS_QP = WS_QKV + 128 * MB;
constexpr size_t WS_PART = WS_QKV + 192 * MB;
constexpr size_t WS_POUT = WS_QKV + 448 * MB;
constexpr size_t WS_PIDX = WS_QKV + 704 * MB;
constexpr size_t WS_PGATE = WS_QKV + 712 * MB;
constexpr size_t WS_PW = WS_QKV + 720 * MB;
constexpr size_t WS_X8 = WS_POUT;
constexpr size_t WS_XS = WS_SC + 256 * 1024;
constexpr size_t WS_WS = WS_SC + 512 * 1024;
constexpr size_t WS_WQ8 = WS_END;
constexpr size_t WS_WIN8 = WS_END + 8 * MB;
constexpr size_t WS_WOUT8 = WS_END + 88 * MB;
constexpr size_t WS_SC2 = WS_END + 108 * MB;
constexpr size_t WS_END2 = WS_END + 110 * MB;
constexpr size_t WS_X8A = WS_HB;
constexpr size_t WS_X8B = WS_HB + 64 * MB;
constexpr size_t WS_A28 = WS_QKV;
constexpr size_t WS_OG8 = WS_QKV + 448 * MB;
static_assert(WS_PW + 8 * MB <= WS_OG + 192 * MB, "PEER scratch must fit in the q|k|v + OG regions");
constexpr int BAR_REGION_WORDS = 4096;
constexpr int MAX_LAUNCHES = 32;

constexpr int NTHREADS = 512;
constexpr int LDS_BYTES = 147456;
constexpr int LDS_BARW = LDS_BYTES - 16;

struct Ctx { LAS unsigned char* lds; int tid, lane, wave, G, bid; };

typedef float f32x2c __attribute__((ext_vector_type(2)));
__device__ __forceinline__ unsigned pk2(float lo, float hi) { const f32x2c v = {lo, hi}; const bf16x2 b = __builtin_convertvector(v, bf16x2); return __builtin_bit_cast(unsigned, b); }
__device__ __forceinline__ float bf_lo(unsigned w) { return __uint_as_float(w << 16); }
__device__ __forceinline__ float bf_hi(unsigned w) { return __uint_as_float(w & 0xffff0000u); }
template <int CTRL> __device__ __forceinline__ float dppf(float x) { return __builtin_bit_cast(float, __builtin_amdgcn_mov_dpp(__builtin_bit_cast(int, x), CTRL, 0xf, 0xf, true)); }
__device__ __forceinline__ float wave_sum(float x) {
    x += dppf<0xB1>(x); x += dppf<0x4E>(x); x += dppf<0x141>(x); x += dppf<0x128>(x);
    auto s = __builtin_amdgcn_permlane16_swap(__float_as_uint(x), __float_as_uint(x), false, false);
    x = __uint_as_float(s[0]) + __uint_as_float(s[1]);
    auto t = __builtin_amdgcn_permlane32_swap(__float_as_uint(x), __float_as_uint(x), false, false);
    return __uint_as_float(t[0]) + __uint_as_float(t[1]);
}
__device__ __forceinline__ float pair_max(float x) { auto t = __builtin_amdgcn_permlane32_swap(__float_as_uint(x), __float_as_uint(x), false, false); return fmaxf(__uint_as_float(t[0]), __uint_as_float(t[1])); }
__device__ __forceinline__ float pair_sum(float x) { auto t = __builtin_amdgcn_permlane32_swap(__float_as_uint(x), __float_as_uint(x), false, false); return __uint_as_float(t[0]) + __uint_as_float(t[1]); }
__device__ __forceinline__ int pair_maxi(int x) { auto t = __builtin_amdgcn_permlane32_swap((unsigned)x, (unsigned)x, false, false); const int a = (int)t[0], b = (int)t[1]; return a > b ? a : b; }
__device__ __forceinline__ bf16x8 pack8(float a0, float a1, float a2, float a3, float b0, float b1, float b2, float b3) {
    u32x4 w = {pk2(a0, a1), pk2(a2, a3), pk2(b0, b1), pk2(b2, b3)}; return __builtin_bit_cast(bf16x8, w);
}
__device__ __forceinline__ float dot2(unsigned a, unsigned b, float acc) { return __builtin_amdgcn_fdot2_f32_bf16(__builtin_bit_cast(bf16x2, a), __builtin_bit_cast(bf16x2, b), acc, false); }
#define MK_LDS_WAIT() asm volatile("s_waitcnt lgkmcnt(0)" ::: "memory")

__device__ __forceinline__ void transpose_weights(const Ctx& c, const float* __restrict__ W, int K, int N, bf16_t* __restrict__ WT) {
    LAS float* scr = (LAS float*)(c.lds + c.wave * 8704);
    const int lane = c.lane, nblk = N / 32, nitems = (K / 64) * nblk;
    for (int item = c.bid * 8 + c.wave; item < nitems; item += c.G * 8) {
        const int kb = item / nblk, nb = item - kb * nblk, k0 = 64 * kb, n0 = 32 * nb;
#pragma unroll 8
        for (int i = 0; i < 32; ++i) { const int kk = 2 * i + (lane >> 5); scr[kk * 33 + (lane & 31)] = W[(size_t)(k0 + kk) * N + n0 + (lane & 31)]; }
        MK_LDS_WAIT();
        const int cch = lane & 7;
#pragma unroll
        for (int j = 0; j < 4; ++j) { const int n = (lane >> 3) + 8 * j; const LAS float* s = scr + (8 * cch) * 33 + n;
            u32x4 o; o.x = pk2(s[0 * 33], s[1 * 33]); o.y = pk2(s[2 * 33], s[3 * 33]); o.z = pk2(s[4 * 33], s[5 * 33]); o.w = pk2(s[6 * 33], s[7 * 33]);
            *(u32x4*)(WT + (size_t)(n0 + n) * K + k0 + 8 * cch) = o; }
        MK_LDS_WAIT();
    }
}
__device__ __forceinline__ unsigned pack_i8x4(f32x4 a);
template <int KK>
__device__ __forceinline__ void transpose_quant(const Ctx& c, const float* __restrict__ W, int N, unsigned char* __restrict__ W8, float* __restrict__ sc, int rot) {
    constexpr int NT = KK / 512, NREG = NT < 6 ? NT : 6;
    LAS float* scr = (LAS float*)(c.lds + c.wave * 8704);
    LAS float* cmx = (LAS float*)(c.lds + 8 * 8704);
    static_assert(8 * 8704 + 1024 + 2 * 4 * 512 * 16 <= LDS_BARW, "transpose_quant LDS");
    const int nblk = N / 32;
#pragma unroll 1
    for (int nb = (c.bid - rot % c.G + c.G) % c.G; nb < nblk; nb += c.G) {
        int lane = mk_hw_lane();
        LAS u32x4* priv = (LAS u32x4*)(c.lds + 8 * 8704 + 1024) + (c.wave * 64 + lane);
        const int n0 = 32 * nb, cch = lane & 7;
        u32x4 keep[NREG][4]; float mx[4] = {0.f, 0.f, 0.f, 0.f};
        f32x4 ld[8];
#define MK_TQ_LOAD(t_) do { int k0_ = 64 * (c.wave + 8 * (t_)); asm volatile("" : "+s"(k0_)); const float* wp_ = W + (size_t)(k0_ + (lane >> 3)) * N + n0 + 4 * (lane & 7); \
            _Pragma("unroll") for (int i_ = 0; i_ < 8; ++i_) ld[i_] = *(const f32x4*)(wp_ + (size_t)(8 * i_) * N); } while (0)
        MK_TQ_LOAD(0);
#pragma unroll
        for (int t = 0; t < NT; ++t) { asm volatile("" : "+v"(lane));
#pragma unroll
            for (int i = 0; i < 8; ++i) { LAS float* d = scr + (8 * i + (lane >> 3)) * 33 + 4 * (lane & 7); d[0] = ld[i][0]; d[1] = ld[i][1]; d[2] = ld[i][2]; d[3] = ld[i][3]; }
            asm volatile("" ::: "memory");
            if (t + 1 < NT) MK_TQ_LOAD(t + 1);
            asm volatile("" ::: "memory");
            MK_LDS_WAIT();
#pragma unroll
            for (int j = 0; j < 4; ++j) { asm volatile("" ::: "memory");
                const int n = (lane >> 3) + 8 * j; const LAS float* s = scr + (8 * cch) * 33 + n;
                u32x4 o; o.x = pk2(s[0 * 33], s[1 * 33]); o.y = pk2(s[2 * 33], s[3 * 33]); o.z = pk2(s[4 * 33], s[5 * 33]); o.w = pk2(s[6 * 33], s[7 * 33]);
                if (t < NREG) keep[t < NREG ? t : 0][j] = o; else priv[((t - NREG) * 4 + j) * 512] = o;
#pragma unroll
                for (int e = 0; e < 4; ++e) mx[j] = fmaxf(mx[j], fmaxf(fabsf(bf_lo(o[e])), fabsf(bf_hi(o[e])))); }
            MK_LDS_WAIT();
        }
#undef MK_TQ_LOAD
#pragma unroll
        for (int j = 0; j < 4; ++j) { float m = mx[j]; m = fmaxf(m, dppf<0xB1>(m)); m = fmaxf(m, dppf<0x4E>(m)); m = fmaxf(m, dppf<0x141>(m));
            if (cch == 0) cmx[c.wave * 32 + (lane >> 3) + 8 * j] = m; }
        __syncthreads();
        float scale[4];
#pragma unroll
        for (int j = 0; j < 4; ++j) { const int n = (lane >> 3) + 8 * j; float m = cmx[n];
#pragma unroll
            for (int w = 1; w < 8; ++w) m = fmaxf(m, cmx[w * 32 + n]);
            const bool ok = (m > 1e-30f) && (m < 1e30f);
            scale[j] = ok ? 127.0f / m : 0.f;
            if (c.wave == 0 && cch == 0) sc[n0 + n] = ok ? m * (1.0f / 127.0f) : 0.f; }
#pragma unroll
        for (int t = 0; t < NT; ++t)
#pragma unroll
            for (int j = 0; j < 4; ++j) { u32x4 o; if (t < NREG) o = keep[t < NREG ? t : 0][j]; else o = priv[((t - NREG) * 4 + j) * 512]; asm volatile("" : "+v"(o));
                u32x2 w;
                w[0] = pack_i8x4((f32x4){bf_lo(o[0]), bf_hi(o[0]), bf_lo(o[1]), bf_hi(o[1])} * scale[j]);
                w[1] = pack_i8x4((f32x4){bf_lo(o[2]), bf_hi(o[2]), bf_lo(o[3]), bf_hi(o[3])} * scale[j]);
                *(u32x2*)(W8 + (size_t)(n0 + (lane >> 3) + 8 * j) * KK + 64 * (c.wave + 8 * t) + 8 * cch) = w; }
        __syncthreads();
    }
}
__device__ __forceinline__ int strips_for(int nblk, int rot, int G, int b) { const int r = (b - rot % G + G) % G; return nblk / G + (r < nblk % G ? 1 : 0); }
struct ConvDeal { int lo, hi, covered; };
__device__ __forceinline__ ConvDeal conv_deal(int G, int bid, int nb0, int w0, int nb1, int rot1, int w1, int nb2, int rot2, int w2, int total) {
    int cmax = 0, csum = 0, cpre = 0, mine = 0;
    int r1 = (G - rot1 % G) % G, r2 = (G - rot2 % G) % G;
    const int q0 = nb0 / G, m0 = nb0 % G, q1 = nb1 / G, m1 = nb1 % G, q2 = nb2 / G, m2 = nb2 % G;
    for (int b = 0; b < G; ++b) { const int cb = (q0 + (b < m0 ? 1 : 0)) * w0 + (q1 + (r1 < m1 ? 1 : 0)) * w1 + (q2 + (r2 < m2 ? 1 : 0)) * w2;
        cmax = cb > cmax ? cb : cmax; csum += cb; if (b < bid) cpre += cb; if (b == bid) mine = cb;
        r1 = (r1 + 1 == G) ? 0 : r1 + 1; r2 = (r2 + 1 == G) ? 0 : r2 + 1; }
    const int spare = total - (G * cmax - csum);
    ConvDeal d;
    if (spare < 0) { d.lo = 0; d.hi = 0; d.covered = 0; return d; }
    const int base = (spare / G) & ~7;
    d.lo = base * bid + (bid * cmax - cpre); d.hi = d.lo + base + (cmax - mine); d.covered = G * base + (G * cmax - csum);
    return d;
}
__device__ __forceinline__ void convert_flat(const Ctx& c, const float* __restrict__ src, bf16_t* __restrict__ dst, size_t n) {
    const size_t n8 = n / 8, stride = (size_t)c.G * NTHREADS;
    for (size_t i = (size_t)c.bid * NTHREADS + c.tid; i < n8; i += stride) {
        const f32x4 a = *(const f32x4*)(src + i * 8), b = *(const f32x4*)(src + i * 8 + 4);
        u32x4 o = {pk2(a[0], a[1]), pk2(a[2], a[3]), pk2(b[0], b[1]), pk2(b[2], b[3])};
        *(u32x4*)(dst + i * 8) = o;
    }
}
__device__ __forceinline__ void zero_flat16(const Ctx& c, void* dst, size_t bytes) {
    const size_t n = bytes / 16, stride = (size_t)c.G * NTHREADS; const u32x4 z = {0u, 0u, 0u, 0u};
    for (size_t i = (size_t)c.bid * NTHREADS + c.tid; i < n; i += stride) ((u32x4*)dst)[i] = z;
}

__device__ __forceinline__ float wave_max(float x) {
    x = fmaxf(x, dppf<0xB1>(x)); x = fmaxf(x, dppf<0x4E>(x)); x = fmaxf(x, dppf<0x141>(x)); x = fmaxf(x, dppf<0x128>(x));
    auto s = __builtin_amdgcn_permlane16_swap(__float_as_uint(x), __float_as_uint(x), false, false);
    x = fmaxf(__uint_as_float(s[0]), __uint_as_float(s[1]));
    auto t = __builtin_amdgcn_permlane32_swap(__float_as_uint(x), __float_as_uint(x), false, false);
    return fmaxf(__uint_as_float(t[0]), __uint_as_float(t[1]));
}
__device__ __forceinline__ void convert_rows_fp8(const Ctx& c, const float* __restrict__ src, unsigned char* __restrict__ dst, float* __restrict__ inv, int rows) {
    for (int row = c.bid * 8 + c.wave; row < rows; row += c.G * 8) {
        const float* rp = src + (size_t)row * DM + c.lane * 16;
        f32x4 v[16]; float mx = 0.f;
#pragma unroll
        for (int i = 0; i < 4; ++i)
#pragma unroll
            for (int q = 0; q < 4; ++q) { v[4 * i + q] = *(const f32x4*)(rp + i * 1024 + 4 * q);
                mx = fmaxf(mx, fmaxf(fmaxf(fabsf(v[4 * i + q][0]), fabsf(v[4 * i + q][1])), fmaxf(fabsf(v[4 * i + q][2]), fabsf(v[4 * i + q][3])))); }
        mx = wave_max(mx);
        const unsigned ex = (__float_as_uint(mx) >> 23) & 0xffu;
        const bool ok = (ex > 8u) && (ex < 250u);
        const float scale = ok ? __uint_as_float((261u - ex) << 23) : 1.0f, iscale = ok ? __uint_as_float((ex - 7u) << 23) : 1.0f;
        if (c.lane == 0) inv[row] = iscale;
        unsigned char* op = dst + ((size_t)(c.lane >> 3) * 16384 + row) * 128 + (c.lane & 7) * 16;
#pragma unroll
        for (int i = 0; i < 4; ++i) { u32x4 w;
#pragma unroll
            for (int q = 0; q < 4; ++q) { const f32x4 a = v[4 * i + q] * scale; int t = 0; t = __builtin_amdgcn_cvt_pk_fp8_f32(a[0], a[1], t, false); t = __builtin_amdgcn_cvt_pk_fp8_f32(a[2], a[3], t, true); w[q] = (unsigned)t; }
            *(u32x4*)(op + (size_t)i * 8 * 16384 * 128) = w; }
    }
}

__device__ __forceinline__ unsigned pack_i8x4(f32x4 a) {
    const int q0 = (int)__builtin_rintf(a[0]), q1 = (int)__builtin_rintf(a[1]), q2 = (int)__builtin_rintf(a[2]), q3 = (int)__builtin_rintf(a[3]);
    return ((unsigned)q0 & 0xffu) | (((unsigned)q1 & 0xffu) << 8) | (((unsigned)q2 & 0xffu) << 16) | ((unsigned)q3 << 24);
}
__device__ __forceinline__ void convert_rows_i8(const Ctx& c, const float* __restrict__ src, unsigned char* __restrict__ dst, float* __restrict__ inv, int row_begin, int row_end, int row_step) {
    for (int row = row_begin; row < row_end; row += row_step) {
        const float* rp = src + (size_t)row * DM + c.lane * 16;
        f32x4 v[16]; float mx = 0.f;
#pragma unroll
        for (int i = 0; i < 4; ++i)
#pragma unroll
            for (int q = 0; q < 4; ++q) { v[4 * i + q] = *(const f32x4*)(rp + i * 1024 + 4 * q);
                mx = fmaxf(mx, fmaxf(fmaxf(fabsf(v[4 * i + q][0]), fabsf(v[4 * i + q][1])), fmaxf(fabsf(v[4 * i + q][2]), fabsf(v[4 * i + q][3])))); }
        mx = wave_max(mx);
        const bool ok = (mx > 1e-30f) && (mx < 1e30f);
        const float scale = ok ? 127.0f / mx : 1.0f, iscale = ok ? mx * (1.0f / 127.0f) : 1.0f;
        if (c.lane == 0) inv[row] = iscale;
        unsigned char* op = dst + ((size_t)(c.lane >> 3) * 16384 + row) * 128 + (c.lane & 7) * 16;
#pragma unroll
        for (int i = 0; i < 4; ++i) { u32x4 w;
#pragma unroll
            for (int q = 0; q < 4; ++q) w[q] = pack_i8x4(v[4 * i + q] * scale);
            *(u32x4*)(op + (size_t)i * 8 * 16384 * 128) = w; }
    }
}

template <int KK>
__device__ __forceinline__ void quant_rows_bf16_i8(const Ctx& c, const bf16_t* __restrict__ src, unsigned char* __restrict__ dst, float* __restrict__ sc, int rows) {
    constexpr int NCH = KK / 512;
    for (int row = c.bid * 8 + c.wave; row < rows; row += c.G * 8) {
        int ln = c.lane; asm volatile("" : "+v"(ln));
        const bf16_t* rp = src + (size_t)row * KK + ln * 8;
        u32x4 v[NCH]; float mx = 0.f;
#pragma unroll
        for (int i = 0; i < NCH; ++i) { v[i] = *(const u32x4*)(rp + i * 512);
#pragma unroll
            for (int j = 0; j < 4; ++j) mx = fmaxf(mx, fmaxf(fabsf(bf_lo(v[i][j])), fabsf(bf_hi(v[i][j])))); }
        mx = wave_max(mx);
        const bool ok = (mx > 1e-30f) && (mx < 1e30f);
        const float scale = ok ? 127.0f / mx : 0.f;
        if (ln == 0) sc[row] = ok ? mx * (1.0f / 127.0f) : 0.f;
        unsigned char* op = dst + (size_t)row * KK + ln * 8;
#pragma unroll
        for (int i = 0; i < NCH; ++i) { u32x2 w;
            w[0] = pack_i8x4((f32x4){bf_lo(v[i][0]), bf_hi(v[i][0]), bf_lo(v[i][1]), bf_hi(v[i][1])} * scale);
            w[1] = pack_i8x4((f32x4){bf_lo(v[i][2]), bf_hi(v[i][2]), bf_lo(v[i][3]), bf_hi(v[i][3])} * scale);
            *(u32x2*)(op + i * 512) = w; }
    }
}

__device__ __forceinline__ void quant_rows_f32_i8(const Ctx& c, const float* __restrict__ src, unsigned char* __restrict__ dst, float* __restrict__ sc, int rows) {
    for (int row = c.bid * 8 + c.wave; row < rows; row += c.G * 8) {
        int ln = c.lane; asm volatile("" : "+v"(ln));
        const size_t off = (size_t)row * DM + 4 * ln;
        f32x4 v[16]; float mx = 0.f;
#pragma unroll
        for (int j = 0; j < 16; ++j) { v[j] = *(const f32x4*)(src + off + 256 * j); mx = fmaxf(mx, fmaxf(fmaxf(fabsf(v[j][0]), fabsf(v[j][1])), fmaxf(fabsf(v[j][2]), fabsf(v[j][3])))); }
        mx = wave_max(mx);
        const bool ok = (mx > 1e-30f) && (mx < 1e30f);
        const float scale = ok ? 127.0f / mx : 0.f;
        if (ln == 0) sc[row] = ok ? mx * (1.0f / 127.0f) : 0.f;
#pragma unroll
        for (int j = 0; j < 16; ++j) *(unsigned*)(dst + off + 256 * j) = pack_i8x4(v[j] * scale);
    }
}

__device__ __forceinline__ void ln_phase(const Ctx& c, const bf16_t* Hf, float* dst, bf16_t* Hb, const float* __restrict__ g, const float* __restrict__ b, unsigned char* X8 = nullptr, float* XS = nullptr) {
    for (int row = c.bid * 8 + c.wave; row < T; row += c.G * 8) {
        int ln = c.lane; asm volatile("" : "+v"(ln));
        const size_t off = (size_t)row * DM + 4 * ln;
        f32x4 v[16]; float s = 0.f;
#pragma unroll
        for (int j = 0; j < 16; ++j) { const u32x2 hw = *(const u32x2*)(Hf + off + 256 * j); v[j] = (f32x4){bf_lo(hw[0]), bf_hi(hw[0]), bf_lo(hw[1]), bf_hi(hw[1])}; s += (v[j][0] + v[j][1]) + (v[j][2] + v[j][3]); }
        const float mean = wave_sum(s) * (1.f / DM); float q = 0.f;
#pragma unroll
        for (int j = 0; j < 16; ++j) { v[j] = v[j] - mean; q += (v[j][0] * v[j][0] + v[j][1] * v[j][1]) + (v[j][2] * v[j][2] + v[j][3] * v[j][3]); }
        const float rstd = 1.0f / sqrtf(wave_sum(q) * (1.f / DM) + LN_EPS);
#pragma unroll
        for (int j = 0; j < 16; ++j) { if ((j & 3) == 0) asm volatile("" ::: "memory");
            const f32x4 gg = *(const f32x4*)(g + 4 * ln + 256 * j), bb = *(const f32x4*)(b + 4 * ln + 256 * j);
            const f32x4 o = v[j] * rstd * gg + bb; if (dst) *(f32x4*)(dst + off + 256 * j) = o; v[j] = o;
            if (Hb) { u32x2 w = {pk2(o[0], o[1]), pk2(o[2], o[3])}; *(u32x2*)(Hb + off + 256 * j) = w; } }
        if (X8) {
            float mx = 0.f;
#pragma unroll
            for (int j = 0; j < 16; ++j) mx = fmaxf(mx, fmaxf(fmaxf(fabsf(v[j][0]), fabsf(v[j][1])), fmaxf(fabsf(v[j][2]), fabsf(v[j][3]))));
            mx = wave_max(mx);
            const bool ok = (mx > 1e-30f) && (mx < 1e30f);
            const float scale = ok ? 127.0f / mx : 1.0f;
            if (ln == 0) XS[row] = ok ? mx * (1.0f / 127.0f) : 1.0f;
#pragma unroll
            for (int j = 0; j < 16; ++j) *(unsigned*)(X8 + off + 256 * j) = pack_i8x4(v[j] * scale);
        }
    }
}

__device__ __forceinline__ void merge_phase(const Ctx& c, const bf16_t* __restrict__ OG, const float* __restrict__ LSE, unsigned char* __restrict__ A28, float* __restrict__ SA2) {
    for (int tok = c.bid * 8 + c.wave; tok < T; tok += c.G * 8) {
        int ln = c.lane; asm volatile("" : "+v"(ln));
        float o[32]; float mx = 0.f;
#pragma unroll
        for (int j = 0; j < 4; ++j) { const int col = 8 * ln + 512 * j, head = col >> 7;
            const float l0 = LSE[(0 * (size_t)T + tok) * 16 + head], l1 = LSE[(1 * (size_t)T + tok) * 16 + head], l2 = LSE[(2 * (size_t)T + tok) * 16 + head];
            const float lm = fmaxf(l0, fmaxf(l1, l2));
            float e0 = __expf(l0 - lm), e1 = __expf(l1 - lm), e2 = __expf(l2 - lm); const float inv = 1.0f / (e0 + e1 + e2); e0 *= inv; e1 *= inv; e2 *= inv;
            const u32x4 a = *(const u32x4*)(OG + (0 * (size_t)T + tok) * 2048 + col), b = *(const u32x4*)(OG + (1 * (size_t)T + tok) * 2048 + col), d = *(const u32x4*)(OG + (2 * (size_t)T + tok) * 2048 + col);
#pragma unroll
            for (int w = 0; w < 4; ++w) { const float lo = e0 * bf_lo(a[w]) + e1 * bf_lo(b[w]) + e2 * bf_lo(d[w]), hi = e0 * bf_hi(a[w]) + e1 * bf_hi(b[w]) + e2 * bf_hi(d[w]);
                o[8 * j + 2 * w] = lo; o[8 * j + 2 * w + 1] = hi; mx = fmaxf(mx, fmaxf(fabsf(lo), fabsf(hi))); } }
        mx = wave_max(mx);
        const bool ok = (mx > 1e-30f) && (mx < 1e30f);
        const float scale = ok ? 127.0f / mx : 0.f;
        if (ln == 0) SA2[tok] = ok ? mx * (1.0f / 127.0f) : 0.f;
#pragma unroll
        for (int j = 0; j < 4; ++j) { u32x2 w;
            w[0] = pack_i8x4((f32x4){o[8 * j], o[8 * j + 1], o[8 * j + 2], o[8 * j + 3]} * scale); w[1] = pack_i8x4((f32x4){o[8 * j + 4], o[8 * j + 5], o[8 * j + 6], o[8 * j + 7]} * scale);
            *(u32x2*)(A28 + (size_t)tok * 2048 + 8 * ln + 512 * j) = w; }
    }
}

__device__ __forceinline__ void cumsum_phase(const Ctx& c, const float* __restrict__ FG, const float* __restrict__ fbias, float* __restrict__ C2, float* __restrict__ C2N) {
    LAS float* wtot = (LAS float*)c.lds;
    for (int seq = c.bid; seq < NBATCH * 32; seq += c.G) {
        const int b = seq >> 5, hd = seq & 31; const float bias = fbias[hd];
        float p[4]; float run = 0.f;
#pragma unroll
        for (int i = 0; i < 4; ++i) { const float z = FG[((size_t)b * SEQ + 4 * c.tid + i) * 32 + hd] + bias; const float lf = fminf(z, 0.f) - log1pf(__expf(-fabsf(z))); run += lf; p[i] = run; }
        float v = run;
#pragma unroll
        for (int o = 1; o < 64; o <<= 1) { const float nb = __shfl_up(v, o); if (c.lane >= o) v += nb; }
        if (c.lane == 63) wtot[c.wave] = v;
        __syncthreads();
        float woff = 0.f;
        for (int w = 0; w < c.wave; ++w) woff += wtot[w];
        const float excl = woff + v - run;
        f32x4 o = {(excl + p[0]) * LOG2E, (excl + p[1]) * LOG2E, (excl + p[2]) * LOG2E, (excl + p[3]) * LOG2E};
        *(f32x4*)(C2 + (size_t)seq * SEQ + 4 * c.tid) = o; *(f32x4*)(C2N + (size_t)seq * SEQ + 4 * c.tid) = -o;
        __syncthreads();
    }
}

constexpr float ATT_THR = 8.0f;
constexpr int KT_PITCH = 272, KT_BYTES = 64 * KT_PITCH;
constexpr int VT_PITCH = 144, VT_BYTES = 128 * VT_PITCH;
constexpr int ABUF_BYTES = KT_BYTES + VT_BYTES;
constexpr int AHALF_BYTES = 2 * ABUF_BYTES + 512;
static_assert(2 * AHALF_BYTES <= LDS_BARW, "attention LDS");

struct AttnHalf { const bf16_t* q; const bf16_t* k; const bf16_t* v; bf16_t* o; float* lse; const float* c2; const float* c2n; float sd2; };
struct AttnTile { size_t rstride, ostride, lstride; int q0, kt_lo, kt_hi; unsigned Wn; int desc; };

__device__ __forceinline__ void half_barrier(LAS unsigned* cnt, int& gen, int lane) {
    asm volatile("s_waitcnt lgkmcnt(0)" ::: "memory");
    if (lane == 0) __hip_atomic_fetch_add((unsigned*)cnt, 1u, __ATOMIC_RELAXED, __HIP_MEMORY_SCOPE_WORKGROUP);
    ++gen; const unsigned target = 4u * (unsigned)gen;
    for (unsigned spins = 0; spins < (1u << 22); ++spins) {
        const unsigned v = __hip_atomic_load((unsigned*)cnt, __ATOMIC_RELAXED, __HIP_MEMORY_SCOPE_WORKGROUP);
        if ((unsigned)__builtin_amdgcn_readfirstlane((int)v) >= target) break;
        __builtin_amdgcn_s_sleep(1);
    }
    asm volatile("s_waitcnt lgkmcnt(0)" ::: "memory");
}
constexpr int ATT_CNT_OFF = 2 * AHALF_BYTES;
static_assert(ATT_CNT_OFF + 128 <= LDS_BARW, "attention counters");
template <int MODE, int VAR = 0>
__device__ __forceinline__ void attn_tile(const Ctx& c, const AttnHalf& H, const AttnTile& A, int& gen) {
    int lane = c.lane; asm volatile("" : "+v"(lane));
    const int hw = c.wave & 3, ht = (c.wave & 3) * 64 + lane, h = lane >> 5, cc = lane & 31;
    LAS unsigned char* base = c.lds + (c.wave >> 2) * AHALF_BYTES;
    LAS unsigned* hcnt = (LAS unsigned*)(c.lds + ATT_CNT_OFF + (c.wave >> 2) * 64);
    const int qlo = A.q0 + 32 * hw, qm = qlo + cc;
    bf16x8 qf[8];
    { const bf16_t* qp = H.q + (size_t)qm * A.rstride + 8 * h;
#pragma unroll
      for (int ks = 0; ks < 8; ++ks) { const u32x4 w = *(const u32x4*)(qp + 16 * ks); u32x4 o;
#pragma unroll
          for (int j = 0; j < 4; ++j) o[j] = pk2(bf_lo(w[j]) * QSCALE2, bf_hi(w[j]) * QSCALE2);
          qf[ks] = __builtin_bit_cast(bf16x8, o); } }
    const float rowterm = MODE ? H.c2[qm] : -H.sd2 * (float)qm;
    f32x16 oacc[4];
#pragma unroll
    for (int d = 0; d < 4; ++d)
#pragma unroll
        for (int r = 0; r < 16; ++r) oacc[d][r] = 0.f;
    float m_run = 0.f, l_run = 0.f;

    u32x4 kst[4], vst[4]; float ctv = 0.f;
    const int s_key = ht >> 4, s_c16 = ht & 15;
    const int v_kq = ht & 15, v_do = ht >> 4;
    const int v_kqs = (v_kq & ~3) | ((v_kq & 1) << 1) | ((v_kq >> 1) & 1);
#define MK_ATT_LOAD(kt) do { const int k0_ = 64 * (kt); \
        _Pragma("unroll") for (int i_ = 0; i_ < 4; ++i_) kst[i_] = *(const u32x4*)(H.k + (size_t)(k0_ + s_key + 16 * i_) * A.rstride + s_c16 * 8); \
        _Pragma("unroll") for (int i_ = 0; i_ < 4; ++i_) vst[i_] = *(const u32x4*)(H.v + (size_t)(k0_ + 4 * v_kq + i_) * A.rstride + v_do * 8); \
        if (ht < 64) ctv = MODE ? H.c2n[k0_ + ht] : H.sd2 * (float)(k0_ + ht); } while (0)
#define MK_ATT_WRITE(b) do { LAS unsigned char* kb_ = base + (b) * ABUF_BYTES; LAS unsigned char* vb_ = kb_ + KT_BYTES; \
        _Pragma("unroll") for (int i_ = 0; i_ < 4; ++i_) *(LAS u32x4*)(kb_ + (s_key + 16 * i_) * KT_PITCH + s_c16 * 16) = kst[i_]; \
        _Pragma("unroll") for (int w_ = 0; w_ < 4; ++w_) { \
            u32x2 e_ = {(vst[0][w_] & 0xffffu) | (vst[1][w_] << 16), (vst[2][w_] & 0xffffu) | (vst[3][w_] << 16)}; \
            u32x2 o_ = {(vst[0][w_] >> 16) | (vst[1][w_] & 0xffff0000u), (vst[2][w_] >> 16) | (vst[3][w_] & 0xffff0000u)}; \
            *(LAS u32x2*)(vb_ + (v_do * 8 + 2 * w_) * VT_PITCH + v_kqs * 8) = e_; \
            *(LAS u32x2*)(vb_ + (v_do * 8 + 2 * w_ + 1) * VT_PITCH + v_kqs * 8) = o_; } \
        if (ht < 64) ((LAS float*)(base + 2 * ABUF_BYTES + (b) * 256))[ht] = ctv; } while (0)

#define MK_KT(t_) (A.desc ? (A.kt_hi - 1 - (t_)) : (A.kt_lo + (t_)))
    const int nt = A.kt_hi - A.kt_lo;
    MK_ATT_LOAD(MK_KT(0)); MK_ATT_WRITE(0);
    half_barrier(hcnt, gen, lane);
    for (int t = 0; t < nt; ++t) {
        const bool more = (t + 1 < nt);
        if (more && VAR != 2 && VAR != 3) MK_ATT_LOAD(MK_KT(t + 1));
#ifdef MK_TEST_WAIT
        if (MODE) asm volatile("s_waitcnt vmcnt(0)" ::: "memory");
#endif
        const int k0 = 64 * MK_KT(t), qhi = qlo + 31;
        const bool need = (VAR != 1) && (k0 <= qhi) && (MODE || (k0 + 63 + (int)A.Wn >= qlo));
        if (need) {
            const LAS unsigned char* kb = base + (t & 1) * ABUF_BYTES; const LAS unsigned char* vb = kb + KT_BYTES;
            const LAS float* ctp = (const LAS float*)(base + 2 * ABUF_BYTES + (t & 1) * 256) + 4 * h;
            f32x16 s0, s1;
            { const float rb = rowterm - m_run;
#pragma unroll
              for (int q4 = 0; q4 < 4; ++q4) { const f32x4 c0 = *(const LAS f32x4*)(ctp + 8 * q4), c1 = *(const LAS f32x4*)(ctp + 32 + 8 * q4);
#pragma unroll
                  for (int i = 0; i < 4; ++i) { s0[4 * q4 + i] = rb + c0[i]; s1[4 * q4 + i] = rb + c1[i]; } } }
            bf16x8 fr[8];
            const LAS unsigned char* ka = kb + cc * KT_PITCH + 16 * h;
            const LAS unsigned char* va = vb + cc * VT_PITCH + 16 * h;
#pragma unroll
            for (int ks = 0; ks < 4; ++ks) { fr[2 * ks] = *(const LAS bf16x8*)(ka + 32 * ks); fr[2 * ks + 1] = *(const LAS bf16x8*)(ka + 32 * KT_PITCH + 32 * ks); }
            __builtin_amdgcn_sched_barrier(0);
#pragma unroll
            for (int ks = 0; ks < 8; ++ks) {
                s0 = __builtin_amdgcn_mfma_f32_32x32x16_bf16(fr[2 * (ks & 3)], qf[ks], s0, 0, 0, 0);
                s1 = __builtin_amdgcn_mfma_f32_32x32x16_bf16(fr[2 * (ks & 3) + 1], qf[ks], s1, 0, 0, 0);
                __builtin_amdgcn_sched_barrier(0);
                if (ks < 4) { fr[2 * ks] = *(const LAS bf16x8*)(ka + 32 * (ks + 4)); fr[2 * ks + 1] = *(const LAS bf16x8*)(ka + 32 * KT_PITCH + 32 * (ks + 4)); }
                else {
#pragma unroll
                    for (int e = 0; e < 2; ++e) { const int f = 2 * (ks - 4) + e; fr[f] = *(const LAS bf16x8*)(va + (f >> 2) * 32 * VT_PITCH + (f & 3) * 32); } }
                __builtin_amdgcn_sched_barrier(0);
            }
            const bool full = (VAR == 3) || ((k0 + 63 <= qlo) && (MODE || (k0 + (int)A.Wn >= qhi)));
            if (!full) { const int dq = qm - k0 - 4 * h; const float NEG = -__builtin_inff();
#pragma unroll
                for (int r = 0; r < 16; ++r) { const int ko = (r & 3) + 8 * (r >> 2);
                    if ((unsigned)(dq - ko) > A.Wn) s0[r] = NEG;
                    if ((unsigned)(dq - ko - 32) > A.Wn) s1[r] = NEG; } }
            float mx = fmaxf(s0[0], s1[0]);
            if (VAR != 3) {
#pragma unroll
            for (int r = 1; r < 16; ++r) mx = fmaxf(mx, fmaxf(s0[r], s1[r]));
            mx = pair_max(mx); }
            if (VAR != 3 && !__all(mx <= ATT_THR)) {
                const float shift = (mx > ATT_THR) ? mx : 0.f, alpha = __builtin_amdgcn_exp2f(-shift);
                m_run += shift; l_run *= alpha;
#pragma unroll
                for (int r = 0; r < 16; ++r) { s0[r] -= shift; s1[r] -= shift; }
#pragma unroll
                for (int d = 0; d < 4; ++d)
#pragma unroll
                    for (int r = 0; r < 16; ++r) oacc[d][r] *= alpha;
            }
            float ps = 0.f;
#pragma unroll
            for (int r = 0; r < 16; ++r) { if (VAR != 3) { s0[r] = __builtin_amdgcn_exp2f(s0[r]); s1[r] = __builtin_amdgcn_exp2f(s1[r]); ps += s0[r] + s1[r]; } }
            if (VAR == 3) ps = s0[0];
            l_run += ps;
            bf16x8 pb[4];
            pb[0] = pack8(s0[0], s0[1], s0[2], s0[3], s0[4], s0[5], s0[6], s0[7]);
            pb[1] = pack8(s0[8], s0[9], s0[10], s0[11], s0[12], s0[13], s0[14], s0[15]);
            pb[2] = pack8(s1[0], s1[1], s1[2], s1[3], s1[4], s1[5], s1[6], s1[7]);
            pb[3] = pack8(s1[8], s1[9], s1[10], s1[11], s1[12], s1[13], s1[14], s1[15]);
            __builtin_amdgcn_sched_barrier(0);
#pragma unroll
            for (int d = 0; d < 4; ++d) {
#pragma unroll
                for (int kk = 0; kk < 4; ++kk) oacc[d] = __builtin_amdgcn_mfma_f32_32x32x16_bf16(fr[4 * (d & 1) + kk], pb[kk], oacc[d], 0, 0, 0);
                __builtin_amdgcn_sched_barrier(0);
                if (d < 2) {
#pragma unroll
                    for (int kk = 0; kk < 4; ++kk) fr[4 * d + kk] = *(const LAS bf16x8*)(va + (d + 2) * 32 * VT_PITCH + kk * 32); }
                __builtin_amdgcn_sched_barrier(0);
            }
        }
        if (more && VAR != 2 && VAR != 3) MK_ATT_WRITE((t + 1) & 1);
        half_barrier(hcnt, gen, lane);
    }
#undef MK_ATT_LOAD
#undef MK_KT
#undef MK_ATT_WRITE
    const float lt = pair_sum(l_run), inv = 1.0f / lt;
    bf16_t* op = H.o + (size_t)qm * A.ostride + 8 * h;
#pragma unroll
    for (int d = 0; d < 4; ++d)
#pragma unroll
        for (int rq = 0; rq < 4; rq += 2) {
            const unsigned a0 = pk2(oacc[d][4 * rq] * inv, oacc[d][4 * rq + 1] * inv), a1 = pk2(oacc[d][4 * rq + 2] * inv, oacc[d][4 * rq + 3] * inv);
            const unsigned b0 = pk2(oacc[d][4 * rq + 4] * inv, oacc[d][4 * rq + 5] * inv), b1 = pk2(oacc[d][4 * rq + 6] * inv, oacc[d][4 * rq + 7] * inv);
            auto r0 = __builtin_amdgcn_permlane32_swap(a0, b0, false, false); auto r1 = __builtin_amdgcn_permlane32_swap(a1, b1, false, false);
            u32x4 w = {r0[0], r1[0], r0[1], r1[1]};
            *(u32x4*)(op + 32 * d + 8 * rq) = w;
        }
    if (MODE == 0 && h == 0) H.lse[(size_t)qm * A.lstride] = (m_run + log2f(lt)) * LN2;
}

__device__ __forceinline__ void dil_attn_phase(const Ctx& c, const bf16_t* QKV, bf16_t* OG, float* LSE) {
    const int hf = c.wave >> 2; int gen = 0;
    if (c.tid < 32) ((LAS unsigned*)(c.lds + ATT_CNT_OFF))[c.tid] = 0u;
    __syncthreads();
    if (hf) { __builtin_amdgcn_s_sleep(24); }
#pragma unroll 1
    for (int it = c.bid; it < NBATCH * 3 * 8 * 16; it += c.G) {
        const int rq = (it + (it >> 8)) & 15, hp = (it >> 4) & 7, rest = it >> 7, g = rest % 3, b = rest / 3;
        const int dil = (g == 0) ? 1 : (g == 1 ? 4 : 16), ntile = 16 / dil, r = rq / ntile, qt = rq - r * ntile;
        const int head = 2 * hp + hf;
        const size_t row0 = (size_t)b * SEQ + r;
        AttnHalf H; AttnTile A;
        const bf16_t* base = QKV + row0 * A_COLS + g * 6144 + head * 128;
        H.q = base; H.k = base + 2048; H.v = base + 4096;
        H.o = OG + ((size_t)g * T + row0) * 2048 + head * 128;
        H.lse = LSE + ((size_t)g * T + row0) * 16 + head;
        H.c2 = nullptr; H.c2n = nullptr;
        H.sd2 = exp2f(-0.5f * (float)(head + 1)) * (float)dil * LOG2E;
        A.rstride = (size_t)dil * A_COLS; A.ostride = (size_t)dil * 2048; A.lstride = (size_t)dil * 16;
        A.q0 = 128 * qt; A.kt_lo = qt ? (2 * qt - 2) : 0; A.kt_hi = 2 * qt + 2; A.Wn = 128u; A.desc = 0;
        attn_tile<0>(c, H, A, gen);
    }
    __syncthreads();
}
template <int VAR = 0>
__device__ __forceinline__ void fox_attn_phase(const Ctx& c, const bf16_t* QKV, const float* C2, const float* C2N, bf16_t* O, bool xmode, int xx, int xr) {
    const int hf = c.wave >> 2; int gen = 0;
    if (c.tid < 32) ((LAS unsigned*)(c.lds + ATT_CNT_OFF))[c.tid] = 0u;
    __syncthreads();
    if (hf) { __builtin_amdgcn_s_sleep(24); }
#pragma unroll 1
    for (int n = 0;; ++n) {
        const int i = n >> 1; int it;
        if (xmode) { if (i >= 4) break; it = ((xx * 4 + (xr >> 3)) + 32 * i) * 8 + (xr & 7); }
        else { it = c.bid + i * c.G; if (it >= NBATCH * 16 * 8) break; }
        const int x0 = it & 7, hp = (it >> 3) & 15, b = it >> 7;
        const int x = (n & 1) ? 15 - x0 : x0;
        const int head = 2 * hp + hf;
        const size_t row0 = (size_t)b * SEQ;
        AttnHalf H; AttnTile A;
        const bf16_t* base = QKV + row0 * FOXW + head * 128;
        H.q = base; H.k = base + 4096; H.v = base + 8192;
        H.o = O + row0 * 4096 + head * 128; H.lse = nullptr; H.c2 = C2 + ((size_t)b * 32 + head) * SEQ; H.c2n = C2N + ((size_t)b * 32 + head) * SEQ; H.sd2 = 0.f;
        A.rstride = FOXW; A.ostride = 4096; A.lstride = 0; A.Wn = 0x7fffffffu; A.kt_lo = 0;
        A.q0 = 128 * x; A.kt_hi = 2 * x + 2; A.desc = (n & 1);
        attn_tile<1, VAR>(c, H, A, gen);
    }
    __syncthreads();
}

template <bool F32BASE>
struct EpiRes {
    static constexpr bool PERM = true, AFTER_DRAIN = false;
    const void* base; bf16_t* C; int ldc; float alpha;
    __device__ __forceinline__ void operator()(const f32x4 (&acc)[2][2][4][2], const pg8::Unit& u, int wr, int wc, int fr, int fq) const {
        const int row0 = u.pm * 256 + wr * 64 + fr, col0 = u.pn * 256 + wc * 32 + 8 * fq;
#pragma unroll
        for (int ai = 0; ai < 2; ++ai)
#pragma unroll
            for (int m = 0; m < 4; ++m) { const size_t off = (size_t)(row0 + ai * 128 + m * 16) * ldc + col0;
#pragma unroll
                for (int bj = 0; bj < 2; ++bj) { f32x4 b0, b1;
                    if (F32BASE) { b0 = *(const f32x4*)((const float*)base + off + bj * 128); b1 = *(const f32x4*)((const float*)base + off + bj * 128 + 4); }
                    else { const u32x4 w = *(const u32x4*)((const bf16_t*)base + off + bj * 128); b0 = (f32x4){bf_lo(w[0]), bf_hi(w[0]), bf_lo(w[1]), bf_hi(w[1])}; b1 = (f32x4){bf_lo(w[2]), bf_hi(w[2]), bf_lo(w[3]), bf_hi(w[3])}; }
                    const f32x4 o0 = b0 * alpha + acc[ai][bj][m][0], o1 = b1 * alpha + acc[ai][bj][m][1];
                    u32x4 w = {pk2(o0[0], o0[1]), pk2(o0[2], o0[3]), pk2(o1[0], o1[1]), pk2(o1[2], o1[3])};
                    *(u32x4*)(C + off + bj * 128) = w; } }
    }
};
struct EpiFox {
    static constexpr bool PERM = true, AFTER_DRAIN = false;
    bf16_t* O; float* FG;
    __device__ __forceinline__ void operator()(const f32x4 (&acc)[2][2][4][2], const pg8::Unit& u, int wr, int wc, int fr, int fq) const {
        const int row0 = u.pm * 256 + wr * 64 + fr;
        if (u.pn < 48) {
            const int col0 = u.pn * 256 + wc * 32 + 8 * fq;
#pragma unroll
            for (int ai = 0; ai < 2; ++ai)
#pragma unroll
                for (int m = 0; m < 4; ++m) { bf16_t* rowp = O + (size_t)(row0 + ai * 128 + m * 16) * FOXW + col0;
#pragma unroll
                    for (int bj = 0; bj < 2; ++bj) { const f32x4 v0 = acc[ai][bj][m][0], v1 = acc[ai][bj][m][1];
                        u32x4 w = {pk2(v0[0], v0[1]), pk2(v0[2], v0[3]), pk2(v1[0], v1[1]), pk2(v1[2], v1[3])};
                        *(u32x4*)(rowp + bj * 128) = w; } }
        } else if (wc == 0) {
#pragma unroll
            for (int ai = 0; ai < 2; ++ai)
#pragma unroll
                for (int m = 0; m < 4; ++m) { float* rowp = FG + (size_t)(row0 + ai * 128 + m * 16) * 32 + 8 * fq;
                    *(f32x4*)(rowp) = acc[ai][0][m][0]; *(f32x4*)(rowp + 4) = acc[ai][0][m][1]; }
        }
    }
};

constexpr int SK_PITCH = 272, SK_BYTES = 2 * 128 * SK_PITCH;
constexpr int SEL_IDX_OFF = SK_BYTES, SEL_GATE_OFF = SEL_IDX_OFF + 32 * 128 * 4, WBUF_OFF = SEL_GATE_OFF + 32 * 128 * 4, PEER_LDS_END = WBUF_OFF + 8 * 128 * 4;
static_assert(PEER_LDS_END <= LDS_BARW, "peer LDS");
struct CandTab { int i[50], j[50]; };
__host__ __device__ constexpr CandTab make_cand() { CandTab t{}; int s = 0; for (int i = 0; i < 16; ++i) for (int j = 0; j < 16; ++j) if ((i + 1) * (j + 1) <= 16) { t.i[s] = i; t.j[s] = j; ++s; } return t; }
__device__ __forceinline__ int f2ord(float f) { const int b = __float_as_int(f); return b ^ ((b >> 31) & 0x7fffffff); }
__device__ __forceinline__ float ord2f(int o) { return __int_as_float(o ^ ((o >> 31) & 0x7fffffff)); }
__device__ __forceinline__ float gelu_exact(float v) { return 0.5f * v * (1.0f + erff(v * 0.70710678118654752f)); }

#define MK_CE(a, b) do { const int hi_ = (a) > (b) ? (a) : (b), lo_ = (a) > (b) ? (b) : (a); (a) = hi_; (b) = lo_; } while (0)
template <int BASE> __device__ __forceinline__ void sort16_desc(int (&v)[64]) {
#pragma unroll
    for (int k = 2; k <= 16; k <<= 1)
#pragma unroll
        for (int j = k >> 1; j > 0; j >>= 1)
#pragma unroll
            for (int i = 0; i < 16; ++i) { const int l = i ^ j; if (l > i) { if ((i & k) == 0) MK_CE(v[BASE + i], v[BASE + l]); else MK_CE(v[BASE + l], v[BASE + i]); } }
}
template <int A, int B> __device__ __forceinline__ void merge_top16(int (&v)[64]) {
#pragma unroll
    for (int i = 0; i < 16; ++i) v[A + i] = v[A + i] > v[B + 15 - i] ? v[A + i] : v[B + 15 - i];
#pragma unroll
    for (int j = 8; j > 0; j >>= 1)
#pragma unroll
        for (int i = 0; i < 16; ++i) { const int l = i ^ j; if (l > i) MK_CE(v[A + i], v[A + l]); }
}
__device__ __forceinline__ void top16_of_64(int (&v)[64]) {
    sort16_desc<0>(v); sort16_desc<16>(v); sort16_desc<32>(v); sort16_desc<48>(v);
    merge_top16<0, 16>(v); merge_top16<32, 48>(v); merge_top16<0, 32>(v);
}
constexpr int LTAB_OFF = WBUF_OFF + 8 * 128 * 4, PEER_LDS_END2 = LTAB_OFF + 8 * 32 * 32;
static_assert(PEER_LDS_END2 <= LDS_BARW, "peer LDS 2");

__device__ __forceinline__ void peer_select(const Ctx& c, const bf16_t* __restrict__ QP, int tok0, unsigned short* __restrict__ IDXg, float* __restrict__ GATEg) {
    int lane = c.lane; asm volatile("" : "+v"(lane));
    const int h = lane >> 5, cc = lane & 31, head = c.wave;
    const bf16_t* qrow = QP + (size_t)(tok0 + cc) * 2048 + head * 256 + 8 * h;
    int L[2][16];
#pragma unroll
    for (int p = 0; p < 2; ++p) {
        bf16x8 qf[8];
#pragma unroll
        for (int ks = 0; ks < 8; ++ks) qf[ks] = *(const bf16x8*)(qrow + p * 128 + 16 * ks);
        f32x16 acc[4];
#pragma unroll
        for (int kb = 0; kb < 4; ++kb)
#pragma unroll
            for (int r = 0; r < 16; ++r) acc[kb][r] = 0.f;
        const LAS unsigned char* ska = c.lds + p * (128 * SK_PITCH) + cc * SK_PITCH + 16 * h;
#pragma unroll
        for (int kb = 0; kb < 4; ++kb)
#pragma unroll
            for (int ks = 0; ks < 8; ++ks) { const bf16x8 a = *(const LAS bf16x8*)(ska + kb * 32 * SK_PITCH + 32 * ks); acc[kb] = __builtin_amdgcn_mfma_f32_32x32x16_bf16(a, qf[ks], acc[kb], 0, 0, 0); }
        int pk[64];
#pragma unroll
        for (int kb = 0; kb < 4; ++kb)
#pragma unroll
            for (int r = 0; r < 16; ++r) { const int n = 32 * kb + (r & 3) + 8 * (r >> 2); pk[16 * kb + r] = (f2ord(acc[kb][r]) & ~127) | (127 - n - 4 * h); }
        top16_of_64(pk);
        int lo16[16], up16[16];
#pragma unroll
        for (int i = 0; i < 16; ++i) { auto t = __builtin_amdgcn_permlane32_swap((unsigned)pk[i], (unsigned)pk[i], false, false); lo16[i] = (int)t[0]; up16[i] = (int)t[1]; }
#pragma unroll
        for (int i = 0; i < 16; ++i) L[p][i] = lo16[i] > up16[15 - i] ? lo16[i] : up16[15 - i];
#pragma unroll
        for (int j = 8; j > 0; j >>= 1)
#pragma unroll
            for (int i = 0; i < 16; ++i) { const int l = i ^ j; if (l > i) MK_CE(L[p][i], L[p][l]); }
    }
    LAS unsigned char* tab = c.lds + LTAB_OFF + (c.wave * 32 + cc) * 32;
    if (h == 0) {
        u32x4 w0, w1;
#pragma unroll
        for (int q4 = 0; q4 < 4; ++q4) {
            w0[q4] = (unsigned)(127 - (L[0][4 * q4] & 127)) | ((unsigned)(127 - (L[0][4 * q4 + 1] & 127)) << 8) | ((unsigned)(127 - (L[0][4 * q4 + 2] & 127)) << 16) | ((unsigned)(127 - (L[0][4 * q4 + 3] & 127)) << 24);
            w1[q4] = (unsigned)(127 - (L[1][4 * q4] & 127)) | ((unsigned)(127 - (L[1][4 * q4 + 1] & 127)) << 8) | ((unsigned)(127 - (L[1][4 * q4 + 2] & 127)) << 16) | ((unsigned)(127 - (L[1][4 * q4 + 3] & 127)) << 24); }
        *(LAS u32x4*)(tab) = w0; *(LAS u32x4*)(tab + 16) = w1;
    }
    constexpr CandTab CT = make_cand();
    int pk2v[64];
#pragma unroll
    for (int s = 0; s < 64; ++s) {
        if (s < 50) { const int i = CT.i[s], j = CT.j[s];
            const float sum = ord2f(L[0][i] & ~127) + ord2f(L[1][j] & ~127);
            pk2v[s] = (f2ord(sum) & ~255) | (255 - (16 * i + j)); }
        else pk2v[s] = (int)0x80000000;
    }
    top16_of_64(pk2v);
    MK_LDS_WAIT();
    float tops[16]; int eidx[16];
#pragma unroll
    for (int it = 0; it < 16; ++it) { const int code = 255 - (pk2v[it] & 255); tops[it] = ord2f(pk2v[it] & ~255);
        eidx[it] = (int)tab[code >> 4] * 128 + (int)tab[16 + (code & 15)]; }
    { const float t0 = tops[0]; float den = 0.f;
#pragma unroll
      for (int it = 0; it < 16; ++it) { tops[it] = __expf(tops[it] - t0); den += tops[it]; }
      const float rden = 1.0f / den;
#pragma unroll
      for (int it = 0; it < 16; ++it) tops[it] *= rden; }
    unsigned short* si = IDXg + (size_t)(tok0 + cc) * 128 + head * 16;
    float* sg = GATEg + (size_t)(tok0 + cc) * 128 + head * 16;
    if (h == 0) {
        u32x4 w0, w1;
#pragma unroll
        for (int q4 = 0; q4 < 4; ++q4) { w0[q4] = (unsigned)eidx[2 * q4] | ((unsigned)eidx[2 * q4 + 1] << 16); w1[q4] = (unsigned)eidx[8 + 2 * q4] | ((unsigned)eidx[8 + 2 * q4 + 1] << 16); }
        *(u32x4*)(si) = w0; *(u32x4*)(si + 8) = w1;
    } else {
#pragma unroll
        for (int q4 = 0; q4 < 4; ++q4) { f32x4 w = {tops[4 * q4], tops[4 * q4 + 1], tops[4 * q4 + 2], tops[4 * q4 + 3]}; *(f32x4*)(sg + 4 * q4) = w; }
    }
}

typedef float f32x2 __attribute__((ext_vector_type(2)));
constexpr int NSLICE = 32, TOKBLK = 512;
#define MK_P_LOAD_ROWS(R, tl, Tb) do { const u32x4 j0_ = *(const LAS u32x4*)(ilds + (tl) * 256), j1_ = *(const LAS u32x4*)(ilds + (tl) * 256 + 16); \
        _Pragma("unroll") for (int w_ = 0; w_ < 4; ++w_) { R[2 * w_] = *(const u32x4*)((Tb) + (size_t)(j0_[w_] & 0xffffu) * 128); R[2 * w_ + 1] = *(const u32x4*)((Tb) + (size_t)(j0_[w_] >> 16) * 128); \
                                                           R[8 + 2 * w_] = *(const u32x4*)((Tb) + (size_t)(j1_[w_] & 0xffffu) * 128); R[8 + 2 * w_ + 1] = *(const u32x4*)((Tb) + (size_t)(j1_[w_] >> 16) * 128); } } while (0)
#define MK_P_FILL_IDX() do { const u32x4* src_ = (const u32x4*)(IDX + (size_t)tok0 * 128) + lane; LAS u32x4* dl_ = (LAS u32x4*)(c.lds + c.wave * 16384) + lane; \
        u32x4 tmp_[16]; _Pragma("unroll") for (int i_ = 0; i_ < 16; ++i_) tmp_[i_] = src_[64 * i_]; \
        _Pragma("unroll") for (int i_ = 0; i_ < 16; ++i_) dl_[64 * i_] = tmp_[i_]; MK_LDS_WAIT(); } while (0)

__device__ __forceinline__ void peer_pass1_unit(const Ctx& c, int slice, int tok0, const unsigned char* __restrict__ Us, const unsigned short* __restrict__ IDX, const unsigned char* __restrict__ X8, unsigned* __restrict__ PART, bool fill) {
    int lane = c.lane; asm volatile("" : "+v"(lane));
    const int p = lane >> 3, q = lane & 7;
    const unsigned char* Tb = Us + (size_t)slice * 16384 * 128 + q * 16;
    const LAS unsigned char* ilds = c.lds + c.wave * 16384 + p * 32;
    const unsigned char* xp = X8 + (size_t)tok0 * DM + slice * 128 + 16 * q;
    unsigned* pp = PART + ((size_t)slice * T + tok0) * 64 + 8 * p + q;
    if (fill) MK_P_FILL_IDX();
    u32x4 XA[2], XB[2], RA[16], RB[16];
#define MK_P1_LOAD_X(X, t) do { X[0] = *(const u32x4*)(xp + (size_t)(t) * DM); X[1] = *(const u32x4*)(xp + (size_t)((t) + 1) * DM); } while (0)
#define MK_P1_COMPUTE(R, Xv, t) do { int r_[16]; \
        _Pragma("unroll") for (int i_ = 0; i_ < 16; ++i_) { int a_ = 0; \
            _Pragma("unroll") for (int w_ = 0; w_ < 4; ++w_) a_ = __builtin_amdgcn_sdot4((int)R[i_][w_], (int)Xv[w_], a_, false); \
            a_ += __builtin_amdgcn_mov_dpp(a_, 0xB1, 0xf, 0xf, true); a_ += __builtin_amdgcn_mov_dpp(a_, 0x4E, 0xf, 0xf, true); a_ += __builtin_amdgcn_mov_dpp(a_, 0x141, 0xf, 0xf, true); r_[i_] = a_; } \
        int v0_ = r_[0], v1_ = r_[1]; \
        _Pragma("unroll") for (int i_ = 1; i_ < 8; ++i_) { v0_ = (q == i_) ? r_[2 * i_] : v0_; v1_ = (q == i_) ? r_[2 * i_ + 1] : v1_; } \
        pp[(size_t)(t) * 64] = pk2((float)v0_, (float)v1_); } while (0)
    constexpr int NT = TOKBLK / 8;
    MK_P1_LOAD_X(XA, 0);
    MK_P_LOAD_ROWS(RA, 0, Tb);
#pragma unroll 1
    for (int t = 0; t < NT; t += 4) {
        MK_P1_LOAD_X(XB, t + 2);
        MK_P_LOAD_ROWS(RB, t + 1, Tb); MK_P1_COMPUTE(RA, XA[0], t);
        MK_P_LOAD_ROWS(RA, t + 2, Tb); MK_P1_COMPUTE(RB, XA[1], t + 1);
        if (t + 4 < NT) MK_P1_LOAD_X(XA, t + 4);
        MK_P_LOAD_ROWS(RB, t + 3, Tb); MK_P1_COMPUTE(RA, XB[0], t + 2);
        if (t + 4 < NT) MK_P_LOAD_ROWS(RA, t + 4, Tb);
        MK_P1_COMPUTE(RB, XB[1], t + 3);
    }
#undef MK_P1_LOAD_X
#undef MK_P1_COMPUTE
}
__device__ __forceinline__ void peer_pass2_unit(const Ctx& c, int slice, int tok0, const unsigned char* __restrict__ Vs, const unsigned short* __restrict__ IDX, const unsigned char* __restrict__ W8, const float* __restrict__ WS, unsigned* __restrict__ OUT, bool fill) {
    int lane = c.lane; asm volatile("" : "+v"(lane));
    const int p = lane >> 3, q = lane & 7;
    const unsigned char* Tb = Vs + (size_t)slice * 16384 * 128 + q * 16;
    const LAS unsigned char* ilds = c.lds + c.wave * 16384 + p * 32;
    const unsigned char* wp = W8 + (size_t)tok0 * 128 + 16 * p;
    const float* wsp = WS + tok0;
    unsigned* op = OUT + (size_t)tok0 * (DM / 2) + slice * 64 + 8 * q + p;
    const bool b3 = (lane & 8) != 0;
    if (fill) MK_P_FILL_IDX();
    u32x4 WA[2], WB[2], RA[16], RB[16]; float SA[2], SB[2];
#define MK_P2_LOAD_W(Wt, St, t) do { Wt[0] = *(const u32x4*)(wp + (size_t)(t) * 128); Wt[1] = *(const u32x4*)(wp + (size_t)((t) + 1) * 128); St[0] = wsp[(t)]; St[1] = wsp[(t) + 1]; } while (0)
#define MK_P2_COMPUTE(R, Wv, sc, t) do { int acc_[16]; \
        _Pragma("unroll") for (int m_ = 0; m_ < 16; ++m_) acc_[m_] = 0; \
        _Pragma("unroll") for (int g_ = 0; g_ < 4; ++g_) { const int wq_ = (int)Wv[g_];     \
            _Pragma("unroll") for (int w_ = 0; w_ < 4; ++w_) { const unsigned a_ = R[4 * g_][w_], b_ = R[4 * g_ + 1][w_], c_ = R[4 * g_ + 2][w_], d_ = R[4 * g_ + 3][w_]; \
                const unsigned p0_ = __builtin_amdgcn_perm(b_, a_, 0x05010400u), p1_ = __builtin_amdgcn_perm(b_, a_, 0x07030602u), p2_ = __builtin_amdgcn_perm(d_, c_, 0x05010400u), p3_ = __builtin_amdgcn_perm(d_, c_, 0x07030602u); \
                acc_[4 * w_ + 0] = __builtin_amdgcn_sdot4((int)__builtin_amdgcn_perm(p2_, p0_, 0x05040100u), wq_, acc_[4 * w_ + 0], false); \
                acc_[4 * w_ + 1] = __builtin_amdgcn_sdot4((int)__builtin_amdgcn_perm(p2_, p0_, 0x07060302u), wq_, acc_[4 * w_ + 1], false); \
                acc_[4 * w_ + 2] = __builtin_amdgcn_sdot4((int)__builtin_amdgcn_perm(p3_, p1_, 0x05040100u), wq_, acc_[4 * w_ + 2], false); \
                acc_[4 * w_ + 3] = __builtin_amdgcn_sdot4((int)__builtin_amdgcn_perm(p3_, p1_, 0x07060302u), wq_, acc_[4 * w_ + 3], false); } } \
          \
        int u_[8]; _Pragma("unroll") for (int i_ = 0; i_ < 8; ++i_) { auto s_ = __builtin_amdgcn_permlane32_swap((unsigned)acc_[i_], (unsigned)acc_[i_ + 8], false, false); u_[i_] = (int)s_[0] + (int)s_[1]; } \
        int t_[4]; _Pragma("unroll") for (int i_ = 0; i_ < 4; ++i_) { auto s_ = __builtin_amdgcn_permlane16_swap((unsigned)u_[i_], (unsigned)u_[i_ + 4], false, false); t_[i_] = (int)s_[0] + (int)s_[1]; } \
        const int k0_ = b3 ? t_[2] : t_[0], s0_ = b3 ? t_[0] : t_[2], k1_ = b3 ? t_[3] : t_[1], s1_ = b3 ? t_[1] : t_[3]; \
        const int rx_ = k0_ + __builtin_amdgcn_mov_dpp(s0_, 0x128, 0xf, 0xf, true), ry_ = k1_ + __builtin_amdgcn_mov_dpp(s1_, 0x128, 0xf, 0xf, true); \
        op[(size_t)(t) * (DM / 2)] = pk2((float)rx_ * (sc), (float)ry_ * (sc)); } while (0)
    constexpr int NT = TOKBLK / 8;
    MK_P2_LOAD_W(WA, SA, 0);
    MK_P_LOAD_ROWS(RA, 0, Tb);
#pragma unroll 1
    for (int t = 0; t < NT; t += 4) {
        MK_P2_LOAD_W(WB, SB, t + 2);
        MK_P_LOAD_ROWS(RB, t + 1, Tb); MK_P2_COMPUTE(RA, WA[0], SA[0], t);
        MK_P_LOAD_ROWS(RA, t + 2, Tb); MK_P2_COMPUTE(RB, WA[1], SA[1], t + 1);
        if (t + 4 < NT) MK_P2_LOAD_W(WA, SA, t + 4);
        MK_P_LOAD_ROWS(RB, t + 3, Tb); MK_P2_COMPUTE(RA, WB[0], SB[0], t + 2);
        if (t + 4 < NT) MK_P_LOAD_ROWS(RA, t + 4, Tb);
        MK_P2_COMPUTE(RB, WB[1], SB[1], t + 3);
    }
#undef MK_P2_LOAD_W
#undef MK_P2_COMPUTE
}
#undef MK_P_LOAD_ROWS
#undef MK_P_FILL_IDX

struct PeerDeal { bool xcd_mode; int x, r; };
__device__ __forceinline__ int deal_xcd(const PeerDeal& d) { return d.x; }
__device__ __forceinline__ int deal_rank(const PeerDeal& d) { return d.r; }
__device__ __forceinline__ PeerDeal peer_deal(const Ctx& c, unsigned* xc, unsigned myx, unsigned myrank, bool census_done) {
    bool ok = census_done && (c.G == 256);
#pragma unroll
    for (int j = 0; j < 16; ++j) { const unsigned n = __hip_atomic_load(xc + j, __ATOMIC_RELAXED, __HIP_MEMORY_SCOPE_AGENT); ok = ok && (n == ((j < 8) ? 32u : 0u)); }
    PeerDeal d; d.xcd_mode = ok && myx < 8u && myrank < 32u; d.x = (int)myx; d.r = (int)myrank; return d;
}
template <int PASS>
__device__ __forceinline__ void peer_pass_phase(const Ctx& c, const PeerDeal& d, const unsigned char* Ts, const unsigned short* IDX, const unsigned char* X8, const unsigned char* W8, const float* WS, void* DST) {
#pragma unroll 1
    for (int i = 0;; ++i) {
        int slice, blk;
        if (d.xcd_mode) { if (i >= 4) break; slice = d.x + 8 * i; blk = d.r; }
        else { const int u = c.bid + i * c.G; if (u >= NSLICE * (T / TOKBLK)) break; slice = u / (T / TOKBLK); blk = u % (T / TOKBLK); }
        const int tok0 = blk * TOKBLK + c.wave * (TOKBLK / 8);
        const bool fill = !(d.xcd_mode && i > 0);
        if (PASS == 1) peer_pass1_unit(c, slice, tok0, Ts, IDX, X8, (unsigned*)DST, fill); else peer_pass2_unit(c, slice, tok0, Ts, IDX, W8, WS, (unsigned*)DST, fill);
    }
}
__device__ __forceinline__ void peer_act_phase(const Ctx& c, const unsigned* __restrict__ PART, const unsigned short* __restrict__ IDX, const float* __restrict__ GATE, const float* __restrict__ SU, const float* __restrict__ SV, const float* __restrict__ XS, unsigned short* __restrict__ W8, float* __restrict__ WS) {
    const size_t n2 = (size_t)T * 64, stride = (size_t)c.G * NTHREADS;
    for (size_t id = (size_t)c.bid * NTHREADS + c.tid; id < n2; id += stride) {
        float s0 = 0.f, s1 = 0.f;
#pragma unroll 8
        for (int j = 0; j < NSLICE; ++j) { const unsigned w = PART[(size_t)j * n2 + id]; s0 += bf_lo(w); s1 += bf_hi(w); }
        const unsigned ee = *(const unsigned*)(IDX + 2 * id); const unsigned e0 = ee & 0xffffu, e1 = ee >> 16;
        const float g0 = GATE[2 * id], g1 = GATE[2 * id + 1];
        const size_t tok = id >> 6; const float xs = XS[tok];
        const float w0 = g0 * gelu_exact(s0 * SU[e0] * xs) * SV[e0], w1 = g1 * gelu_exact(s1 * SU[e1] * xs) * SV[e1];
        const float mx = wave_max(fmaxf(fabsf(w0), fabsf(w1)));
        const bool ok = (mx > 1e-30f) && (mx < 1e30f);
        const float scale = ok ? 127.0f / mx : 0.f;
        if (c.lane == 0) WS[tok] = ok ? mx * (1.0f / 127.0f) : 0.f;
        const int q0 = (int)__builtin_rintf(w0 * scale), q1 = (int)__builtin_rintf(w1 * scale);
        W8[id] = (unsigned short)(((unsigned)q0 & 0xffu) | (((unsigned)q1 & 0xffu) << 8));
    }
}
typedef int mk_i32x4 __attribute__((ext_vector_type(4)));
__device__ __forceinline__ void fox_gate_job(const Ctx& c, const unsigned char* __restrict__ X8, const float* __restrict__ XS, const unsigned char* __restrict__ WG8, const float* __restrict__ SBG, float* __restrict__ FG) {
    const int mt = c.wave & 3, nt = c.wave >> 2;
    for (int blk = c.bid; blk < T / 64; blk += c.G) {
        int lane = c.lane; asm volatile("" : "+v"(lane));
        const int tok0 = blk * 64 + mt * 16;
        const unsigned char* ap = X8 + (size_t)(tok0 + (lane & 15)) * DM + 16 * (lane >> 4);
        const unsigned char* bp = WG8 + (size_t)(nt * 16 + (lane & 15)) * DM + 16 * (lane >> 4);
        mk_i32x4 acc = {0, 0, 0, 0};
#pragma unroll 8
        for (int ks = 0; ks < DM / 64; ++ks) {
            const mk_i32x4 a = *(const mk_i32x4*)(ap + 64 * ks), b = *(const mk_i32x4*)(bp + 64 * ks);
            acc = __builtin_amdgcn_mfma_i32_16x16x64_i8(a, b, acc, 0, 0, 0);
        }
        const float sb = SBG[nt * 16 + (lane & 15)];
#pragma unroll
        for (int r = 0; r < 4; ++r) { const int tok = tok0 + 4 * (lane >> 4) + r; FG[(size_t)tok * 32 + nt * 16 + (lane & 15)] = (float)acc[r] * XS[tok] * sb; }
    }
}
__device__ __forceinline__ void ln_add_phase(const Ctx& c, const bf16_t* Y, const float* __restrict__ g1, const float* __restrict__ b1, const bf16_t* __restrict__ ADD, float* dst, bf16_t* Hb, const float* __restrict__ g, const float* __restrict__ b, unsigned char* X8 = nullptr, float* XS = nullptr) {
    for (int row = c.bid * 8 + c.wave; row < T; row += c.G * 8) {
        int ln = c.lane; asm volatile("" : "+v"(ln));
        const size_t off = (size_t)row * DM + 4 * ln;
        f32x4 v[16]; float s = 0.f;
#pragma unroll
        for (int j = 0; j < 16; ++j) { const u32x2 hw = *(const u32x2*)(Y + off + 256 * j); v[j] = (f32x4){bf_lo(hw[0]), bf_hi(hw[0]), bf_lo(hw[1]), bf_hi(hw[1])}; s += (v[j][0] + v[j][1]) + (v[j][2] + v[j][3]); }
        float mean = wave_sum(s) * (1.f / DM), qq = 0.f;
#pragma unroll
        for (int j = 0; j < 16; ++j) { v[j] = v[j] - mean; qq += (v[j][0] * v[j][0] + v[j][1] * v[j][1]) + (v[j][2] * v[j][2] + v[j][3] * v[j][3]); }
        float rstd = 1.0f / sqrtf(wave_sum(qq) * (1.f / DM) + LN_EPS);
        s = 0.f;
#pragma unroll
        for (int j = 0; j < 16; ++j) { if ((j & 1) == 0) asm volatile("" ::: "memory");
            const f32x4 gg = *(const f32x4*)(g1 + 4 * ln + 256 * j), bb = *(const f32x4*)(b1 + 4 * ln + 256 * j);
            const u32x2 aw = *(const u32x2*)(ADD + off + 256 * j); const f32x4 av = {bf_lo(aw[0]), bf_hi(aw[0]), bf_lo(aw[1]), bf_hi(aw[1])};
            v[j] = (v[j] * rstd * gg + bb) * DN_ALPHA + av; s += (v[j][0] + v[j][1]) + (v[j][2] + v[j][3]); }
        mean = wave_sum(s) * (1.f / DM); qq = 0.f;
#pragma unroll
        for (int j = 0; j < 16; ++j) { v[j] = v[j] - mean; qq += (v[j][0] * v[j][0] + v[j][1] * v[j][1]) + (v[j][2] * v[j][2] + v[j][3] * v[j][3]); }
        rstd = 1.0f / sqrtf(wave_sum(qq) * (1.f / DM) + LN_EPS);
#pragma unroll
        for (int j = 0; j < 16; ++j) { if ((j & 1) == 0) asm volatile("" ::: "memory");
            const f32x4 gg = *(const f32x4*)(g + 4 * ln + 256 * j), bb = *(const f32x4*)(b + 4 * ln + 256 * j);
            const f32x4 o = v[j] * rstd * gg + bb; if (dst) *(f32x4*)(dst + off + 256 * j) = o; v[j] = o;
            if (Hb) { u32x2 w = {pk2(o[0], o[1]), pk2(o[2], o[3])}; *(u32x2*)(Hb + off + 256 * j) = w; } }
        if (X8) {
            float mx = 0.f;
#pragma unroll
            for (int j = 0; j < 16; ++j) mx = fmaxf(mx, fmaxf(fmaxf(fabsf(v[j][0]), fabsf(v[j][1])), fmaxf(fabsf(v[j][2]), fabsf(v[j][3]))));
            mx = wave_max(mx);
            const bool ok = (mx > 1e-30f) && (mx < 1e30f);
            const float scale = ok ? 127.0f / mx : 0.f;
            if (ln == 0) XS[row] = ok ? mx * (1.0f / 127.0f) : 0.f;
#pragma unroll
            for (int j = 0; j < 16; ++j) *(unsigned*)(X8 + off + 256 * j) = pack_i8x4(v[j] * scale);
        }
    }
}

__device__ __forceinline__ void peer_select_phase(const Ctx& c, const bf16_t* QP, const float* __restrict__ subk, unsigned short* IDXg, float* GATEg) {
    for (int i = c.tid; i < 2 * 128 * 16; i += NTHREADS) { const int row = i >> 4, ch = i & 15;
        const f32x4 a = *(const f32x4*)(subk + row * 128 + ch * 8), bq = *(const f32x4*)(subk + row * 128 + ch * 8 + 4);
        u32x4 w = {pk2(a[0], a[1]), pk2(a[2], a[3]), pk2(bq[0], bq[1]), pk2(bq[2], bq[3])};
        *(LAS u32x4*)(c.lds + row * SK_PITCH + ch * 16) = w; }
    __syncthreads();
#pragma unroll 1
    for (int unit = c.bid; unit < T / 32; unit += c.G) peer_select(c, QP, unit * 32, IDXg, GATEg);
    __syncthreads();
}

constexpr int NPHASES = 27;
struct Args { const float* in[14]; float* out; unsigned char* ws; int ph_lo, ph_hi, li, pad; };

__global__ void __launch_bounds__(NTHREADS, 2) mk_fwd(Args args) {
    extern __shared__ __attribute__((aligned(16))) unsigned char lds_raw[];
    Ctx c; c.lds = (LAS unsigned char*)lds_raw; c.wave = __builtin_amdgcn_readfirstlane((int)(threadIdx.x >> 6)); c.G = gridDim.x; c.bid = blockIdx.x; c.lane = mk_hw_lane(); c.tid = c.wave * 64 + c.lane;
#define RELANE() do { c.lane = mk_hw_lane(); c.tid = c.wave * 64 + c.lane; } while (0)
    if (c.tid < 4) ((LAS unsigned*)(c.lds + LDS_BARW))[c.tid] = 0u;
    __syncthreads();
    unsigned char* ws = args.ws;
    XcdBarrier bar = xcd_barrier_post((unsigned*)(ws + WS_CTL) + (size_t)args.li * BAR_REGION_WORDS, (volatile LAS unsigned*)(c.lds + LDS_BARW), c.wave);
    const int lo = args.ph_lo, hi = args.ph_hi; const int rep_ = 1; (void)rep_;
#ifndef MK_ONLY
#define MK_ONLY -1
#endif
#define IN(k) ((MK_ONLY < 0 || MK_ONLY == (k)) && lo <= (k) && (k) < hi)
#define SEAM(k) do { if (IN((k) + 1) && !((MK_DUP == (k) || MK_DUP2 == (k)) && rep_ == 0)) xcd_barrier(bar); } while (0)
#ifndef MK_DUP
#define MK_DUP -1
#endif
#ifndef MK_DUPS
#define MK_DUPS -1
#endif
#ifndef MK_FOXVAR
#define MK_FOXVAR 0
#endif
#ifndef MK_DUP2
#define MK_DUP2 -1
#endif
#define REP(k) for (int rep_ = 0; rep_ < ((MK_DUP == (k) || MK_DUP2 == (k)) ? 2 : 1); ++rep_)
#define INP(k) ([&]() { int k_ = (k); asm volatile("" : "+s"(k_)); return args.in[k_]; }())
#define x INP(0)
#define a_w_in INP(1)
#define a_w_out INP(2)
#define b_w_in INP(3)
#define b_f_bias INP(4)
#define b_w_out INP(5)
#define peer_w_q INP(6)
#define peer_sk INP(7)
#define peer_u INP(8)
#define peer_v INP(9)
#define ln_mix_g INP(10)
#define ln_mix_b INP(11)
#define ln_ffn_g INP(12)
#define ln_ffn_b INP(13)
    bf16_t* W_IN = (bf16_t*)(ws + WS_WIN); bf16_t* W_OUT = (bf16_t*)(ws + WS_WOUT); bf16_t* W_Q = (bf16_t*)(ws + WS_WQ); unsigned char* UB = ws + WS_U; unsigned char* VB = ws + WS_V; float* SU = (float*)(ws + WS_SC); float* SV = SU + 16384;
    bf16_t* HF = (bf16_t*)(ws + WS_HF);     bf16_t* HB = (bf16_t*)(ws + WS_HB); bf16_t* QKV = (bf16_t*)(ws + WS_QKV); bf16_t* OG = (bf16_t*)(ws + WS_OG);
    float* LSE = (float*)(ws + WS_LSE); float* FG = (float*)(ws + WS_FG); float* C2 = (float*)(ws + WS_C2); bf16_t* A2 = (bf16_t*)(ws + WS_A2); bf16_t* QP = (bf16_t*)(ws + WS_QP);
    const size_t EU = (size_t)16384 * DM;

    unsigned* XC = (unsigned*)(ws + WS_CTL) + (MAX_LAUNCHES * BAR_REGION_WORDS) + (size_t)args.li * 64;
    const unsigned myx = xb_xcc_id(); unsigned myrank = 0;
    { unsigned r0 = 0; if (c.tid == 0) r0 = __hip_atomic_fetch_add(XC + myx, 1u, __ATOMIC_RELAXED, __HIP_MEMORY_SCOPE_AGENT); myrank = (unsigned)__builtin_amdgcn_readfirstlane((int)r0); }
    if (c.tid == 0) ((LAS unsigned*)(c.lds + LDS_BARW))[2] = myrank;
    __syncthreads();
    myrank = (unsigned)__builtin_amdgcn_readfirstlane((int)((LAS unsigned*)(c.lds + LDS_BARW))[2]);
    unsigned short* PIDX = (unsigned short*)(ws + WS_PIDX); float* PGATE = (float*)(ws + WS_PGATE); unsigned short* PW = (unsigned short*)(ws + WS_PW); float* WSC = (float*)(ws + WS_WS); unsigned char* WQ8 = ws + WS_WQ8; unsigned* PART = (unsigned*)(ws + WS_PART); bf16_t* POUT = (bf16_t*)(ws + WS_POUT); unsigned char* X8 = ws + WS_X8; float* XS = (float*)(ws + WS_XS);

    unsigned char* WIN8 = ws + WS_WIN8; unsigned char* WOUT8 = ws + WS_WOUT8; unsigned char* X8A = ws + WS_X8A; unsigned char* X8B = ws + WS_X8B; unsigned char* A28 = ws + WS_A28; unsigned char* OG8 = ws + WS_OG8;
    float* SBIN = (float*)(ws + WS_SC2); float* SBOUT = SBIN + 32768; float* SBQ = SBOUT + 8192; float* XSA = SBQ + 8192; float* XSB = XSA + 16384; float* SA2 = XSB + 16384; float* SOG = SA2 + 16384;

    if (IN(0)) { RELANE();
        const int r1 = (A_COLS / 32) % c.G, r2 = (A_COLS / 32 + DM / 32) % c.G;
        transpose_quant<4096>(c, a_w_in, A_COLS, WIN8, SBIN, 0); transpose_quant<2048>(c, a_w_out, DM, WOUT8, SBOUT, r1); transpose_quant<4096>(c, peer_w_q, 2048, WQ8, SBQ, r2);
        RELANE();
        const ConvDeal cd = conv_deal(c.G, c.bid, A_COLS / 32, 32, DM / 32, r1, 16, 2048 / 32, r2, 32, 16384);
        convert_rows_i8(c, peer_u, UB, SU, cd.lo + c.wave, cd.hi, 8); convert_rows_i8(c, peer_u, UB, SU, cd.covered + c.bid * 8 + c.wave, 16384, c.G * 8);
        convert_rows_i8(c, peer_v, VB, SV, c.bid * 8 + c.wave, 16384, c.G * 8); quant_rows_f32_i8(c, x, X8A, XSA, T);
        SEAM(0);
    }
    if (IN(2)) { RELANE();
        pg8::Gemm g{(const bf16_t*)X8A, (const bf16_t*)WIN8, T, A_COLS, DM / 2, c.wave, XSA, SBIN}; pg8::StaticOrder S; S.init(T, A_COLS, c.G, c.bid);
        pg8::EpiBf16<0> E{QKV, A_COLS, nullptr, 0, 0};
        pg8::gemm_phase<pg8::EpiBf16<0>, pg8::StaticOrder, false, true>(c.lds, g, S, E, nullptr);
        SEAM(2);
    }
    if (IN(3)) { RELANE(); dil_attn_phase(c, QKV, OG, LSE); SEAM(3); }
    if (IN(4)) { RELANE(); merge_phase(c, OG, LSE, A28, SA2); SEAM(4); }
    if (IN(5)) { RELANE();
        pg8::Gemm g{(const bf16_t*)A28, (const bf16_t*)WOUT8, T, DM, 2048 / 2, c.wave, SA2, SBOUT}; pg8::StaticOrder S; S.init(T, DM, c.G, c.bid);
        EpiRes<true> E{x, HF, DM, DN_ALPHA};
        pg8::gemm_phase<EpiRes<true>, pg8::StaticOrder, false, true>(c.lds, g, S, E, nullptr);
        SEAM(5);
    }
    if (IN(6)) { RELANE(); ln_phase(c, HF, nullptr, nullptr, ln_mix_g, ln_mix_b, X8, XS); SEAM(6);     }
    if (IN(7)) { RELANE();
        pg8::Gemm g{(const bf16_t*)X8, (const bf16_t*)WQ8, T, 2048, DM / 2, c.wave, XS, SBQ}; pg8::StaticOrder S; S.init(T, 2048, c.G, c.bid);
        pg8::EpiBf16<0> E{QP, 2048, nullptr, 0, 0};
        pg8::gemm_phase<pg8::EpiBf16<0>, pg8::StaticOrder, false, true>(c.lds, g, S, E, nullptr);
        SEAM(7);
    }
    if (IN(8)) { RELANE(); peer_select_phase(c, QP, peer_sk, PIDX, PGATE); SEAM(8); }
    if (IN(9)) { RELANE(); const PeerDeal d = peer_deal(c, XC, myx, myrank, IN(8)); peer_pass_phase<1>(c, d, UB, PIDX, X8, nullptr, nullptr, PART);
#if MK_DUPS == 9
        peer_pass_phase<1>(c, d, UB, PIDX, X8, nullptr, nullptr, PART);
#endif
        SEAM(9); }
    if (IN(10)) { RELANE(); peer_act_phase(c, PART, PIDX, PGATE, SU, SV, XS, PW, WSC); SEAM(10); }
    if (IN(11)) { RELANE(); const PeerDeal d = peer_deal(c, XC, myx, myrank, IN(10)); peer_pass_phase<2>(c, d, VB, PIDX, nullptr, (const unsigned char*)PW, WSC, POUT);
#if MK_DUPS == 11
        peer_pass_phase<2>(c, d, VB, PIDX, nullptr, (const unsigned char*)PW, WSC, POUT);
#endif
        SEAM(11); }
    if (IN(12)) { RELANE(); ln_add_phase(c, HF, ln_mix_g, ln_mix_b, POUT, nullptr, HF, ln_ffn_g, ln_ffn_b, X8B, XSB);   }
    if (IN(13)) { RELANE();
        const int r1 = (B_COLS / 32) % c.G, r2 = (B_COLS / 32 + DM / 32) % c.G;
        transpose_quant<4096>(c, b_w_in, B_COLS, WIN8, SBIN, 0); transpose_quant<4096>(c, b_w_out, DM, WOUT8, SBOUT, r1); transpose_quant<4096>(c, peer_w_q + (size_t)DM * 2048, 2048, WQ8, SBQ, r2);
        RELANE();
        zero_flat16(c, WIN8 + (size_t)B_COLS * DM, (size_t)(B_COLS_PAD - B_COLS) * DM);
        for (int i = c.bid * NTHREADS + c.tid; i < B_COLS_PAD - B_COLS; i += c.G * NTHREADS) SBIN[B_COLS + i] = 0.f;
        const ConvDeal cd = conv_deal(c.G, c.bid, B_COLS / 32, 32, DM / 32, r1, 32, 2048 / 32, r2, 32, 16384);
        convert_rows_i8(c, peer_u + EU, UB, SU, cd.lo + c.wave, cd.hi, 8); convert_rows_i8(c, peer_u + EU, UB, SU, cd.covered + c.bid * 8 + c.wave, 16384, c.G * 8);
        convert_rows_i8(c, peer_v + EU, VB, SV, c.bid * 8 + c.wave, 16384, c.G * 8);
        SEAM(13);
    }
    if (IN(15)) { RELANE();
        fox_gate_job(c, X8B, XSB, WIN8 + (size_t)FOXW * DM, SBIN + FOXW, FG); RELANE();
        pg8::Gemm g{(const bf16_t*)X8B, (const bf16_t*)WIN8, T, FOXW, DM / 2, c.wave, XSB, SBIN}; pg8::StaticOrder S; S.init(T, FOXW, c.G, c.bid);
        EpiFox E{QKV, FG};
        pg8::gemm_phase<EpiFox, pg8::StaticOrder, false, true>(c.lds, g, S, E, nullptr);
        SEAM(15);
    }
    if (IN(16)) { RELANE(); cumsum_phase(c, FG, b_f_bias, C2, LSE  ); SEAM(16); }
    if (IN(17)) { RELANE(); const PeerDeal d = peer_deal(c, XC, myx, myrank, IN(16));
#if MK_DUPS == 17
        fox_attn_phase<MK_FOXVAR>(c, QKV, C2, LSE, OG, d.xcd_mode, deal_xcd(d), deal_rank(d));
#endif
        fox_attn_phase<0>(c, QKV, C2, LSE, OG, d.xcd_mode, deal_xcd(d), deal_rank(d));
        SEAM(17); }
    if (IN(18)) { RELANE(); quant_rows_bf16_i8<4096>(c, OG, OG8, SOG, T); SEAM(18); }
    if (IN(19)) { RELANE();
        pg8::Gemm g{(const bf16_t*)OG8, (const bf16_t*)WOUT8, T, DM, DM / 2, c.wave, SOG, SBOUT}; pg8::StaticOrder S; S.init(T, DM, c.G, c.bid);
        EpiRes<false> E{HF, HF, DM, DN_ALPHA};
        pg8::gemm_phase<EpiRes<false>, pg8::StaticOrder, false, true>(c.lds, g, S, E, nullptr);
        SEAM(19);
    }
    if (IN(20)) { RELANE(); ln_phase(c, HF, nullptr, nullptr, ln_mix_g + DM, ln_mix_b + DM, X8, XS); SEAM(20); }
    if (IN(21)) { RELANE();
        pg8::Gemm g{(const bf16_t*)X8, (const bf16_t*)WQ8, T, 2048, DM / 2, c.wave, XS, SBQ}; pg8::StaticOrder S; S.init(T, 2048, c.G, c.bid);
        pg8::EpiBf16<0> E{QP, 2048, nullptr, 0, 0};
        pg8::gemm_phase<pg8::EpiBf16<0>, pg8::StaticOrder, false, true>(c.lds, g, S, E, nullptr);
        SEAM(21);
    }
    if (IN(22)) { RELANE(); peer_select_phase(c, QP, peer_sk + 2 * 128 * 128, PIDX, PGATE); SEAM(22); }
    if (IN(23)) { RELANE(); const PeerDeal d = peer_deal(c, XC, myx, myrank, IN(22)); peer_pass_phase<1>(c, d, UB, PIDX, X8, nullptr, nullptr, PART); SEAM(23); }
    if (IN(24)) { RELANE(); peer_act_phase(c, PART, PIDX, PGATE, SU, SV, XS, PW, WSC); SEAM(24); }
    if (IN(25)) { RELANE(); const PeerDeal d = peer_deal(c, XC, myx, myrank, IN(24)); peer_pass_phase<2>(c, d, VB, PIDX, nullptr, (const unsigned char*)PW, WSC, POUT); SEAM(25); }
    if (IN(26)) { RELANE(); ln_add_phase(c, HF, ln_mix_g + DM, ln_mix_b + DM, POUT, args.out, nullptr, ln_ffn_g + DM, ln_ffn_b + DM); }
#undef IN
#undef SEAM
#undef x
#undef a_w_in
#undef a_w_out
#undef b_w_in
#undef b_f_bias
#undef b_w_out
#undef peer_w_q
#undef peer_sk
#undef peer_u
#undef peer_v
#undef ln_mix_g
#undef ln_mix_b
#undef ln_ffn_g
#undef ln_ffn_b
#undef INP
}
}

extern "C" void kernel_launch(void* const* d_in, const int* in_sizes, int n_in, void* d_out, int out_size, void* d_ws, size_t ws_size, hipStream_t stream) {
    using namespace mk;
    static int grid = 0;
    if (grid == 0) {
        if (n_in != 14 || out_size != T * DM || ws_size < WS_END2) { fprintf(stderr, "kernel_launch: unexpected shapes (n_in %d out %d ws %zu need %zu); nothing launched\n", n_in, out_size, ws_size, (size_t)WS_END2); grid = -1; return; }
        int dev = 0, cus = 0, per_cu = 0;
        if (hipGetDevice(&dev) != hipSuccess || hipDeviceGetAttribute(&cus, hipDeviceAttributeMultiprocessorCount, dev) != hipSuccess) { grid = -1; return; }
        if (hipFuncSetAttribute((const void*)mk_fwd, hipFuncAttributeMaxDynamicSharedMemorySize, LDS_BYTES) != hipSuccess) { fprintf(stderr, "kernel_launch: hipFuncSetAttribute failed\n"); grid = -1; return; }
        if (hipOccupancyMaxActiveBlocksPerMultiprocessor(&per_cu, (const void*)mk_fwd, NTHREADS, LDS_BYTES) != hipSuccess || per_cu < 1) { fprintf(stderr, "kernel_launch: occupancy query says %d\n", per_cu); per_cu = 1; }
        (void)hipGetLastError();
        grid = cus;
    }
    if (grid < 0) return;
    if (hipMemsetAsync((char*)d_ws + WS_CTL, 0, (size_t)MAX_LAUNCHES * BAR_REGION_WORDS * 4 + MAX_LAUNCHES * 256, stream) != hipSuccess) return;
    Args a{};
    for (int i = 0; i < 14; ++i) a.in[i] = (const float*)d_in[i];
    a.out = (float*)d_out; a.ws = (unsigned char*)d_ws; a.pad = 0;
#if MK_N_LAUNCHES == 1
    a.ph_lo = 0; a.ph_hi = NPHASES; a.li = 0;
    hipLaunchKernelGGL(mk_fwd, dim3(grid), dim3(NTHREADS), LDS_BYTES, stream, a);
#else
    for (int p = 0; p < NPHASES; ++p) { a.ph_lo = p; a.ph_hi = p + 1; a.li = p; hipLaunchKernelGGL(mk_fwd, dim3(grid), dim3(NTHREADS), LDS_BYTES, stream, a); }
#endif
}
```

```cpp
#include <hip/hip_runtime.h>
#include <cstdio>
#include <cstdint>
#ifndef MK_N_LAUNCHES
#define MK_N_LAUNCHES 1
#endif
__device__ __forceinline__ int mk_hw_lane() { int l; asm volatile("v_mbcnt_lo_u32_b32 %0, -1, 0\n\tv_mbcnt_hi_u32_b32 %0, -1, %0" : "=v"(l)); return l; }

#define XB_TMO      128
#define XB_XCNT(j)  (256  + 64 * (j))
#define XB_XSUB(j)  (1280 + 64 * (j))
#define XB_XGEN(j)  (2304 + 64 * (j))
#define XB_TOP      3328
#define XB_TOPGEN   3392
#define XCD_BAR_WORDS 3456
#define XB_SPIN_CAP (1u << 18)
#define LAS __attribute__((address_space(3)))

__device__ __forceinline__ unsigned xb_ld(unsigned* p)              { return __hip_atomic_load(p, __ATOMIC_RELAXED, __HIP_MEMORY_SCOPE_AGENT); }
__device__ __forceinline__ unsigned xb_add(unsigned* p, unsigned v) { return __hip_atomic_fetch_add(p, v, __ATOMIC_RELAXED, __HIP_MEMORY_SCOPE_AGENT); }
__device__ __forceinline__ unsigned xb_xcc_id() { return (unsigned)__builtin_amdgcn_s_getreg((3 << 11) | 20) & 0xFu; }
#define XB_SPIN(cond, bar) do { unsigned _sp = 0; while (cond) { __builtin_amdgcn_s_sleep(1); \
    if ((++_sp & 255u) == 0u) { if (xb_ld(&(bar)[XB_TMO])) break; if (_sp > XB_SPIN_CAP) { atomicAdd(&(bar)[XB_TMO], 1u); break; } } } } while (0)

struct XcdBarrier {
    unsigned* bar; unsigned x; int wave;
    volatile LAS unsigned* st;
};

__device__ __forceinline__ XcdBarrier xcd_barrier_post(unsigned* bar, volatile LAS unsigned* st, int wave) {
    XcdBarrier b; b.bar = bar; b.x = xb_xcc_id(); b.st = st; b.wave = wave;
    if (wave == 0 && mk_hw_lane() == 0) (void)xb_add(&bar[XB_XCNT(b.x)], 1u);
    return b;
}
__device__ __forceinline__ void xcd_barrier_complete(unsigned* bar, unsigned x, unsigned& nloc, unsigned& nx) {
    const unsigned G = gridDim.x * gridDim.y * gridDim.z;
    unsigned sum, cnt, mine, sp = 0u;
    for (;;) {
        sum = 0u; cnt = 0u; mine = 0u;
#pragma unroll
        for (unsigned j = 0; j < 16; ++j) { const unsigned c = xb_ld(&bar[XB_XCNT(j)]); sum += c; cnt += (c > 0u) ? 1u : 0u; mine = (j == x) ? c : mine; }
        if (sum == G) break;
        __builtin_amdgcn_s_sleep(1);
        if ((++sp & 255u) == 0u) { if (xb_ld(&bar[XB_TMO])) break; if (sp > XB_SPIN_CAP) { atomicAdd(&bar[XB_TMO], 1u); break; } }
    }
    nloc = mine > 0u ? mine : 1u; nx = cnt > 0u ? cnt : 1u;
}

__device__ __forceinline__ void xcd_barrier(const XcdBarrier& b) {
    asm volatile("s_waitcnt vmcnt(0)" ::: "memory");
    __syncthreads();
    if (b.wave == 0 && mk_hw_lane() == 0) {
        unsigned* bar = b.bar;
        __builtin_amdgcn_s_waitcnt(0);
        unsigned nloc = b.st[0], nx = b.st[1];
        if (nloc == 0u) { xcd_barrier_complete(bar, b.x, nloc, nx); b.st[0] = nloc; b.st[1] = nx; }
        const unsigned old = xb_add(&bar[XB_XSUB(b.x)], 1u);
        const unsigned gen = old / nloc;
        if (old + 1u == (gen + 1u) * nloc) {
            __builtin_amdgcn_fence(__ATOMIC_RELEASE, "agent");
            asm volatile("s_waitcnt vmcnt(0)" ::: "memory");
            const unsigned og = xb_add(&bar[XB_TOP], 1u);
            const unsigned tg = og / nx;
            if (og + 1u == (tg + 1u) * nx) xb_add(&bar[XB_TOPGEN], 1u);
            else XB_SPIN(xb_ld(&bar[XB_TOPGEN]) == tg, bar);
            __builtin_amdgcn_fence(__ATOMIC_ACQUIRE, "agent");
            xb_add(&bar[XB_XGEN(b.x)], 1u);
            asm volatile("s_waitcnt vmcnt(0)" ::: "memory");
        } else {
            XB_SPIN(xb_ld(&bar[XB_XGEN(b.x)]) == gen, bar);
            __builtin_amdgcn_fence(__ATOMIC_ACQUIRE, "agent");
            asm volatile("s_waitcnt vmcnt(0)" ::: "memory");
        }
    }
    __syncthreads();
}

namespace pg8 {
#define PG8_LAS __attribute__((address_space(3)))
typedef unsigned short bf16_t;
typedef short bf16x8 __attribute__((ext_vector_type(8)));
typedef float f32x4 __attribute__((ext_vector_type(4)));
typedef unsigned u32x4 __attribute__((ext_vector_type(4)));
constexpr int BM = 256, BK = 64, HALF = 128, HTB = HALF * BK * 2  , STAGE_BYTES = 8 * HTB, NXCD = 8, WGM = 8;

__host__ __device__ __forceinline__ int lds_byte(int r, int c) { const int st = (r >> 4) * 2 + (c >> 5), rr = r & 15, cc = c & 31, ob = rr * 64 + cc * 2; return st * 1024 + (ob ^ (((ob >> 9) & 1) << 5)); }
__host__ __device__ __forceinline__ void stage_rc(int b, int& R, int& C) { const int st = b / 1024, sb = b % 1024, swz = sb ^ (((sb >> 9) & 1) << 5); R = (st >> 1) * 16 + swz / 64; C = (st & 1) * 32 + (swz % 64) / 2; }
__host__ __device__ __forceinline__ int perm32(int rho) { const int n = rho >> 4, i = rho & 15; return 8 * (i >> 2) + 4 * n + (i & 3); }

struct Unit { int pm, pn; };
struct Gemm { const bf16_t* A; const bf16_t* Bt; int M, N, K, wave; const float* sa; const float* sb; };

struct StaticOrder {
    int nM, nN, nwg, G, c;
    __host__ __device__ void init(int M, int N, int G_, int c_) { nM = M / BM; nN = N / BM; nwg = nM * nN; G = G_; c = c_; }
    __host__ __device__ bool next(int i, Unit& u) const {
        const long L = (long)i * G + c; if (L >= nwg) return false;
        int wgid = (int)L; { const int q = nwg / NXCD, r = nwg % NXCD, xcd = wgid % NXCD, off = wgid / NXCD; wgid = (xcd < r ? xcd * (q + 1) : r * (q + 1) + (xcd - r) * q) + off; }
        const int nig = WGM * nN, gid = wgid / nig, fm = gid * WGM, gsz = (nM - fm) < WGM ? (nM - fm) : WGM;
        u.pm = fm + ((wgid % nig) % gsz); u.pn = (wgid % nig) / gsz; return true;
    }
    __device__ __forceinline__ void a_ready(const Unit&) const {}
    __device__ __forceinline__ void done(const Unit&) const {}
};
struct CountedOrder : StaticOrder {
    const unsigned* ready; unsigned need; unsigned* tmo;
    __device__ __forceinline__ void a_ready(const Unit& u) const {
        if (threadIdx.x < 64) {
            const unsigned long long t0 = __builtin_amdgcn_s_memrealtime(); unsigned polls = 0;
            while ((unsigned)__builtin_amdgcn_readfirstlane(__hip_atomic_load(ready + 64 * u.pm, __ATOMIC_RELAXED, __HIP_MEMORY_SCOPE_AGENT)) < need) {
                if ((++polls & 255u) == 0u && __builtin_amdgcn_readfirstlane(__hip_atomic_load(tmo, __ATOMIC_RELAXED, __HIP_MEMORY_SCOPE_AGENT)) != 0u) break;
                if (__builtin_amdgcn_s_memrealtime() - t0 > 2000000ull) {
                    if (threadIdx.x == 0) { unsigned expect = 0u; __hip_atomic_compare_exchange_strong(tmo + 1, &expect, 0x600u | (unsigned)(u.pm & 0xff), __ATOMIC_RELAXED, __ATOMIC_RELAXED, __HIP_MEMORY_SCOPE_AGENT); __hip_atomic_store(tmo, 1u, __ATOMIC_RELAXED, __HIP_MEMORY_SCOPE_AGENT); }
                    break; }
                __builtin_amdgcn_s_sleep(2); }
            __builtin_amdgcn_fence(__ATOMIC_ACQUIRE, "agent");
            asm volatile("s_waitcnt vmcnt(0)" ::: "memory");
        }
#if !defined(BROKEN_HOOK_NO_BARRIER)
        asm volatile("" ::: "memory"); __builtin_amdgcn_s_barrier(); asm volatile("" ::: "memory");
#endif
    }
};

__device__ __forceinline__ unsigned cvt_pk_bf16(float lo, float hi) { unsigned r; asm volatile("v_cvt_pk_bf16_f32 %0, %1, %2" : "=v"(r) : "v"(lo), "v"(hi)); return r; }
typedef float f32x2 __attribute__((ext_vector_type(2)));
__device__ __forceinline__ f32x2 gelu_pk(f32x2 v) {
    const f32x2 av = __builtin_elementwise_abs(v), d = av * 0.2316418882f + 1.0f;
    f32x2 t; t.x = __builtin_amdgcn_rcpf(d.x); t.y = __builtin_amdgcn_rcpf(d.y);
    f32x2 q = t * 0.5307027145f + (-0.7265760135f); q = q * t + 0.7107068705f; q = q * t + (-0.142248368f); q = q * t + 0.127414796f; q = q * t;
    const f32x2 s = (v * v) * (-0.72134752044f);
    f32x2 e; e.x = __builtin_amdgcn_exp2f(s.x); e.y = __builtin_amdgcn_exp2f(s.y);
    const f32x2 m = v * (q * e), r = v - m;
    f32x2 o; o.x = v.x < 0.f ? m.x : r.x; o.y = v.y < 0.f ? m.y : r.y; return o;
}

struct EpiF32 {
    static constexpr bool PERM = false, AFTER_DRAIN = false;
    float* C; int ldc; const float* bias;
    __device__ __forceinline__ void operator()(const f32x4 (&acc)[2][2][4][2], const Unit& u, int wr, int wc, int fr, int fq) const {
        const int row0 = u.pm * BM + wr * 64 + fr, col0 = u.pn * BM + wc * 32 + 4 * fq;
        f32x4 bv[2][2];
#pragma unroll
        for (int bj = 0; bj < 2; ++bj)
#pragma unroll
            for (int n = 0; n < 2; ++n) bv[bj][n] = bias ? *(const f32x4*)(bias + col0 + bj * HALF + n * 16) : (f32x4){0.f, 0.f, 0.f, 0.f};
#pragma unroll
        for (int ai = 0; ai < 2; ++ai)
#pragma unroll
            for (int m = 0; m < 4; ++m) { float* rowp = C + (size_t)(row0 + ai * HALF + m * 16) * ldc + col0;
#pragma unroll
                for (int bj = 0; bj < 2; ++bj)
#pragma unroll
                    for (int n = 0; n < 2; ++n) *(f32x4*)(rowp + bj * HALF + n * 16) = acc[ai][bj][m][n] + bv[bj][n]; }
    }
};
template <int ACT  > struct EpiBf16 {
    static constexpr bool PERM = true, AFTER_DRAIN = false;
    bf16_t* O; int ldc; const float* bias; int split_cols; size_t split_stride;
    __device__ __forceinline__ void operator()(const f32x4 (&acc)[2][2][4][2], const Unit& u, int wr, int wc, int fr, int fq) const {
        const int row0 = u.pm * BM + wr * 64 + fr; int colt = u.pn * BM; bf16_t* base = O;
        if (split_cols) { const int t = colt / split_cols; base += (size_t)t * split_stride; colt -= t * split_cols; }
        const int col0 = colt + wc * 32 + 8 * fq, bcol0 = u.pn * BM + wc * 32 + 8 * fq;
        f32x4 bv[2][2];
#pragma unroll
        for (int bj = 0; bj < 2; ++bj)
#pragma unroll
            for (int n = 0; n < 2; ++n) bv[bj][n] = bias ? *(const f32x4*)(bias + bcol0 + bj * HALF + 4 * n) : (f32x4){0.f, 0.f, 0.f, 0.f};
#pragma unroll
        for (int ai = 0; ai < 2; ++ai)
#pragma unroll
            for (int m = 0; m < 4; ++m) { bf16_t* rowp = base + (size_t)(row0 + ai * HALF + m * 16) * ldc + col0;
#pragma unroll
                for (int bj = 0; bj < 2; ++bj) { f32x4 v0 = acc[ai][bj][m][0] + bv[bj][0], v1 = acc[ai][bj][m][1] + bv[bj][1];
                    if (ACT == 1) { f32x2 a = gelu_pk((f32x2){v0[0], v0[1]}), b = gelu_pk((f32x2){v0[2], v0[3]}), c = gelu_pk((f32x2){v1[0], v1[1]}), d = gelu_pk((f32x2){v1[2], v1[3]});
                        v0 = (f32x4){a.x, a.y, b.x, b.y}; v1 = (f32x4){c.x, c.y, d.x, d.y}; }
                    if (ACT == 2) {
#pragma unroll
                        for (int j = 0; j < 4; ++j) { v0[j] = 0.5f * v0[j] * (1.0f + erff(v0[j] * 0.70710678f)); v1[j] = 0.5f * v1[j] * (1.0f + erff(v1[j] * 0.70710678f)); } }
                    u32x4 w; w.x = cvt_pk_bf16(v0[0], v0[1]); w.y = cvt_pk_bf16(v0[2], v0[3]); w.z = cvt_pk_bf16(v1[0], v1[1]); w.w = cvt_pk_bf16(v1[2], v1[3]);
                    *(u32x4*)(rowp + bj * HALF) = w; } }
    }
};

struct PanelStats {
    unsigned* xbuf;
    unsigned* cnt;
    unsigned* tmo;
    int ntn; float eps;
    unsigned code;
    __device__ __forceinline__ bool run(const f32x4 (&v)[2][2][4][2], const Unit& u, int wr, int wc, int fr, int fq, PG8_LAS unsigned char* lds, int wid, int lane) const {
        typedef float f32x2v __attribute__((ext_vector_type(2)));
        PG8_LAS f32x2v* P = (PG8_LAS f32x2v*)lds;
        PG8_LAS f32x2v* S = (PG8_LAS f32x2v*)(lds + 8192);
        PG8_LAS unsigned* flag = (PG8_LAS unsigned*)(lds + 8192 + 2048);
#pragma unroll
        for (int ai = 0; ai < 2; ++ai)
#pragma unroll
            for (int m = 0; m < 4; ++m) {
                float s = 0.f;
#pragma unroll
                for (int bj = 0; bj < 2; ++bj)
#pragma unroll
                    for (int n = 0; n < 2; ++n) { const f32x4 x = v[ai][bj][m][n]; s += (x[0] + x[1]) + (x[2] + x[3]); }
                s += __shfl_xor(s, 16); s += __shfl_xor(s, 32);
                const float mw = s * (1.0f / 64.0f); float q = 0.f;
#pragma unroll
                for (int bj = 0; bj < 2; ++bj)
#pragma unroll
                    for (int n = 0; n < 2; ++n) { const f32x4 d = v[ai][bj][m][n] - mw; q += (d[0] * d[0] + d[1] * d[1]) + (d[2] * d[2] + d[3] * d[3]); }
                q += __shfl_xor(q, 16); q += __shfl_xor(q, 32);
                if (fq == 0) P[(ai * HALF + wr * 64 + m * 16 + fr) * 4 + wc] = (f32x2v){mw, q};
            }
        asm volatile("s_waitcnt lgkmcnt(0)" ::: "memory"); __builtin_amdgcn_s_barrier(); asm volatile("" ::: "memory");
#if defined(BROKEN_NO_WAIT)
        if (blockIdx.x >= 64) { const long long t0 = clock64(); while (clock64() - t0 < 60000) __builtin_amdgcn_s_sleep(8); }
#endif
        const int row = wid * 32 + (lane & 31);
        if (lane < 32) {
            const f32x2v a = P[row * 4 + 0], b = P[row * 4 + 1], c = P[row * 4 + 2], d = P[row * 4 + 3];
            const float mt = (a.x + b.x + c.x + d.x) * 0.25f;
            const float da = a.x - mt, db = b.x - mt, dc = c.x - mt, dd = d.x - mt;
            const float m2 = (a.y + b.y) + (c.y + d.y) + 64.0f * ((da * da + db * db) + (dc * dc + dd * dd));
            unsigned long long* slot = (unsigned long long*)xbuf + ((size_t)(u.pm * BM + row) * 4 + u.pn);
            __hip_atomic_store(slot, ((unsigned long long)__float_as_uint(m2) << 32) | __float_as_uint(mt), __ATOMIC_RELAXED, __HIP_MEMORY_SCOPE_AGENT);
        }
        asm volatile("s_waitcnt vmcnt(0)" ::: "memory");
        if (lane == 0) __hip_atomic_fetch_add(cnt + 64 * u.pm, 1u, __ATOMIC_RELAXED, __HIP_MEMORY_SCOPE_AGENT);
        if (wid == 0) {
            bool dead = false; const unsigned long long t0 = __builtin_amdgcn_s_memrealtime(); const unsigned want = 8u * (unsigned)ntn;
            for (;;) {
#if defined(BROKEN_NO_WAIT)
                break;
#endif
                if ((unsigned)__builtin_amdgcn_readfirstlane(__hip_atomic_load(cnt + 64 * u.pm, __ATOMIC_RELAXED, __HIP_MEMORY_SCOPE_AGENT)) >= want) break;
                if (__builtin_amdgcn_s_memrealtime() - t0 > 2000000ull) {
                    if (lane == 0) { unsigned expect = 0u; __hip_atomic_compare_exchange_strong(tmo + 1, &expect, code | (unsigned)(u.pm & 0xff), __ATOMIC_RELAXED, __ATOMIC_RELAXED, __HIP_MEMORY_SCOPE_AGENT);
                                     __hip_atomic_store(tmo, 1u, __ATOMIC_RELAXED, __HIP_MEMORY_SCOPE_AGENT); }
                    dead = true; break; }
                __builtin_amdgcn_s_sleep(2);
            }
            __builtin_amdgcn_fence(__ATOMIC_ACQUIRE, "agent");
            if (lane == 0) flag[0] = dead ? 1u : 0u;
        }
        asm volatile("s_waitcnt vmcnt(0) lgkmcnt(0)" ::: "memory"); __builtin_amdgcn_s_barrier(); asm volatile("" ::: "memory");
        const bool bad = flag[0] != 0u;
        if (lane < 32) {
            const unsigned long long* slot = (const unsigned long long*)xbuf + (size_t)(u.pm * BM + row) * 4; float mt[4], m2[4]; float ms = 0.f;
#pragma unroll
            for (int t = 0; t < 4; ++t) { if (t < ntn) { const unsigned long long w = __hip_atomic_load(slot + t, __ATOMIC_RELAXED, __HIP_MEMORY_SCOPE_AGENT); mt[t] = __uint_as_float((unsigned)w); m2[t] = __uint_as_float((unsigned)(w >> 32)); } else { mt[t] = 0.f; m2[t] = 0.f; } ms += mt[t]; }
            const float mean = ms / (float)ntn; float q = 0.f;
#pragma unroll
            for (int t = 0; t < 4; ++t) if (t < ntn) { const float dm = mt[t] - mean; q += m2[t] + 256.0f * dm * dm; }
            S[row] = (f32x2v){mean, 1.0f / sqrtf(q / (256.0f * (float)ntn) + eps)};
        }
        asm volatile("s_waitcnt lgkmcnt(0)" ::: "memory"); __builtin_amdgcn_s_barrier(); asm volatile("" ::: "memory");
        return bad;
    }
};
struct EpiLnRes {
    static constexpr bool PERM = false, AFTER_DRAIN = true;
    const float* base; float* out; int ldc; const float* bias; PanelStats st; unsigned poison;
    __device__ __forceinline__ void refuse(size_t i0, size_t stride, int M, int N) const { const float q = __builtin_nanf(""); for (size_t i = i0; i < (size_t)M * N; i += stride) out[(i / N) * ldc + i % N] = q;
        if (i0 == 0) { unsigned expect = 0u; __hip_atomic_compare_exchange_strong(st.tmo + 1, &expect, 0x7f0u, __ATOMIC_RELAXED, __ATOMIC_RELAXED, __HIP_MEMORY_SCOPE_AGENT); __hip_atomic_store(st.tmo, 1u, __ATOMIC_RELAXED, __HIP_MEMORY_SCOPE_AGENT); } }
    __device__ __forceinline__ void fused(f32x4 (&acc)[2][2][4][2], const Unit& u, int wr, int wc, int fr, int fq, PG8_LAS unsigned char* lds, int wid, int lane) const {
        typedef float f32x2v __attribute__((ext_vector_type(2)));
        const PG8_LAS f32x2v* S = (const PG8_LAS f32x2v*)(lds + 8192);
        const int col0 = u.pn * BM + wc * 32 + 4 * fq;
#pragma unroll
        for (int bj = 0; bj < 2; ++bj)
#pragma unroll
            for (int n = 0; n < 2; ++n) { const f32x4 bv = bias ? *(const f32x4*)(bias + col0 + bj * HALF + n * 16) : (f32x4){0.f, 0.f, 0.f, 0.f};
#pragma unroll
                for (int ai = 0; ai < 2; ++ai)
#pragma unroll
                    for (int m = 0; m < 4; ++m) acc[ai][bj][m][n] += bv; }
        const bool bad = st.run(acc, u, wr, wc, fr, fq, lds, wid, lane) || poison != 0u;
        const float qnan = __builtin_nanf("");
#pragma unroll
        for (int ai = 0; ai < 2; ++ai)
#pragma unroll
            for (int m = 0; m < 4; ++m) { const int r = ai * HALF + wr * 64 + m * 16 + fr; const f32x2v sr = S[r]; const size_t off = (size_t)(u.pm * BM + r) * ldc + col0;
#pragma unroll
                for (int bj = 0; bj < 2; ++bj)
#pragma unroll
                    for (int n = 0; n < 2; ++n) { const f32x4 bs = *(const f32x4*)(base + off + bj * HALF + n * 16); f32x4 o = bs + (acc[ai][bj][m][n] - sr.x) * sr.y;
                        if (bad) o = (f32x4){qnan, qnan, qnan, qnan}; *(f32x4*)(out + off + bj * HALF + n * 16) = o; }
                asm volatile("" ::: "memory"); }
    }
};
struct EpiLnResLn {
    static constexpr bool PERM = false, AFTER_DRAIN = true;
    const float* base; float* out; bf16_t* xn; int ldc; const float* bias; PanelStats st1, st2; unsigned poison;
    __device__ __forceinline__ void refuse(size_t i0, size_t stride, int M, int N) const { const float q = __builtin_nanf(""); for (size_t i = i0; i < (size_t)M * N; i += stride) { const size_t o = (i / N) * ldc + i % N; out[o] = q; xn[o] = (bf16_t)0x7fc0u; }
        if (i0 == 0) { unsigned expect = 0u; __hip_atomic_compare_exchange_strong(st1.tmo + 1, &expect, 0x7f0u, __ATOMIC_RELAXED, __ATOMIC_RELAXED, __HIP_MEMORY_SCOPE_AGENT); __hip_atomic_store(st1.tmo, 1u, __ATOMIC_RELAXED, __HIP_MEMORY_SCOPE_AGENT); } }
    __device__ __forceinline__ void fused(f32x4 (&acc)[2][2][4][2], const Unit& u, int wr, int wc, int fr, int fq, PG8_LAS unsigned char* lds, int wid, int lane) const {
        typedef float f32x2v __attribute__((ext_vector_type(2))); typedef unsigned u32x2v __attribute__((ext_vector_type(2)));
        const PG8_LAS f32x2v* S = (const PG8_LAS f32x2v*)(lds + 8192);
        const int col0 = u.pn * BM + wc * 32 + 4 * fq;
#pragma unroll
        for (int bj = 0; bj < 2; ++bj)
#pragma unroll
            for (int n = 0; n < 2; ++n) { const f32x4 bv = bias ? *(const f32x4*)(bias + col0 + bj * HALF + n * 16) : (f32x4){0.f, 0.f, 0.f, 0.f};
#pragma unroll
                for (int ai = 0; ai < 2; ++ai)
#pragma unroll
                    for (int m = 0; m < 4; ++m) acc[ai][bj][m][n] += bv; }
        bool bad = st1.run(acc, u, wr, wc, fr, fq, lds, wid, lane) || poison != 0u;
        const float qnan = __builtin_nanf("");
#pragma unroll
        for (int ai = 0; ai < 2; ++ai)
#pragma unroll
            for (int m = 0; m < 4; ++m) { const int r = ai * HALF + wr * 64 + m * 16 + fr; const f32x2v sr = S[r]; const size_t off = (size_t)(u.pm * BM + r) * ldc + col0;
#pragma unroll
                for (int bj = 0; bj < 2; ++bj)
#pragma unroll
                    for (int n = 0; n < 2; ++n) { const f32x4 bs = *(const f32x4*)(base + off + bj * HALF + n * 16); acc[ai][bj][m][n] = bs + (acc[ai][bj][m][n] - sr.x) * sr.y; }
                asm volatile("" : "+v"(acc[ai][0][m][0]), "+v"(acc[ai][0][m][1]), "+v"(acc[ai][1][m][0]), "+v"(acc[ai][1][m][1]));
                if (m & 1) asm volatile("" ::: "memory"); }
        const bool bad1 = bad;
        bad = st2.run(acc, u, wr, wc, fr, fq, lds, wid, lane) || bad;
#pragma unroll
        for (int ai = 0; ai < 2; ++ai)
#pragma unroll
            for (int m = 0; m < 4; ++m) { const int r = ai * HALF + wr * 64 + m * 16 + fr; const f32x2v sr = S[r]; const size_t off = (size_t)(u.pm * BM + r) * ldc + col0;
#pragma unroll
                for (int bj = 0; bj < 2; ++bj)
#pragma unroll
                    for (int n = 0; n < 2; ++n) { const f32x4 x1 = acc[ai][bj][m][n]; *(f32x4*)(out + off + bj * HALF + n * 16) = bad1 ? (f32x4){qnan, qnan, qnan, qnan} : x1;
                        const f32x4 o = (x1 - sr.x) * sr.y; u32x2v w; w.x = cvt_pk_bf16(o[0], o[1]); w.y = cvt_pk_bf16(o[2], o[3]);
                        if (bad) { w.x = 0x7fc07fc0u; w.y = 0x7fc07fc0u; } *(u32x2v*)(xn + off + bj * HALF + n * 16) = w; }
                asm volatile("" ::: "memory"); }
    }
};

typedef int i32x4 __attribute__((ext_vector_type(4)));
template <class Epi, class Sched, bool STAMP = false, bool I8 = false>
__device__ __forceinline__ void gemm_phase(PG8_LAS unsigned char* lds, const Gemm g, const Sched& S, const Epi& E, unsigned long long* stamps) {
    const int lane = mk_hw_lane(), wid = g.wave, tid = wid * 64 + lane, wr = wid >> 2, wc = wid & 3, fr = lane & 15, fq = lane >> 4;
    const int K = g.K, nt = K / BK;
    int ts_lo = 0, ts_hi = 0, nts = 0; const unsigned long long rt_entry = STAMP ? (unsigned long long)wall_clock64() : 0ull;
#define PG8_STAMP() do { if (STAMP && wid == 0 && nts < 64) { const unsigned long long _c = (unsigned long long)clock64(); \
        ts_lo = (lane == nts) ? (int)(unsigned)_c : ts_lo; ts_hi = (lane == nts) ? (int)(unsigned)(_c >> 32) : ts_hi; ++nts; } } while (0)
    PG8_STAMP();
    unsigned voffA[2], voffB[2];
#pragma unroll
    for (int i = 0; i < 2; ++i) { int R, C; stage_rc(tid * 16 + i * 8192, R, C); const int Rb = Epi::PERM ? ((R & ~31) + perm32(R & 31)) : R;
        voffA[i] = (unsigned)(R * K + C) * 2u; voffB[i] = (unsigned)(Rb * K + C) * 2u; }
    const size_t kstep = (size_t)(BK * 2);
    const size_t hstep = (size_t)HALF * K * 2;
    const size_t tstep = 2 * hstep;
    const unsigned ldsw = (unsigned)wid * 1024u;
    const int aoff = lds_byte(wr * 64 + fr, fq * 8), boff = lds_byte(wc * 32 + fr, fq * 8);
#define PG8_SA(b, h) (((b) * 2 + (h)) * HTB)
#define PG8_SB(b, h) ((4 + (b) * 2 + (h)) * HTB)
#define PG8_STAGE(bufoff, gbase, voff) do { _Pragma("unroll") for (int _i = 0; _i < 2; ++_i) \
        __builtin_amdgcn_global_load_lds((const unsigned*)((const char*)(gbase) + (voff)[_i]), (PG8_LAS unsigned*)(lds + (bufoff) + ldsw + _i * 8192), 16, 0, 0); } while (0)
#define PG8_LDA(dst, b, h) do { _Pragma("unroll") for (int m = 0; m < 4; ++m) _Pragma("unroll") for (int k = 0; k < 2; ++k) dst[m][k] = *(const PG8_LAS bf16x8*)(lds + PG8_SA(b, h) + aoff + m * 2048 + k * 1024); } while (0)
#define PG8_LDB(dst, b, h) do { _Pragma("unroll") for (int n = 0; n < 2; ++n) _Pragma("unroll") for (int k = 0; k < 2; ++k) dst[n][k] = *(const PG8_LAS bf16x8*)(lds + PG8_SB(b, h) + boff + n * 2048 + k * 1024); } while (0)
#define PG8_MMA(ai, bj, At, Bt) do { __builtin_amdgcn_s_setprio(1); _Pragma("unroll") for (int m = 0; m < 4; ++m) _Pragma("unroll") for (int n = 0; n < 2; ++n) _Pragma("unroll") for (int k = 0; k < 2; ++k) \
        { if constexpr (I8) acc[ai][bj][m][n] = __builtin_bit_cast(f32x4, __builtin_amdgcn_mfma_i32_16x16x64_i8(__builtin_bit_cast(i32x4, Bt[n][k]), __builtin_bit_cast(i32x4, At[m][k]), __builtin_bit_cast(i32x4, acc[ai][bj][m][n]), 0, 0, 0)); \
          else acc[ai][bj][m][n] = __builtin_amdgcn_mfma_f32_16x16x32_bf16(Bt[n][k], At[m][k], acc[ai][bj][m][n], 0, 0, 0); } __builtin_amdgcn_s_setprio(0); } while (0)
#define PG8_WAIT_V(n) asm volatile("s_waitcnt vmcnt(" #n ")" ::: "memory")
#define PG8_WAIT_L(n) asm volatile("s_waitcnt lgkmcnt(" #n ")" ::: "memory")
#define PG8_BAR __builtin_amdgcn_s_barrier()
#define PG8_SCHED __builtin_amdgcn_sched_barrier(0)
    Unit cur, nxt; int ui = 0;
    if (!S.next(0, cur)) return;
    f32x4 acc[2][2][4][2];
#pragma unroll
    for (int a = 0; a < 2; ++a)
#pragma unroll
        for (int b = 0; b < 2; ++b)
#pragma unroll
            for (int m = 0; m < 4; ++m)
#pragma unroll
                for (int n = 0; n < 2; ++n) acc[a][b][m][n] = (f32x4){0.f, 0.f, 0.f, 0.f};
    bf16x8 At[4][2], B0[2][2], B1[2][2];
    const char* cA = (const char*)g.A + (size_t)cur.pm * tstep; const char* cB = (const char*)g.Bt + (size_t)cur.pn * tstep;
    S.a_ready(cur);
    PG8_STAGE(PG8_SB(0, 0), cB, voffB); PG8_STAGE(PG8_SA(0, 0), cA, voffA); PG8_STAGE(PG8_SB(0, 1), cB + hstep, voffB); PG8_STAGE(PG8_SA(0, 1), cA + hstep, voffA);
    if (wr == 1) PG8_BAR;
    PG8_WAIT_V(4); PG8_BAR;
    PG8_STAGE(PG8_SB(1, 0), cB + kstep, voffB); PG8_STAGE(PG8_SA(1, 0), cA + kstep, voffA); PG8_STAGE(PG8_SB(1, 1), cB + hstep + kstep, voffB);
    PG8_WAIT_V(6); PG8_BAR;
    PG8_STAMP();
    for (;;) {
        const bool has_next = S.next(ui + 1, nxt);
        const char* nA = has_next ? (const char*)g.A + (size_t)nxt.pm * tstep : cA; const char* nB = has_next ? (const char*)g.Bt + (size_t)nxt.pn * tstep : cB;
        for (int t = 0; t < nt; t += 2) {
            const bool last = (t == nt - 2);
            const char* a1 = cA + (size_t)(t + 1) * kstep;
            const char* a2 = last ? nA : cA + (size_t)(t + 2) * kstep; const char* b2 = last ? nB : cB + (size_t)(t + 2) * kstep;
            const char* a3 = a2 + kstep; const char* b3 = b2 + kstep;
            if (last && has_next) S.a_ready(nxt);
            PG8_LDB(B0, 0, 0); PG8_SCHED; PG8_LDA(At, 0, 0); PG8_STAGE(PG8_SA(1, 1), a1 + hstep, voffA);
            PG8_WAIT_L(8); PG8_BAR; PG8_WAIT_L(0); PG8_MMA(0, 0, At, B0); PG8_BAR; PG8_SCHED;
            PG8_LDB(B1, 0, 1); PG8_STAGE(PG8_SB(0, 0), b2, voffB);
            PG8_BAR; PG8_WAIT_L(0); PG8_MMA(0, 1, At, B1); PG8_BAR;
            PG8_LDA(At, 0, 1); PG8_STAGE(PG8_SA(0, 0), a2, voffA);
            PG8_BAR; PG8_WAIT_L(0); PG8_MMA(1, 0, At, B0); PG8_BAR; PG8_SCHED;
            PG8_STAGE(PG8_SB(0, 1), b2 + hstep, voffB);
            PG8_WAIT_V(6); PG8_BAR; PG8_MMA(1, 1, At, B1); PG8_BAR;
            PG8_LDB(B0, 1, 0); PG8_SCHED; PG8_LDA(At, 1, 0); PG8_STAGE(PG8_SA(0, 1), a2 + hstep, voffA);
            PG8_WAIT_L(8); PG8_BAR; PG8_WAIT_L(0); PG8_MMA(0, 0, At, B0); PG8_BAR; PG8_SCHED;
            PG8_LDB(B1, 1, 1); PG8_STAGE(PG8_SB(1, 0), b3, voffB);
            PG8_BAR; PG8_WAIT_L(0); PG8_MMA(0, 1, At, B1); PG8_BAR;
            PG8_LDA(At, 1, 1); PG8_STAGE(PG8_SA(1, 0), a3, voffA);
            PG8_BAR; PG8_WAIT_L(0); PG8_MMA(1, 0, At, B0); PG8_BAR; PG8_SCHED;
            PG8_STAGE(PG8_SB(1, 1), b3 + hstep, voffB);
            PG8_WAIT_V(6); PG8_BAR; PG8_MMA(1, 1, At, B1); PG8_BAR;
        }
        PG8_STAMP();
        if constexpr (I8) {
            const int r0_ = cur.pm * BM + wr * 64 + fr, c0_ = cur.pn * BM + wc * 32 + (Epi::PERM ? 8 * fq : 4 * fq);
#pragma unroll
            for (int bj = 0; bj < 2; ++bj)
#pragma unroll
                for (int n = 0; n < 2; ++n) { const f32x4 sbv = *(const f32x4*)(g.sb + c0_ + bj * HALF + (Epi::PERM ? 4 * n : 16 * n));
#pragma unroll
                    for (int ai = 0; ai < 2; ++ai)
#pragma unroll
                        for (int m = 0; m < 4; ++m) { const float sav = g.sa[r0_ + ai * HALF + m * 16]; const i32x4 iv = __builtin_bit_cast(i32x4, acc[ai][bj][m][n]);
                            acc[ai][bj][m][n] = (f32x4){(float)iv[0] * sav * sbv[0], (float)iv[1] * sav * sbv[1], (float)iv[2] * sav * sbv[2], (float)iv[3] * sav * sbv[3]}; } }
        }
        if constexpr (!Epi::AFTER_DRAIN) { E(acc, cur, wr, wc, fr, fq); S.done(cur); }
        PG8_STAMP();
        if (!has_next) break;
#pragma unroll
        for (int a = 0; a < 2; ++a)
#pragma unroll
            for (int b = 0; b < 2; ++b)
#pragma unroll
                for (int m = 0; m < 4; ++m)
#pragma unroll
                    for (int n = 0; n < 2; ++n) acc[a][b][m][n] = (f32x4){0.f, 0.f, 0.f, 0.f};
        cur = nxt; cA = nA; cB = nB; ++ui;
    }
    PG8_WAIT_V(0);
    if (wr == 0) PG8_BAR;
    PG8_BAR;
    if constexpr (Epi::AFTER_DRAIN) { E.fused(acc, cur, wr, wc, fr, fq, lds, wid, lane); S.done(cur); }
    PG8_STAMP();
    if (STAMP && wid == 0) { stamps[lane] = lane < nts ? (((unsigned long long)(unsigned)ts_hi << 32) | (unsigned)ts_lo) : 0ull;
        if (lane == 62) stamps[62] = rt_entry; if (lane == 63) stamps[63] = (unsigned long long)wall_clock64(); }
#undef PG8_STAMP
#undef PG8_SA
#undef PG8_SB
#undef PG8_STAGE
#undef PG8_LDA
#undef PG8_LDB
#undef PG8_MMA
#undef PG8_WAIT_V
#undef PG8_WAIT_L
#undef PG8_BAR
#undef PG8_SCHED
}
}

namespace mk {
using pg8::bf16_t; using pg8::bf16x8; using pg8::f32x4; using pg8::u32x4;
typedef float f32x16 __attribute__((ext_vector_type(16)));
typedef unsigned u32x2 __attribute__((ext_vector_type(2)));
typedef __bf16 bf16x2 __attribute__((ext_vector_type(2)));

constexpr int T = 16384, DM = 4096, SEQ = 2048, NBATCH = 8;
constexpr int A_COLS = 18432, B_COLS = 12320, B_COLS_PAD = 12544, FOXW = 12288;
constexpr float DN_ALPHA = 1.4142135623730951f;
constexpr float LN_EPS = 1e-5f;
constexpr float LOG2E = 1.4426950408889634f, LN2 = 0.6931471805599453f;
constexpr float QSCALE2 = 0.08838834764831845f * 1.4426950408889634f;

constexpr size_t MB = (size_t)1 << 20;
constexpr size_t WS_CTL = 0;
constexpr size_t WS_WIN = 1 * MB;
constexpr size_t WS_WOUT = WS_WIN + 144 * MB;
constexpr size_t WS_WQ = WS_WOUT + 32 * MB;
constexpr size_t WS_U = WS_WQ + 16 * MB;
constexpr size_t WS_V = WS_U + 128 * MB;
constexpr size_t WS_HF = WS_V + 128 * MB;
constexpr size_t WS_HB = WS_HF + 256 * MB;
constexpr size_t WS_QKV = WS_HB + 128 * MB;
constexpr size_t WS_OG = WS_QKV + 576 * MB;
constexpr size_t WS_LSE = WS_OG + 192 * MB;
constexpr size_t WS_FG = WS_LSE + 3 * MB;
constexpr size_t WS_C2 = WS_FG + 2 * MB;
constexpr size_t WS_SC = WS_C2 + 2 * MB;
constexpr size_t WS_END = WS_SC + 1 * MB;
constexpr size_t WS_A2 = WS_QKV;
constexpr size_t WS_QP = WS_QKV + 128 * MB;
constexpr size_t WS_PART = WS_QKV + 192 * MB;
constexpr size_t WS_POUT = WS_QKV + 448 * MB;
constexpr size_t WS_PIDX = WS_QKV + 704 * MB;
constexpr size_t WS_PGATE = WS_QKV + 712 * MB;
constexpr size_t WS_PW = WS_QKV + 720 * MB;
constexpr size_t WS_X8 = WS_POUT;
constexpr size_t WS_XS = WS_SC + 256 * 1024;
constexpr size_t WS_WS = WS_SC + 512 * 1024;
constexpr size_t WS_WQ8 = WS_END;
constexpr size_t WS_WIN8 = WS_END + 8 * MB;
constexpr size_t WS_WOUT8 = WS_END + 88 * MB;
constexpr size_t WS_SC2 = WS_END + 108 * MB;
constexpr size_t WS_END2 = WS_END + 110 * MB;
constexpr size_t WS_X8A = WS_HB;
constexpr size_t WS_X8B = WS_HB + 64 * MB;
constexpr size_t WS_A28 = WS_QKV;
constexpr size_t WS_OG8 = WS_QKV + 448 * MB;
static_assert(WS_PW + 8 * MB <= WS_OG + 192 * MB, "PEER scratch must fit in the q|k|v + OG regions");
constexpr int BAR_REGION_WORDS = 4096;
constexpr int MAX_LAUNCHES = 32;

constexpr int NTHREADS = 512;
constexpr int LDS_BYTES = 147456;
constexpr int LDS_BARW = LDS_BYTES - 16;

struct Ctx { LAS unsigned char* lds; int tid, lane, wave, G, bid; };

typedef float f32x2c __attribute__((ext_vector_type(2)));
__device__ __forceinline__ unsigned pk2(float lo, float hi) { const f32x2c v = {lo, hi}; const bf16x2 b = __builtin_convertvector(v, bf16x2); return __builtin_bit_cast(unsigned, b); }
__device__ __forceinline__ float bf_lo(unsigned w) { return __uint_as_float(w << 16); }
__device__ __forceinline__ float bf_hi(unsigned w) { return __uint_as_float(w & 0xffff0000u); }
template <int CTRL> __device__ __forceinline__ float dppf(float x) { return __builtin_bit_cast(float, __builtin_amdgcn_mov_dpp(__builtin_bit_cast(int, x), CTRL, 0xf, 0xf, true)); }
__device__ __forceinline__ float wave_sum(float x) {
    x += dppf<0xB1>(x); x += dppf<0x4E>(x); x += dppf<0x141>(x); x += dppf<0x128>(x);
    auto s = __builtin_amdgcn_permlane16_swap(__float_as_uint(x), __float_as_uint(x), false, false);
    x = __uint_as_float(s[0]) + __uint_as_float(s[1]);
    auto t = __builtin_amdgcn_permlane32_swap(__float_as_uint(x), __float_as_uint(x), false, false);
    return __uint_as_float(t[0]) + __uint_as_float(t[1]);
}
__device__ __forceinline__ float pair_max(float x) { auto t = __builtin_amdgcn_permlane32_swap(__float_as_uint(x), __float_as_uint(x), false, false); return fmaxf(__uint_as_float(t[0]), __uint_as_float(t[1])); }
__device__ __forceinline__ float pair_sum(float x) { auto t = __builtin_amdgcn_permlane32_swap(__float_as_uint(x), __float_as_uint(x), false, false); return __uint_as_float(t[0]) + __uint_as_float(t[1]); }
__device__ __forceinline__ int pair_maxi(int x) { auto t = __builtin_amdgcn_permlane32_swap((unsigned)x, (unsigned)x, false, false); const int a = (int)t[0], b = (int)t[1]; return a > b ? a : b; }
__device__ __forceinline__ bf16x8 pack8(float a0, float a1, float a2, float a3, float b0, float b1, float b2, float b3) {
    u32x4 w = {pk2(a0, a1), pk2(a2, a3), pk2(b0, b1), pk2(b2, b3)}; return __builtin_bit_cast(bf16x8, w);
}
__device__ __forceinline__ float dot2(unsigned a, unsigned b, float acc) { return __builtin_amdgcn_fdot2_f32_bf16(__builtin_bit_cast(bf16x2, a), __builtin_bit_cast(bf16x2, b), acc, false); }
#define MK_LDS_WAIT() asm volatile("s_waitcnt lgkmcnt(0)" ::: "memory")

__device__ __forceinline__ void transpose_weights(const Ctx& c, const float* __restrict__ W, int K, int N, bf16_t* __restrict__ WT) {
    LAS float* scr = (LAS float*)(c.lds + c.wave * 8704);
    const int lane = c.lane, nblk = N / 32, nitems = (K / 64) * nblk;
    for (int item = c.bid * 8 + c.wave; item < nitems; item += c.G * 8) {
        const int kb = item / nblk, nb = item - kb * nblk, k0 = 64 * kb, n0 = 32 * nb;
#pragma unroll 8
        for (int i = 0; i < 32; ++i) { const int kk = 2 * i + (lane >> 5); scr[kk * 33 + (lane & 31)] = W[(size_t)(k0 + kk) * N + n0 + (lane & 31)]; }
        MK_LDS_WAIT();
        const int cch = lane & 7;
#pragma unroll
        for (int j = 0; j < 4; ++j) { const int n = (lane >> 3) + 8 * j; const LAS float* s = scr + (8 * cch) * 33 + n;
            u32x4 o; o.x = pk2(s[0 * 33], s[1 * 33]); o.y = pk2(s[2 * 33], s[3 * 33]); o.z = pk2(s[4 * 33], s[5 * 33]); o.w = pk2(s[6 * 33], s[7 * 33]);
            *(u32x4*)(WT + (size_t)(n0 + n) * K + k0 + 8 * cch) = o; }
        MK_LDS_WAIT();
    }
}
__device__ __forceinline__ unsigned pack_i8x4(f32x4 a);
template <int KK>
__device__ __forceinline__ void transpose_quant(const Ctx& c, const float* __restrict__ W, int N, unsigned char* __restrict__ W8, float* __restrict__ sc, int rot) {
    constexpr int NT = KK / 512, NREG = NT < 6 ? NT : 6;
    LAS float* scr = (LAS float*)(c.lds + c.wave * 8704);
    LAS float* cmx = (LAS float*)(c.lds + 8 * 8704);
    static_assert(8 * 8704 + 1024 + 2 * 4 * 512 * 16 <= LDS_BARW, "transpose_quant LDS");
    const int nblk = N / 32;
#pragma unroll 1
    for (int nb = (c.bid - rot % c.G + c.G) % c.G; nb < nblk; nb += c.G) {
        int lane = mk_hw_lane();
        LAS u32x4* priv = (LAS u32x4*)(c.lds + 8 * 8704 + 1024) + (c.wave * 64 + lane);
        const int n0 = 32 * nb, cch = lane & 7;
        u32x4 keep[NREG][4]; float mx[4] = {0.f, 0.f, 0.f, 0.f};
        f32x4 ld[8];
#define MK_TQ_LOAD(t_) do { int k0_ = 64 * (c.wave + 8 * (t_)); asm volatile("" : "+s"(k0_)); const float* wp_ = W + (size_t)(k0_ + (lane >> 3)) * N + n0 + 4 * (lane & 7); \
            _Pragma("unroll") for (int i_ = 0; i_ < 8; ++i_) ld[i_] = *(const f32x4*)(wp_ + (size_t)(8 * i_) * N); } while (0)
        MK_TQ_LOAD(0);
#pragma unroll
        for (int t = 0; t < NT; ++t) { asm volatile("" : "+v"(lane));
#pragma unroll
            for (int i = 0; i < 8; ++i) { LAS float* d = scr + (8 * i + (lane >> 3)) * 33 + 4 * (lane & 7); d[0] = ld[i][0]; d[1] = ld[i][1]; d[2] = ld[i][2]; d[3] = ld[i][3]; }
            asm volatile("" ::: "memory");
            if (t + 1 < NT) MK_TQ_LOAD(t + 1);
            asm volatile("" ::: "memory");
            MK_LDS_WAIT();
#pragma unroll
            for (int j = 0; j < 4; ++j) { asm volatile("" ::: "memory");
                const int n = (lane >> 3) + 8 * j; const LAS float* s = scr + (8 * cch) * 33 + n;
                u32x4 o; o.x = pk2(s[0 * 33], s[1 * 33]); o.y = pk2(s[2 * 33], s[3 * 33]); o.z = pk2(s[4 * 33], s[5 * 33]); o.w = pk2(s[6 * 33], s[7 * 33]);
                if (t < NREG) keep[t < NREG ? t : 0][j] = o; else priv[((t - NREG) * 4 + j) * 512] = o;
#pragma unroll
                for (int e = 0; e < 4; ++e) mx[j] = fmaxf(mx[j], fmaxf(fabsf(bf_lo(o[e])), fabsf(bf_hi(o[e])))); }
            MK_LDS_WAIT();
        }
#undef MK_TQ_LOAD
#pragma unroll
        for (int j = 0; j < 4; ++j) { float m = mx[j]; m = fmaxf(m, dppf<0xB1>(m)); m = fmaxf(m, dppf<0x4E>(m)); m = fmaxf(m, dppf<0x141>(m));
            if (cch == 0) cmx[c.wave * 32 + (lane >> 3) + 8 * j] = m; }
        __syncthreads();
        float scale[4];
#pragma unroll
        for (int j = 0; j < 4; ++j) { const int n = (lane >> 3) + 8 * j; float m = cmx[n];
#pragma unroll
            for (int w = 1; w < 8; ++w) m = fmaxf(m, cmx[w * 32 + n]);
            const bool ok = (m > 1e-30f) && (m < 1e30f);
            scale[j] = ok ? 127.0f / m : 0.f;
            if (c.wave == 0 && cch == 0) sc[n0 + n] = ok ? m * (1.0f / 127.0f) : 0.f; }
#pragma unroll
        for (int t = 0; t < NT; ++t)
#pragma unroll
            for (int j = 0; j < 4; ++j) { u32x4 o; if (t < NREG) o = keep[t < NREG ? t : 0][j]; else o = priv[((t - NREG) * 4 + j) * 512]; asm volatile("" : "+v"(o));
                u32x2 w;
                w[0] = pack_i8x4((f32x4){bf_lo(o[0]), bf_hi(o[0]), bf_lo(o[1]), bf_hi(o[1])} * scale[j]);
                w[1] = pack_i8x4((f32x4){bf_lo(o[2]), bf_hi(o[2]), bf_lo(o[3]), bf_hi(o[3])} * scale[j]);
                *(u32x2*)(W8 + (size_t)(n0 + (lane >> 3) + 8 * j) * KK + 64 * (c.wave + 8 * t) + 8 * cch) = w; }
        __syncthreads();
    }
}
__device__ __forceinline__ int strips_for(int nblk, int rot, int G, int b) { const int r = (b - rot % G + G) % G; return nblk / G + (r < nblk % G ? 1 : 0); }
struct ConvDeal { int lo, hi, covered; };
__device__ __forceinline__ ConvDeal conv_deal(int G, int bid, int nb0, int w0, int nb1, int rot1, int w1, int nb2, int rot2, int w2, int total) {
    int cmax = 0, csum = 0, cpre = 0, mine = 0;
    int r1 = (G - rot1 % G) % G, r2 = (G - rot2 % G) % G;
    const int q0 = nb0 / G, m0 = nb0 % G, q1 = nb1 / G, m1 = nb1 % G, q2 = nb2 / G, m2 = nb2 % G;
    for (int b = 0; b < G; ++b) { const int cb = (q0 + (b < m0 ? 1 : 0)) * w0 + (q1 + (r1 < m1 ? 1 : 0)) * w1 + (q2 + (r2 < m2 ? 1 : 0)) * w2;
        cmax = cb > cmax ? cb : cmax; csum += cb; if (b < bid) cpre += cb; if (b == bid) mine = cb;
        r1 = (r1 + 1 == G) ? 0 : r1 + 1; r2 = (r2 + 1 == G) ? 0 : r2 + 1; }
    const int spare = total - (G * cmax - csum);
    ConvDeal d;
    if (spare < 0) { d.lo = 0; d.hi = 0; d.covered = 0; return d; }
    const int base = (spare / G) & ~7;
    d.lo = base * bid + (bid * cmax - cpre); d.hi = d.lo + base + (cmax - mine); d.covered = G * base + (G * cmax - csum);
    return d;
}
__device__ __forceinline__ void convert_flat(const Ctx& c, const float* __restrict__ src, bf16_t* __restrict__ dst, size_t n) {
    const size_t n8 = n / 8, stride = (size_t)c.G * NTHREADS;
    for (size_t i = (size_t)c.bid * NTHREADS + c.tid; i < n8; i += stride) {
        const f32x4 a = *(const f32x4*)(src + i * 8), b = *(const f32x4*)(src + i * 8 + 4);
        u32x4 o = {pk2(a[0], a[1]), pk2(a[2], a[3]), pk2(b[0], b[1]), pk2(b[2], b[3])};
        *(u32x4*)(dst + i * 8) = o;
    }
}
__device__ __forceinline__ void zero_flat16(const Ctx& c, void* dst, size_t bytes) {
    const size_t n = bytes / 16, stride = (size_t)c.G * NTHREADS; const u32x4 z = {0u, 0u, 0u, 0u};
    for (size_t i = (size_t)c.bid * NTHREADS + c.tid; i < n; i += stride) ((u32x4*)dst)[i] = z;
}

__device__ __forceinline__ float wave_max(float x) {
    x = fmaxf(x, dppf<0xB1>(x)); x = fmaxf(x, dppf<0x4E>(x)); x = fmaxf(x, dppf<0x141>(x)); x = fmaxf(x, dppf<0x128>(x));
    auto s = __builtin_amdgcn_permlane16_swap(__float_as_uint(x), __float_as_uint(x), false, false);
    x = fmaxf(__uint_as_float(s[0]), __uint_as_float(s[1]));
    auto t = __builtin_amdgcn_permlane32_swap(__float_as_uint(x), __float_as_uint(x), false, false);
    return fmaxf(__uint_as_float(t[0]), __uint_as_float(t[1]));
}
__device__ __forceinline__ void convert_rows_fp8(const Ctx& c, const float* __restrict__ src, unsigned char* __restrict__ dst, float* __restrict__ inv, int rows) {
    for (int row = c.bid * 8 + c.wave; row < rows; row += c.G * 8) {
        const float* rp = src + (size_t)row * DM + c.lane * 16;
        f32x4 v[16]; float mx = 0.f;
#pragma unroll
        for (int i = 0; i < 4; ++i)
#pragma unroll
            for (int q = 0; q < 4; ++q) { v[4 * i + q] = *(const f32x4*)(rp + i * 1024 + 4 * q);
                mx = fmaxf(mx, fmaxf(fmaxf(fabsf(v[4 * i + q][0]), fabsf(v[4 * i + q][1])), fmaxf(fabsf(v[4 * i + q][2]), fabsf(v[4 * i + q][3])))); }
        mx = wave_max(mx);
        const unsigned ex = (__float_as_uint(mx) >> 23) & 0xffu;
        const bool ok = (ex > 8u) && (ex < 250u);
        const float scale = ok ? __uint_as_float((261u - ex) << 23) : 1.0f, iscale = ok ? __uint_as_float((ex - 7u) << 23) : 1.0f;
        if (c.lane == 0) inv[row] = iscale;
        unsigned char* op = dst + ((size_t)(c.lane >> 3) * 16384 + row) * 128 + (c.lane & 7) * 16;
#pragma unroll
        for (int i = 0; i < 4; ++i) { u32x4 w;
#pragma unroll
            for (int q = 0; q < 4; ++q) { const f32x4 a = v[4 * i + q] * scale; int t = 0; t = __builtin_amdgcn_cvt_pk_fp8_f32(a[0], a[1], t, false); t = __builtin_amdgcn_cvt_pk_fp8_f32(a[2], a[3], t, true); w[q] = (unsigned)t; }
            *(u32x4*)(op + (size_t)i * 8 * 16384 * 128) = w; }
    }
}

__device__ __forceinline__ unsigned pack_i8x4(f32x4 a) {
    const int q0 = (int)__builtin_rintf(a[0]), q1 = (int)__builtin_rintf(a[1]), q2 = (int)__builtin_rintf(a[2]), q3 = (int)__builtin_rintf(a[3]);
    return ((unsigned)q0 & 0xffu) | (((unsigned)q1 & 0xffu) << 8) | (((unsigned)q2 & 0xffu) << 16) | ((unsigned)q3 << 24);
}
__device__ __forceinline__ void convert_rows_i8(const Ctx& c, const float* __restrict__ src, unsigned char* __restrict__ dst, float* __restrict__ inv, int row_begin, int row_end, int row_step) {
    for (int row = row_begin; row < row_end; row += row_step) {
        const float* rp = src + (size_t)row * DM + c.lane * 16;
        f32x4 v[16]; float mx = 0.f;
#pragma unroll
        for (int i = 0; i < 4; ++i)
#pragma unroll
            for (int q = 0; q < 4; ++q) { v[4 * i + q] = *(const f32x4*)(rp + i * 1024 + 4 * q);
                mx = fmaxf(mx, fmaxf(fmaxf(fabsf(v[4 * i + q][0]), fabsf(v[4 * i + q][1])), fmaxf(fabsf(v[4 * i + q][2]), fabsf(v[4 * i + q][3])))); }
        mx = wave_max(mx);
        const bool ok = (mx > 1e-30f) && (mx < 1e30f);
        const float scale = ok ? 127.0f / mx : 1.0f, iscale = ok ? mx * (1.0f / 127.0f) : 1.0f;
        if (c.lane == 0) inv[row] = iscale;
        unsigned char* op = dst + ((size_t)(c.lane >> 3) * 16384 + row) * 128 + (c.lane & 7) * 16;
#pragma unroll
        for (int i = 0; i < 4; ++i) { u32x4 w;
#pragma unroll
            for (int q = 0; q < 4; ++q) w[q] = pack_i8x4(v[4 * i + q] * scale);
            *(u32x4*)(op + (size_t)i * 8 * 16384 * 128) = w; }
    }
}

template <int KK>
__device__ __forceinline__ void quant_rows_bf16_i8(const Ctx& c, const bf16_t* __restrict__ src, unsigned char* __restrict__ dst, float* __restrict__ sc, int rows) {
    constexpr int NCH = KK / 512;
    for (int row = c.bid * 8 + c.wave; row < rows; row += c.G * 8) {
        int ln = c.lane; asm volatile("" : "+v"(ln));
        const bf16_t* rp = src + (size_t)row * KK + ln * 8;
        u32x4 v[NCH]; float mx = 0.f;
#pragma unroll
        for (int i = 0; i < NCH; ++i) { v[i] = *(const u32x4*)(rp + i * 512);
#pragma unroll
            for (int j = 0; j < 4; ++j) mx = fmaxf(mx, fmaxf(fabsf(bf_lo(v[i][j])), fabsf(bf_hi(v[i][j])))); }
        mx = wave_max(mx);
        const bool ok = (mx > 1e-30f) && (mx < 1e30f);
        const float scale = ok ? 127.0f / mx : 0.f;
        if (ln == 0) sc[row] = ok ? mx * (1.0f / 127.0f) : 0.f;
        unsigned char* op = dst + (size_t)row * KK + ln * 8;
#pragma unroll
        for (int i = 0; i < NCH; ++i) { u32x2 w;
            w[0] = pack_i8x4((f32x4){bf_lo(v[i][0]), bf_hi(v[i][0]), bf_lo(v[i][1]), bf_hi(v[i][1])} * scale);
            w[1] = pack_i8x4((f32x4){bf_lo(v[i][2]), bf_hi(v[i][2]), bf_lo(v[i][3]), bf_hi(v[i][3])} * scale);
            *(u32x2*)(op + i * 512) = w; }
    }
}

__device__ __forceinline__ void quant_rows_f32_i8(const Ctx& c, const float* __restrict__ src, unsigned char* __restrict__ dst, float* __restrict__ sc, int rows) {
    for (int row = c.bid * 8 + c.wave; row < rows; row += c.G * 8) {
        int ln = c.lane; asm volatile("" : "+v"(ln));
        const size_t off = (size_t)row * DM + 4 * ln;
        f32x4 v[16]; float mx = 0.f;
#pragma unroll
        for (int j = 0; j < 16; ++j) { v[j] = *(const f32x4*)(src + off + 256 * j); mx = fmaxf(mx, fmaxf(fmaxf(fabsf(v[j][0]), fabsf(v[j][1])), fmaxf(fabsf(v[j][2]), fabsf(v[j][3])))); }
        mx = wave_max(mx);
        const bool ok = (mx > 1e-30f) && (mx < 1e30f);
        const float scale = ok ? 127.0f / mx : 0.f;
        if (ln == 0) sc[row] = ok ? mx * (1.0f / 127.0f) : 0.f;
#pragma unroll
        for (int j = 0; j < 16; ++j) *(unsigned*)(dst + off + 256 * j) = pack_i8x4(v[j] * scale);
    }
}

__device__ __forceinline__ void ln_phase(const Ctx& c, const bf16_t* Hf, float* dst, bf16_t* Hb, const float* __restrict__ g, const float* __restrict__ b, unsigned char* X8 = nullptr, float* XS = nullptr) {
    for (int row = c.bid * 8 + c.wave; row < T; row += c.G * 8) {
        int ln = c.lane; asm volatile("" : "+v"(ln));
        const size_t off = (size_t)row * DM + 4 * ln;
        f32x4 v[16]; float s = 0.f;
#pragma unroll
        for (int j = 0; j < 16; ++j) { const u32x2 hw = *(const u32x2*)(Hf + off + 256 * j); v[j] = (f32x4){bf_lo(hw[0]), bf_hi(hw[0]), bf_lo(hw[1]), bf_hi(hw[1])}; s += (v[j][0] + v[j][1]) + (v[j][2] + v[j][3]); }
        const float mean = wave_sum(s) * (1.f / DM); float q = 0.f;
#pragma unroll
        for (int j = 0; j < 16; ++j) { v[j] = v[j] - mean; q += (v[j][0] * v[j][0] + v[j][1] * v[j][1]) + (v[j][2] * v[j][2] + v[j][3] * v[j][3]); }
        const float rstd = 1.0f / sqrtf(wave_sum(q) * (1.f / DM) + LN_EPS);
#pragma unroll
        for (int j = 0; j < 16; ++j) { if ((j & 3) == 0) asm volatile("" ::: "memory");
            const f32x4 gg = *(const f32x4*)(g + 4 * ln + 256 * j), bb = *(const f32x4*)(b + 4 * ln + 256 * j);
            const f32x4 o = v[j] * rstd * gg + bb; if (dst) *(f32x4*)(dst + off + 256 * j) = o; v[j] = o;
            if (Hb) { u32x2 w = {pk2(o[0], o[1]), pk2(o[2], o[3])}; *(u32x2*)(Hb + off + 256 * j) = w; } }
        if (X8) {
            float mx = 0.f;
#pragma unroll
            for (int j = 0; j < 16; ++j) mx = fmaxf(mx, fmaxf(fmaxf(fabsf(v[j][0]), fabsf(v[j][1])), fmaxf(fabsf(v[j][2]), fabsf(v[j][3]))));
            mx = wave_max(mx);
            const bool ok = (mx > 1e-30f) && (mx < 1e30f);
            const float scale = ok ? 127.0f / mx : 1.0f;
            if (ln == 0) XS[row] = ok ? mx * (1.0f / 127.0f) : 1.0f;
#pragma unroll
            for (int j = 0; j < 16; ++j) *(unsigned*)(X8 + off + 256 * j) = pack_i8x4(v[j] * scale);
        }
    }
}

__device__ __forceinline__ void merge_phase(const Ctx& c, const bf16_t* __restrict__ OG, const float* __restrict__ LSE, unsigned char* __restrict__ A28, float* __restrict__ SA2) {
    for (int tok = c.bid * 8 + c.wave; tok < T; tok += c.G * 8) {
        int ln = c.lane; asm volatile("" : "+v"(ln));
        float o[32]; float mx = 0.f;
#pragma unroll
        for (int j = 0; j < 4; ++j) { const int col = 8 * ln + 512 * j, head = col >> 7;
            const float l0 = LSE[(0 * (size_t)T + tok) * 16 + head], l1 = LSE[(1 * (size_t)T + tok) * 16 + head], l2 = LSE[(2 * (size_t)T + tok) * 16 + head];
            const float lm = fmaxf(l0, fmaxf(l1, l2));
            float e0 = __expf(l0 - lm), e1 = __expf(l1 - lm), e2 = __expf(l2 - lm); const float inv = 1.0f / (e0 + e1 + e2); e0 *= inv; e1 *= inv; e2 *= inv;
            const u32x4 a = *(const u32x4*)(OG + (0 * (size_t)T + tok) * 2048 + col), b = *(const u32x4*)(OG + (1 * (size_t)T + tok) * 2048 + col), d = *(const u32x4*)(OG + (2 * (size_t)T + tok) * 2048 + col);
#pragma unroll
            for (int w = 0; w < 4; ++w) { const float lo = e0 * bf_lo(a[w]) + e1 * bf_lo(b[w]) + e2 * bf_lo(d[w]), hi = e0 * bf_hi(a[w]) + e1 * bf_hi(b[w]) + e2 * bf_hi(d[w]);
                o[8 * j + 2 * w] = lo; o[8 * j + 2 * w + 1] = hi; mx = fmaxf(mx, fmaxf(fabsf(lo), fabsf(hi))); } }
        mx = wave_max(mx);
        const bool ok = (mx > 1e-30f) && (mx < 1e30f);
        const float scale = ok ? 127.0f / mx : 0.f;
        if (ln == 0) SA2[tok] = ok ? mx * (1.0f / 127.0f) : 0.f;
#pragma unroll
        for (int j = 0; j < 4; ++j) { u32x2 w;
            w[0] = pack_i8x4((f32x4){o[8 * j], o[8 * j + 1], o[8 * j + 2], o[8 * j + 3]} * scale); w[1] = pack_i8x4((f32x4){o[8 * j + 4], o[8 * j + 5], o[8 * j + 6], o[8 * j + 7]} * scale);
            *(u32x2*)(A28 + (size_t)tok * 2048 + 8 * ln + 512 * j) = w; }
    }
}

__device__ __forceinline__ void cumsum_phase(const Ctx& c, const float* __restrict__ FG, const float* __restrict__ fbias, float* __restrict__ C2, float* __restrict__ C2N) {
    LAS float* wtot = (LAS float*)c.lds;
    for (int seq = c.bid; seq < NBATCH * 32; seq += c.G) {
        const int b = seq >> 5, hd = seq & 31; const float bias = fbias[hd];
        float p[4]; float run = 0.f;
#pragma unroll
        for (int i = 0; i < 4; ++i) { const float z = FG[((size_t)b * SEQ + 4 * c.tid + i) * 32 + hd] + bias; const float lf = fminf(z, 0.f) - log1pf(__expf(-fabsf(z))); run += lf; p[i] = run; }
        float v = run;
#pragma unroll
        for (int o = 1; o < 64; o <<= 1) { const float nb = __shfl_up(v, o); if (c.lane >= o) v += nb; }
        if (c.lane == 63) wtot[c.wave] = v;
        __syncthreads();
        float woff = 0.f;
        for (int w = 0; w < c.wave; ++w) woff += wtot[w];
        const float excl = woff + v - run;
        f32x4 o = {(excl + p[0]) * LOG2E, (excl + p[1]) * LOG2E, (excl + p[2]) * LOG2E, (excl + p[3]) * LOG2E};
        *(f32x4*)(C2 + (size_t)seq * SEQ + 4 * c.tid) = o; *(f32x4*)(C2N + (size_t)seq * SEQ + 4 * c.tid) = -o;
        __syncthreads();
    }
}

constexpr float ATT_THR = 8.0f;
constexpr int KT_PITCH = 272, KT_BYTES = 64 * KT_PITCH;
constexpr int VT_PITCH = 144, VT_BYTES = 128 * VT_PITCH;
constexpr int ABUF_BYTES = KT_BYTES + VT_BYTES;
constexpr int AHALF_BYTES = 2 * ABUF_BYTES + 512;
static_assert(2 * AHALF_BYTES <= LDS_BARW, "attention LDS");

struct AttnHalf { const bf16_t* q; const bf16_t* k; const bf16_t* v; bf16_t* o; float* lse; const float* c2; const float* c2n; float sd2; };
struct AttnTile { size_t rstride, ostride, lstride; int q0, kt_lo, kt_hi; unsigned Wn; int desc; };

__device__ __forceinline__ void half_barrier(LAS unsigned* cnt, int& gen, int lane) {
    asm volatile("s_waitcnt lgkmcnt(0)" ::: "memory");
    if (lane == 0) __hip_atomic_fetch_add((unsigned*)cnt, 1u, __ATOMIC_RELAXED, __HIP_MEMORY_SCOPE_WORKGROUP);
    ++gen; const unsigned target = 4u * (unsigned)gen;
    for (unsigned spins = 0; spins < (1u << 22); ++spins) {
        const unsigned v = __hip_atomic_load((unsigned*)cnt, __ATOMIC_RELAXED, __HIP_MEMORY_SCOPE_WORKGROUP);
        if ((unsigned)__builtin_amdgcn_readfirstlane((int)v) >= target) break;
        __builtin_amdgcn_s_sleep(1);
    }
    asm volatile("s_waitcnt lgkmcnt(0)" ::: "memory");
}
constexpr int ATT_CNT_OFF = 2 * AHALF_BYTES;
static_assert(ATT_CNT_OFF + 128 <= LDS_BARW, "attention counters");
struct AttnPre { u32x4 q[8], k[4], v[4]; float ctv, rowterm; bool have; };
template <int MODE, int VAR = 0>
__device__ __forceinline__ void attn_tile(const Ctx& c, const AttnHalf& H, const AttnTile& A, int& gen, const AttnHalf& Hn, const AttnTile& An, AttnPre& P) {
    int lane = c.lane; asm volatile("" : "+v"(lane));
    const int hw = c.wave & 3, ht = (c.wave & 3) * 64 + lane, h = lane >> 5, cc = lane & 31;
    LAS unsigned char* base = c.lds + (c.wave >> 2) * AHALF_BYTES;
    LAS unsigned* hcnt = (LAS unsigned*)(c.lds + ATT_CNT_OFF + (c.wave >> 2) * 64);
    const int qlo = A.q0 + 32 * hw, qm = qlo + cc;
    bf16x8 qf[8];
    if (!P.have) { const bf16_t* qp = H.q + (size_t)qm * A.rstride + 8 * h;
#pragma unroll
      for (int ks = 0; ks < 8; ++ks) P.q[ks] = *(const u32x4*)(qp + 16 * ks);
      if (MODE) P.rowterm = H.c2[qm]; }
    f32x16 oacc[4];
#pragma unroll
    for (int d = 0; d < 4; ++d)
#pragma unroll
        for (int r = 0; r < 16; ++r) oacc[d][r] = 0.f;
    float m_run = 0.f, l_run = 0.f;

    u32x4 (&kst)[4] = P.k; u32x4 (&vst)[4] = P.v; float& ctv = P.ctv;
    const int s_key = ht >> 4, s_c16 = ht & 15;
    const int v_kq = ht & 15, v_do = ht >> 4;
    const int v_kqs = (v_kq & ~3) | ((v_kq & 1) << 1) | ((v_kq >> 1) & 1);
#define MK_ATT_LOAD(kt) do { const int k0_ = 64 * (kt); \
        _Pragma("unroll") for (int i_ = 0; i_ < 4; ++i_) kst[i_] = *(const u32x4*)(H.k + (size_t)(k0_ + s_key + 16 * i_) * A.rstride + s_c16 * 8); \
        _Pragma("unroll") for (int i_ = 0; i_ < 4; ++i_) vst[i_] = *(const u32x4*)(H.v + (size_t)(k0_ + 4 * v_kq + i_) * A.rstride + v_do * 8); \
        if (ht < 64) ctv = MODE ? H.c2n[k0_ + ht] : H.sd2 * (float)(k0_ + ht); } while (0)
#define MK_ATT_WRITE(b) do { LAS unsigned char* kb_ = base + (b) * ABUF_BYTES; LAS unsigned char* vb_ = kb_ + KT_BYTES; \
        _Pragma("unroll") for (int i_ = 0; i_ < 4; ++i_) *(LAS u32x4*)(kb_ + (s_key + 16 * i_) * KT_PITCH + s_c16 * 16) = kst[i_]; \
        _Pragma("unroll") for (int w_ = 0; w_ < 4; ++w_) { \
            u32x2 e_ = {(vst[0][w_] & 0xffffu) | (vst[1][w_] << 16), (vst[2][w_] & 0xffffu) | (vst[3][w_] << 16)}; \
            u32x2 o_ = {(vst[0][w_] >> 16) | (vst[1][w_] & 0xffff0000u), (vst[2][w_] >> 16) | (vst[3][w_] & 0xffff0000u)}; \
            *(LAS u32x2*)(vb_ + (v_do * 8 + 2 * w_) * VT_PITCH + v_kqs * 8) = e_; \
            *(LAS u32x2*)(vb_ + (v_do * 8 + 2 * w_ + 1) * VT_PITCH + v_kqs * 8) = o_; } \
        if (ht < 64) ((LAS float*)(base + 2 * ABUF_BYTES + (b) * 256))[ht] = ctv; } while (0)

#define MK_KT(t_) (A.desc ? (A.kt_hi - 1 - (t_)) : (A.kt_lo + (t_)))
    const int nt = A.kt_hi - A.kt_lo;
    if (!P.have) MK_ATT_LOAD(MK_KT(0));
    const float rowterm = MODE ? P.rowterm : -H.sd2 * (float)qm;
#pragma unroll
    for (int ks = 0; ks < 8; ++ks) { u32x4 o;
#pragma unroll
        for (int j = 0; j < 4; ++j) o[j] = pk2(bf_lo(P.q[ks][j]) * QSCALE2, bf_hi(P.q[ks][j]) * QSCALE2);
        qf[ks] = __builtin_bit_cast(bf16x8, o); }
    MK_ATT_WRITE(0);
    half_barrier(hcnt, gen, lane);
    for (int t = 0; t < nt; ++t) {
        const bool more = (t + 1 < nt);
        if (more && VAR != 2 && VAR != 3) MK_ATT_LOAD(MK_KT(t + 1));
#ifdef MK_TEST_WAIT
        if (MODE) asm volatile("s_waitcnt vmcnt(0)" ::: "memory");
#endif
        const int k0 = 64 * MK_KT(t), qhi = qlo + 31;
        const bool need = (VAR != 1) && (k0 <= qhi) && (MODE || (k0 + 63 + (int)A.Wn >= qlo));
        if (need) {
            const LAS unsigned char* kb = base + (t & 1) * ABUF_BYTES; const LAS unsigned char* vb = kb + KT_BYTES;
            const LAS float* ctp = (const LAS float*)(base + 2 * ABUF_BYTES + (t & 1) * 256) + 4 * h;
            f32x16 s0, s1;
            { const float rb = rowterm - m_run;
#pragma unroll
              for (int q4 = 0; q4 < 4; ++q4) { const f32x4 c0 = *(const LAS f32x4*)(ctp + 8 * q4), c1 = *(const LAS f32x4*)(ctp + 32 + 8 * q4);
#pragma unroll
                  for (int i = 0; i < 4; ++i) { s0[4 * q4 + i] = rb + c0[i]; s1[4 * q4 + i] = rb + c1[i]; } } }
            bf16x8 fr[8];
            const LAS unsigned char* ka = kb + cc * KT_PITCH + 16 * h;
            const LAS unsigned char* va = vb + cc * VT_PITCH + 16 * h;
#pragma unroll
            for (int ks = 0; ks < 4; ++ks) { fr[2 * ks] = *(const LAS bf16x8*)(ka + 32 * ks); fr[2 * ks + 1] = *(const LAS bf16x8*)(ka + 32 * KT_PITCH + 32 * ks); }
            __builtin_amdgcn_sched_barrier(0);
#pragma unroll
            for (int ks = 0; ks < 8; ++ks) {
                s0 = __builtin_amdgcn_mfma_f32_32x32x16_bf16(fr[2 * (ks & 3)], qf[ks], s0, 0, 0, 0);
                s1 = __builtin_amdgcn_mfma_f32_32x32x16_bf16(fr[2 * (ks & 3) + 1], qf[ks], s1, 0, 0, 0);
                __builtin_amdgcn_sched_barrier(0);
                if (ks < 4) { fr[2 * ks] = *(const LAS bf16x8*)(ka + 32 * (ks + 4)); fr[2 * ks + 1] = *(const LAS bf16x8*)(ka + 32 * KT_PITCH + 32 * (ks + 4)); }
                else {
#pragma unroll
                    for (int e = 0; e < 2; ++e) { const int f = 2 * (ks - 4) + e; fr[f] = *(const LAS bf16x8*)(va + (f >> 2) * 32 * VT_PITCH + (f & 3) * 32); } }
                __builtin_amdgcn_sched_barrier(0);
            }
            const bool full = (VAR == 3) || ((k0 + 63 <= qlo) && (MODE || (k0 + (int)A.Wn >= qhi)));
            if (!full) { const int dq = qm - k0 - 4 * h; const float NEG = -__builtin_inff();
#pragma unroll
                for (int r = 0; r < 16; ++r) { const int ko = (r & 3) + 8 * (r >> 2);
                    if ((unsigned)(dq - ko) > A.Wn) s0[r] = NEG;
                    if ((unsigned)(dq - ko - 32) > A.Wn) s1[r] = NEG; } }
            float mx = fmaxf(s0[0], s1[0]);
            if (VAR != 3) {
#pragma unroll
            for (int r = 1; r < 16; ++r) mx = fmaxf(mx, fmaxf(s0[r], s1[r]));
            mx = pair_max(mx); }
            if (VAR != 3 && !__all(mx <= ATT_THR)) {
                const float shift = (mx > ATT_THR) ? mx : 0.f, alpha = __builtin_amdgcn_exp2f(-shift);
                m_run += shift; l_run *= alpha;
#pragma unroll
                for (int r = 0; r < 16; ++r) { s0[r] -= shift; s1[r] -= shift; }
#pragma unroll
                for (int d = 0; d < 4; ++d)
#pragma unroll
                    for (int r = 0; r < 16; ++r) oacc[d][r] *= alpha;
            }
            float ps = 0.f;
#pragma unroll
            for (int r = 0; r < 16; ++r) { if (VAR != 3) { s0[r] = __builtin_amdgcn_exp2f(s0[r]); s1[r] = __builtin_amdgcn_exp2f(s1[r]); ps += s0[r] + s1[r]; } }
            if (VAR == 3) ps = s0[0];
            l_run += ps;
            bf16x8 pb[4];
            pb[0] = pack8(s0[0], s0[1], s0[2], s0[3], s0[4], s0[5], s0[6], s0[7]);
            pb[1] = pack8(s0[8], s0[9], s0[10], s0[11], s0[12], s0[13], s0[14], s0[15]);
            pb[2] = pack8(s1[0], s1[1], s1[2], s1[3], s1[4], s1[5], s1[6], s1[7]);
            pb[3] = pack8(s1[8], s1[9], s1[10], s1[11], s1[12], s1[13], s1[14], s1[15]);
            __builtin_amdgcn_sched_barrier(0);
#pragma unroll
            for (int d = 0; d < 4; ++d) {
#pragma unroll
                for (int kk = 0; kk < 4; ++kk) oacc[d] = __builtin_amdgcn_mfma_f32_32x32x16_bf16(fr[4 * (d & 1) + kk], pb[kk], oacc[d], 0, 0, 0);
                __builtin_amdgcn_sched_barrier(0);
                if (d < 2) {
#pragma unroll
                    for (int kk = 0; kk < 4; ++kk) fr[4 * d + kk] = *(const LAS bf16x8*)(va + (d + 2) * 32 * VT_PITCH + kk * 32); }
                __builtin_amdgcn_sched_barrier(0);
            }
        }
        if (more && VAR != 2 && VAR != 3) MK_ATT_WRITE((t + 1) & 1);
        half_barrier(hcnt, gen, lane);
    }
    { const int qmn = An.q0 + 32 * hw + cc;
      const bf16_t* qpn = Hn.q + (size_t)qmn * An.rstride + 8 * h;
#pragma unroll
      for (int ks = 0; ks < 8; ++ks) P.q[ks] = *(const u32x4*)(qpn + 16 * ks);
      if (MODE) P.rowterm = Hn.c2[qmn];
      const int k0_ = 64 * (An.desc ? (An.kt_hi - 1) : An.kt_lo);
#pragma unroll
      for (int i_ = 0; i_ < 4; ++i_) kst[i_] = *(const u32x4*)(Hn.k + (size_t)(k0_ + s_key + 16 * i_) * An.rstride + s_c16 * 8);
#pragma unroll
      for (int i_ = 0; i_ < 4; ++i_) vst[i_] = *(const u32x4*)(Hn.v + (size_t)(k0_ + 4 * v_kq + i_) * An.rstride + v_do * 8);
      if (ht < 64) ctv = MODE ? Hn.c2n[k0_ + ht] : Hn.sd2 * (float)(k0_ + ht);
      P.have = true; }
#undef MK_ATT_LOAD
#undef MK_KT
#undef MK_ATT_WRITE
    const float lt = pair_sum(l_run), inv = 1.0f / lt;
    bf16_t* op = H.o + (size_t)qm * A.ostride + 8 * h;
#pragma unroll
    for (int d = 0; d < 4; ++d)
#pragma unroll
        for (int rq = 0; rq < 4; rq += 2) {
            const unsigned a0 = pk2(oacc[d][4 * rq] * inv, oacc[d][4 * rq + 1] * inv), a1 = pk2(oacc[d][4 * rq + 2] * inv, oacc[d][4 * rq + 3] * inv);
            const unsigned b0 = pk2(oacc[d][4 * rq + 4] * inv, oacc[d][4 * rq + 5] * inv), b1 = pk2(oacc[d][4 * rq + 6] * inv, oacc[d][4 * rq + 7] * inv);
            auto r0 = __builtin_amdgcn_permlane32_swap(a0, b0, false, false); auto r1 = __builtin_amdgcn_permlane32_swap(a1, b1, false, false);
            u32x4 w = {r0[0], r1[0], r0[1], r1[1]};
            *(u32x4*)(op + 32 * d + 8 * rq) = w;
        }
    if (MODE == 0 && h == 0) H.lse[(size_t)qm * A.lstride] = (m_run + log2f(lt)) * LN2;
}

__device__ __forceinline__ void dil_item(int it, int hf, const bf16_t* QKV, bf16_t* OG, float* LSE, AttnHalf& H, AttnTile& A) {
    const int rq = (it + (it >> 8)) & 15, hp = (it >> 4) & 7, rest = it >> 7, g = rest % 3, b = rest / 3;
    const int dil = (g == 0) ? 1 : (g == 1 ? 4 : 16), ntile = 16 / dil, r = rq / ntile, qt = rq - r * ntile;
    const int head = 2 * hp + hf;
    const size_t row0 = (size_t)b * SEQ + r;
    const bf16_t* base = QKV + row0 * A_COLS + g * 6144 + head * 128;
    H.q = base; H.k = base + 2048; H.v = base + 4096;
    H.o = OG + ((size_t)g * T + row0) * 2048 + head * 128;
    H.lse = LSE + ((size_t)g * T + row0) * 16 + head;
    H.c2 = nullptr; H.c2n = nullptr;
    H.sd2 = exp2f(-0.5f * (float)(head + 1)) * (float)dil * LOG2E;
    A.rstride = (size_t)dil * A_COLS; A.ostride = (size_t)dil * 2048; A.lstride = (size_t)dil * 16;
    A.q0 = 128 * qt; A.kt_lo = qt ? (2 * qt - 2) : 0; A.kt_hi = 2 * qt + 2; A.Wn = 128u; A.desc = 0;
}
__device__ __forceinline__ void dil_attn_phase(const Ctx& c, const bf16_t* QKV, bf16_t* OG, float* LSE) {
    const int hf = c.wave >> 2; int gen = 0;
    if (c.tid < 32) ((LAS unsigned*)(c.lds + ATT_CNT_OFF))[c.tid] = 0u;
    __syncthreads();
    if (hf) { __builtin_amdgcn_s_sleep(24); }
    constexpr int NIT = NBATCH * 3 * 8 * 16;
    AttnPre P; P.have = false;
    AttnHalf H, Hn; AttnTile A, An;
    if (c.bid < NIT) dil_item(c.bid, hf, QKV, OG, LSE, H, A);
#pragma unroll 1
    for (int it = c.bid; it < NIT; it += c.G) {
        if (it + c.G < NIT) dil_item(it + c.G, hf, QKV, OG, LSE, Hn, An); else { Hn = H; An = A; }
        attn_tile<0>(c, H, A, gen, Hn, An, P);
        H = Hn; A = An;
    }
    __syncthreads();
}
__device__ __forceinline__ bool fox_item(const Ctx& c, int n, int hf, bool xmode, int xx, int xr, const bf16_t* QKV, const float* C2, const float* C2N, bf16_t* O, AttnHalf& H, AttnTile& A) {
    const int i = n >> 1; int it;
    if (xmode) { if (i >= 4) return false; it = ((xx * 4 + (xr >> 3)) + 32 * i) * 8 + (xr & 7); }
    else { it = c.bid + i * c.G; if (it >= NBATCH * 16 * 8) return false; }
    const int x0 = it & 7, hp = (it >> 3) & 15, b = it >> 7;
    const int x = (n & 1) ? 15 - x0 : x0;
    const int head = 2 * hp + hf;
    const size_t row0 = (size_t)b * SEQ;
    const bf16_t* base = QKV + row0 * FOXW + head * 128;
    H.q = base; H.k = base + 4096; H.v = base + 8192;
    H.o = O + row0 * 4096 + head * 128; H.lse = nullptr; H.c2 = C2 + ((size_t)b * 32 + head) * SEQ; H.c2n = C2N + ((size_t)b * 32 + head) * SEQ; H.sd2 = 0.f;
    A.rstride = FOXW; A.ostride = 4096; A.lstride = 0; A.Wn = 0x7fffffffu; A.kt_lo = 0;
    A.q0 = 128 * x; A.kt_hi = 2 * x + 2; A.desc = (n & 1);
    return true;
}
template <int VAR = 0>
__device__ __forceinline__ void fox_attn_phase(const Ctx& c, const bf16_t* QKV, const float* C2, const float* C2N, bf16_t* O, bool xmode, int xx, int xr) {
    const int hf = c.wave >> 2; int gen = 0;
    if (c.tid < 32) ((LAS unsigned*)(c.lds + ATT_CNT_OFF))[c.tid] = 0u;
    __syncthreads();
    if (hf) { __builtin_amdgcn_s_sleep(24); }
    AttnPre P; P.have = false;
    AttnHalf H, Hn; AttnTile A, An;
    bool ok = fox_item(c, 0, hf, xmode, xx, xr, QKV, C2, C2N, O, H, A);
#pragma unroll 1
    for (int n = 0; ok; ++n) {
        const bool okn = fox_item(c, n + 1, hf, xmode, xx, xr, QKV, C2, C2N, O, Hn, An);
        if (!okn) { Hn = H; An = A; }
        attn_tile<1, VAR>(c, H, A, gen, Hn, An, P);
        H = Hn; A = An; ok = okn;
    }
    __syncthreads();
}

template <bool F32BASE>
struct EpiRes {
    static constexpr bool PERM = true, AFTER_DRAIN = false;
    const void* base; bf16_t* C; int ldc; float alpha;
    __device__ __forceinline__ void operator()(const f32x4 (&acc)[2][2][4][2], const pg8::Unit& u, int wr, int wc, int fr, int fq) const {
        const int row0 = u.pm * 256 + wr * 64 + fr, col0 = u.pn * 256 + wc * 32 + 8 * fq;
#pragma unroll
        for (int ai = 0; ai < 2; ++ai)
#pragma unroll
            for (int m = 0; m < 4; ++m) { const size_t off = (size_t)(row0 + ai * 128 + m * 16) * ldc + col0;
#pragma unroll
                for (int bj = 0; bj < 2; ++bj) { f32x4 b0, b1;
                    if (F32BASE) { b0 = *(const f32x4*)((const float*)base + off + bj * 128); b1 = *(const f32x4*)((const float*)base + off + bj * 128 + 4); }
                    else { const u32x4 w = *(const u32x4*)((const bf16_t*)base + off + bj * 128); b0 = (f32x4){bf_lo(w[0]), bf_hi(w[0]), bf_lo(w[1]), bf_hi(w[1])}; b1 = (f32x4){bf_lo(w[2]), bf_hi(w[2]), bf_lo(w[3]), bf_hi(w[3])}; }
                    const f32x4 o0 = b0 * alpha + acc[ai][bj][m][0], o1 = b1 * alpha + acc[ai][bj][m][1];
                    u32x4 w = {pk2(o0[0], o0[1]), pk2(o0[2], o0[3]), pk2(o1[0], o1[1]), pk2(o1[2], o1[3])};
                    *(u32x4*)(C + off + bj * 128) = w; } }
    }
};
struct EpiFox {
    static constexpr bool PERM = true, AFTER_DRAIN = false;
    bf16_t* O; float* FG;
    __device__ __forceinline__ void operator()(const f32x4 (&acc)[2][2][4][2], const pg8::Unit& u, int wr, int wc, int fr, int fq) const {
        const int row0 = u.pm * 256 + wr * 64 + fr;
        if (u.pn < 48) {
            const int col0 = u.pn * 256 + wc * 32 + 8 * fq;
#pragma unroll
            for (int ai = 0; ai < 2; ++ai)
#pragma unroll
                for (int m = 0; m < 4; ++m) { bf16_t* rowp = O + (size_t)(row0 + ai * 128 + m * 16) * FOXW + col0;
#pragma unroll
                    for (int bj = 0; bj < 2; ++bj) { const f32x4 v0 = acc[ai][bj][m][0], v1 = acc[ai][bj][m][1];
                        u32x4 w = {pk2(v0[0], v0[1]), pk2(v0[2], v0[3]), pk2(v1[0], v1[1]), pk2(v1[2], v1[3])};
                        *(u32x4*)(rowp + bj * 128) = w; } }
        } else if (wc == 0) {
#pragma unroll
            for (int ai = 0; ai < 2; ++ai)
#pragma unroll
                for (int m = 0; m < 4; ++m) { float* rowp = FG + (size_t)(row0 + ai * 128 + m * 16) * 32 + 8 * fq;
                    *(f32x4*)(rowp) = acc[ai][0][m][0]; *(f32x4*)(rowp + 4) = acc[ai][0][m][1]; }
        }
    }
};

constexpr int SK_PITCH = 272, SK_BYTES = 2 * 128 * SK_PITCH;
constexpr int SEL_IDX_OFF = SK_BYTES, SEL_GATE_OFF = SEL_IDX_OFF + 32 * 128 * 4, WBUF_OFF = SEL_GATE_OFF + 32 * 128 * 4, PEER_LDS_END = WBUF_OFF + 8 * 128 * 4;
static_assert(PEER_LDS_END <= LDS_BARW, "peer LDS");
struct CandTab { int i[50], j[50]; };
__host__ __device__ constexpr CandTab make_cand() { CandTab t{}; int s = 0; for (int i = 0; i < 16; ++i) for (int j = 0; j < 16; ++j) if ((i + 1) * (j + 1) <= 16) { t.i[s] = i; t.j[s] = j; ++s; } return t; }
__device__ __forceinline__ int f2ord(float f) { const int b = __float_as_int(f); return b ^ ((b >> 31) & 0x7fffffff); }
__device__ __forceinline__ float ord2f(int o) { return __int_as_float(o ^ ((o >> 31) & 0x7fffffff)); }
__device__ __forceinline__ float gelu_exact(float v) { return 0.5f * v * (1.0f + erff(v * 0.70710678118654752f)); }

#define MK_CE(a, b) do { const int hi_ = (a) > (b) ? (a) : (b), lo_ = (a) > (b) ? (b) : (a); (a) = hi_; (b) = lo_; } while (0)
template <int BASE> __device__ __forceinline__ void sort16_desc(int (&v)[64]) {
#pragma unroll
    for (int k = 2; k <= 16; k <<= 1)
#pragma unroll
        for (int j = k >> 1; j > 0; j >>= 1)
#pragma unroll
            for (int i = 0; i < 16; ++i) { const int l = i ^ j; if (l > i) { if ((i & k) == 0) MK_CE(v[BASE + i], v[BASE + l]); else MK_CE(v[BASE + l], v[BASE + i]); } }
}
template <int A, int B> __device__ __forceinline__ void merge_top16(int (&v)[64]) {
#pragma unroll
    for (int i = 0; i < 16; ++i) v[A + i] = v[A + i] > v[B + 15 - i] ? v[A + i] : v[B + 15 - i];
#pragma unroll
    for (int j = 8; j > 0; j >>= 1)
#pragma unroll
        for (int i = 0; i < 16; ++i) { const int l = i ^ j; if (l > i) MK_CE(v[A + i], v[A + l]); }
}
__device__ __forceinline__ void top16_of_64(int (&v)[64]) {
    sort16_desc<0>(v); sort16_desc<16>(v); sort16_desc<32>(v); sort16_desc<48>(v);
    merge_top16<0, 16>(v); merge_top16<32, 48>(v); merge_top16<0, 32>(v);
}
constexpr int LTAB_OFF = WBUF_OFF + 8 * 128 * 4, PEER_LDS_END2 = LTAB_OFF + 8 * 32 * 32;
static_assert(PEER_LDS_END2 <= LDS_BARW, "peer LDS 2");

__device__ __forceinline__ void peer_select(const Ctx& c, const bf16_t* __restrict__ QP, int tok0, unsigned short* __restrict__ IDXg, float* __restrict__ GATEg) {
    int lane = c.lane; asm volatile("" : "+v"(lane));
    const int h = lane >> 5, cc = lane & 31, head = c.wave;
    const bf16_t* qrow = QP + (size_t)(tok0 + cc) * 2048 + head * 256 + 8 * h;
    int L[2][16];
#pragma unroll
    for (int p = 0; p < 2; ++p) {
        bf16x8 qf[8];
#pragma unroll
        for (int ks = 0; ks < 8; ++ks) qf[ks] = *(const bf16x8*)(qrow + p * 128 + 16 * ks);
        f32x16 acc[4];
#pragma unroll
        for (int kb = 0; kb < 4; ++kb)
#pragma unroll
            for (int r = 0; r < 16; ++r) acc[kb][r] = 0.f;
        const LAS unsigned char* ska = c.lds + p * (128 * SK_PITCH) + cc * SK_PITCH + 16 * h;
#pragma unroll
        for (int kb = 0; kb < 4; ++kb)
#pragma unroll
            for (int ks = 0; ks < 8; ++ks) { const bf16x8 a = *(const LAS bf16x8*)(ska + kb * 32 * SK_PITCH + 32 * ks); acc[kb] = __builtin_amdgcn_mfma_f32_32x32x16_bf16(a, qf[ks], acc[kb], 0, 0, 0); }
        int pk[64];
#pragma unroll
        for (int kb = 0; kb < 4; ++kb)
#pragma unroll
            for (int r = 0; r < 16; ++r) { const int n = 32 * kb + (r & 3) + 8 * (r >> 2); pk[16 * kb + r] = (f2ord(acc[kb][r]) & ~127) | (127 - n - 4 * h); }
        top16_of_64(pk);
        int lo16[16], up16[16];
#pragma unroll
        for (int i = 0; i < 16; ++i) { auto t = __builtin_amdgcn_permlane32_swap((unsigned)pk[i], (unsigned)pk[i], false, false); lo16[i] = (int)t[0]; up16[i] = (int)t[1]; }
#pragma unroll
        for (int i = 0; i < 16; ++i) L[p][i] = lo16[i] > up16[15 - i] ? lo16[i] : up16[15 - i];
#pragma unroll
        for (int j = 8; j > 0; j >>= 1)
#pragma unroll
            for (int i = 0; i < 16; ++i) { const int l = i ^ j; if (l > i) MK_CE(L[p][i], L[p][l]); }
    }
    LAS unsigned char* tab = c.lds + LTAB_OFF + (c.wave * 32 + cc) * 32;
    if (h == 0) {
        u32x4 w0, w1;
#pragma unroll
        for (int q4 = 0; q4 < 4; ++q4) {
            w0[q4] = (unsigned)(127 - (L[0][4 * q4] & 127)) | ((unsigned)(127 - (L[0][4 * q4 + 1] & 127)) << 8) | ((unsigned)(127 - (L[0][4 * q4 + 2] & 127)) << 16) | ((unsigned)(127 - (L[0][4 * q4 + 3] & 127)) << 24);
            w1[q4] = (unsigned)(127 - (L[1][4 * q4] & 127)) | ((unsigned)(127 - (L[1][4 * q4 + 1] & 127)) << 8) | ((unsigned)(127 - (L[1][4 * q4 + 2] & 127)) << 16) | ((unsigned)(127 - (L[1][4 * q4 + 3] & 127)) << 24); }
        *(LAS u32x4*)(tab) = w0; *(LAS u32x4*)(tab + 16) = w1;
    }
    constexpr CandTab CT = make_cand();
    int pk2v[64];
#pragma unroll
    for (int s = 0; s < 64; ++s) {
        if (s < 50) { const int i = CT.i[s], j = CT.j[s];
            const float sum = ord2f(L[0][i] & ~127) + ord2f(L[1][j] & ~127);
            pk2v[s] = (f2ord(sum) & ~255) | (255 - (16 * i + j)); }
        else pk2v[s] = (int)0x80000000;
    }
    top16_of_64(pk2v);
    MK_LDS_WAIT();
    float tops[16]; int eidx[16];
#pragma unroll
    for (int it = 0; it < 16; ++it) { const int code = 255 - (pk2v[it] & 255); tops[it] = ord2f(pk2v[it] & ~255);
        eidx[it] = (int)tab[code >> 4] * 128 + (int)tab[16 + (code & 15)]; }
    { const float t0 = tops[0]; float den = 0.f;
#pragma unroll
      for (int it = 0; it < 16; ++it) { tops[it] = __expf(tops[it] - t0); den += tops[it]; }
      const float rden = 1.0f / den;
#pragma unroll
      for (int it = 0; it < 16; ++it) tops[it] *= rden; }
    unsigned short* si = IDXg + (size_t)(tok0 + cc) * 128 + head * 16;
    float* sg = GATEg + (size_t)(tok0 + cc) * 128 + head * 16;
    if (h == 0) {
        u32x4 w0, w1;
#pragma unroll
        for (int q4 = 0; q4 < 4; ++q4) { w0[q4] = (unsigned)eidx[2 * q4] | ((unsigned)eidx[2 * q4 + 1] << 16); w1[q4] = (unsigned)eidx[8 + 2 * q4] | ((unsigned)eidx[8 + 2 * q4 + 1] << 16); }
        *(u32x4*)(si) = w0; *(u32x4*)(si + 8) = w1;
    } else {
#pragma unroll
        for (int q4 = 0; q4 < 4; ++q4) { f32x4 w = {tops[4 * q4], tops[4 * q4 + 1], tops[4 * q4 + 2], tops[4 * q4 + 3]}; *(f32x4*)(sg + 4 * q4) = w; }
    }
}

typedef float f32x2 __attribute__((ext_vector_type(2)));
constexpr int NSLICE = 32, TOKBLK = 512;
#define MK_P_LOAD_ROWS(R, tl, Tb) do { const u32x4 j0_ = *(const LAS u32x4*)(ilds + (tl) * 256), j1_ = *(const LAS u32x4*)(ilds + (tl) * 256 + 16); \
        _Pragma("unroll") for (int w_ = 0; w_ < 4; ++w_) { R[2 * w_] = *(const u32x4*)((Tb) + (size_t)(j0_[w_] & 0xffffu) * 128); R[2 * w_ + 1] = *(const u32x4*)((Tb) + (size_t)(j0_[w_] >> 16) * 128); \
                                                           R[8 + 2 * w_] = *(const u32x4*)((Tb) + (size_t)(j1_[w_] & 0xffffu) * 128); R[8 + 2 * w_ + 1] = *(const u32x4*)((Tb) + (size_t)(j1_[w_] >> 16) * 128); } } while (0)
#define MK_P_FILL_IDX() do { const u32x4* src_ = (const u32x4*)(IDX + (size_t)tok0 * 128) + lane; LAS u32x4* dl_ = (LAS u32x4*)(c.lds + c.wave * 16384) + lane; \
        u32x4 tmp_[16]; _Pragma("unroll") for (int i_ = 0; i_ < 16; ++i_) tmp_[i_] = src_[64 * i_]; \
        _Pragma("unroll") for (int i_ = 0; i_ < 16; ++i_) dl_[64 * i_] = tmp_[i_]; MK_LDS_WAIT(); } while (0)

__device__ __forceinline__ void peer_pass1_unit(const Ctx& c, int slice, int tok0, const unsigned char* __restrict__ Us, const unsigned short* __restrict__ IDX, const unsigned char* __restrict__ X8, unsigned* __restrict__ PART, bool fill) {
    int lane = c.lane; asm volatile("" : "+v"(lane));
    const int p = lane >> 3, q = lane & 7;
    const unsigned char* Tb = Us + (size_t)slice * 16384 * 128 + q * 16;
    const LAS unsigned char* ilds = c.lds + c.wave * 16384 + p * 32;
    const unsigned char* xp = X8 + (size_t)tok0 * DM + slice * 128 + 16 * q;
    unsigned* pp = PART + ((size_t)slice * T + tok0) * 64 + 8 * p + q;
    if (fill) MK_P_FILL_IDX();
    u32x4 XA[2], XB[2], RA[16], RB[16];
#define MK_P1_LOAD_X(X, t) do { X[0] = *(const u32x4*)(xp + (size_t)(t) * DM); X[1] = *(const u32x4*)(xp + (size_t)((t) + 1) * DM); } while (0)
#define MK_P1_COMPUTE(R, Xv, t) do { int r_[16]; \
        _Pragma("unroll") for (int i_ = 0; i_ < 16; ++i_) { int a_ = 0; \
            _Pragma("unroll") for (int w_ = 0; w_ < 4; ++w_) a_ = __builtin_amdgcn_sdot4((int)R[i_][w_], (int)Xv[w_], a_, false); \
            a_ += __builtin_amdgcn_mov_dpp(a_, 0xB1, 0xf, 0xf, true); a_ += __builtin_amdgcn_mov_dpp(a_, 0x4E, 0xf, 0xf, true); a_ += __builtin_amdgcn_mov_dpp(a_, 0x141, 0xf, 0xf, true); r_[i_] = a_; } \
        int v0_ = r_[0], v1_ = r_[1]; \
        _Pragma("unroll") for (int i_ = 1; i_ < 8; ++i_) { v0_ = (q == i_) ? r_[2 * i_] : v0_; v1_ = (q == i_) ? r_[2 * i_ + 1] : v1_; } \
        pp[(size_t)(t) * 64] = pk2((float)v0_, (float)v1_); } while (0)
    constexpr int NT = TOKBLK / 8;
    MK_P1_LOAD_X(XA, 0);
    MK_P_LOAD_ROWS(RA, 0, Tb);
#pragma unroll 1
    for (int t = 0; t < NT; t += 4) {
        MK_P1_LOAD_X(XB, t + 2);
        MK_P_LOAD_ROWS(RB, t + 1, Tb); MK_P1_COMPUTE(RA, XA[0], t);
        MK_P_LOAD_ROWS(RA, t + 2, Tb); MK_P1_COMPUTE(RB, XA[1], t + 1);
        if (t + 4 < NT) MK_P1_LOAD_X(XA, t + 4);
        MK_P_LOAD_ROWS(RB, t + 3, Tb); MK_P1_COMPUTE(RA, XB[0], t + 2);
        if (t + 4 < NT) MK_P_LOAD_ROWS(RA, t + 4, Tb);
        MK_P1_COMPUTE(RB, XB[1], t + 3);
    }
#undef MK_P1_LOAD_X
#undef MK_P1_COMPUTE
}
__device__ __forceinline__ void peer_pass2_unit(const Ctx& c, int slice, int tok0, const unsigned char* __restrict__ Vs, const unsigned short* __restrict__ IDX, const unsigned char* __restrict__ W8, const float* __restrict__ WS, unsigned* __restrict__ OUT, bool fill) {
    int lane = c.lane; asm volatile("" : "+v"(lane));
    const int p = lane >> 3, q = lane & 7;
    const unsigned char* Tb = Vs + (size_t)slice * 16384 * 128 + q * 16;
    const LAS unsigned char* ilds = c.lds + c.wave * 16384 + p * 32;
    const unsigned char* wp = W8 + (size_t)tok0 * 128 + 16 * p;
    const float* wsp = WS + tok0;
    unsigned* op = OUT + (size_t)tok0 * (DM / 2) + slice * 64 + 8 * q + p;
    const bool b3 = (lane & 8) != 0;
    if (fill) MK_P_FILL_IDX();
    u32x4 WA[2], WB[2], RA[16], RB[16]; float SA[2], SB[2];
#define MK_P2_LOAD_W(Wt, St, t) do { Wt[0] = *(const u32x4*)(wp + (size_t)(t) * 128); Wt[1] = *(const u32x4*)(wp + (size_t)((t) + 1) * 128); St[0] = wsp[(t)]; St[1] = wsp[(t) + 1]; } while (0)
#define MK_P2_COMPUTE(R, Wv, sc, t) do { int acc_[16]; \
        _Pragma("unroll") for (int m_ = 0; m_ < 16; ++m_) acc_[m_] = 0; \
        _Pragma("unroll") for (int g_ = 0; g_ < 4; ++g_) { const int wq_ = (int)Wv[g_];     \
            _Pragma("unroll") for (int w_ = 0; w_ < 4; ++w_) { const unsigned a_ = R[4 * g_][w_], b_ = R[4 * g_ + 1][w_], c_ = R[4 * g_ + 2][w_], d_ = R[4 * g_ + 3][w_]; \
                const unsigned p0_ = __builtin_amdgcn_perm(b_, a_, 0x05010400u), p1_ = __builtin_amdgcn_perm(b_, a_, 0x07030602u), p2_ = __builtin_amdgcn_perm(d_, c_, 0x05010400u), p3_ = __builtin_amdgcn_perm(d_, c_, 0x07030602u); \
                acc_[4 * w_ + 0] = __builtin_amdgcn_sdot4((int)__builtin_amdgcn_perm(p2_, p0_, 0x05040100u), wq_, acc_[4 * w_ + 0], false); \
                acc_[4 * w_ + 1] = __builtin_amdgcn_sdot4((int)__builtin_amdgcn_perm(p2_, p0_, 0x07060302u), wq_, acc_[4 * w_ + 1], false); \
                acc_[4 * w_ + 2] = __builtin_amdgcn_sdot4((int)__builtin_amdgcn_perm(p3_, p1_, 0x05040100u), wq_, acc_[4 * w_ + 2], false); \
                acc_[4 * w_ + 3] = __builtin_amdgcn_sdot4((int)__builtin_amdgcn_perm(p3_, p1_, 0x07060302u), wq_, acc_[4 * w_ + 3], false); } } \
          \
        int u_[8]; _Pragma("unroll") for (int i_ = 0; i_ < 8; ++i_) { auto s_ = __builtin_amdgcn_permlane32_swap((unsigned)acc_[i_], (unsigned)acc_[i_ + 8], false, false); u_[i_] = (int)s_[0] + (int)s_[1]; } \
        int t_[4]; _Pragma("unroll") for (int i_ = 0; i_ < 4; ++i_) { auto s_ = __builtin_amdgcn_permlane16_swap((unsigned)u_[i_], (unsigned)u_[i_ + 4], false, false); t_[i_] = (int)s_[0] + (int)s_[1]; } \
        const int k0_ = b3 ? t_[2] : t_[0], s0_ = b3 ? t_[0] : t_[2], k1_ = b3 ? t_[3] : t_[1], s1_ = b3 ? t_[1] : t_[3]; \
        const int rx_ = k0_ + __builtin_amdgcn_mov_dpp(s0_, 0x128, 0xf, 0xf, true), ry_ = k1_ + __builtin_amdgcn_mov_dpp(s1_, 0x128, 0xf, 0xf, true); \
        op[(size_t)(t) * (DM / 2)] = pk2((float)rx_ * (sc), (float)ry_ * (sc)); } while (0)
    constexpr int NT = TOKBLK / 8;
    MK_P2_LOAD_W(WA, SA, 0);
    MK_P_LOAD_ROWS(RA, 0, Tb);
#pragma unroll 1
    for (int t = 0; t < NT; t += 4) {
        MK_P2_LOAD_W(WB, SB, t + 2);
        MK_P_LOAD_ROWS(RB, t + 1, Tb); MK_P2_COMPUTE(RA, WA[0], SA[0], t);
        MK_P_LOAD_ROWS(RA, t + 2, Tb); MK_P2_COMPUTE(RB, WA[1], SA[1], t + 1);
        if (t + 4 < NT) MK_P2_LOAD_W(WA, SA, t + 4);
        MK_P_LOAD_ROWS(RB, t + 3, Tb); MK_P2_COMPUTE(RA, WB[0], SB[0], t + 2);
        if (t + 4 < NT) MK_P_LOAD_ROWS(RA, t + 4, Tb);
        MK_P2_COMPUTE(RB, WB[1], SB[1], t + 3);
    }
#undef MK_P2_LOAD_W
#undef MK_P2_COMPUTE
}
#undef MK_P_LOAD_ROWS
#undef MK_P_FILL_IDX

struct PeerDeal { bool xcd_mode; int x, r; };
__device__ __forceinline__ int deal_xcd(const PeerDeal& d) { return d.x; }
__device__ __forceinline__ int deal_rank(const PeerDeal& d) { return d.r; }
__device__ __forceinline__ PeerDeal peer_deal(const Ctx& c, unsigned* xc, unsigned myx, unsigned myrank, bool census_done) {
    bool ok = census_done && (c.G == 256);
#pragma unroll
    for (int j = 0; j < 16; ++j) { const unsigned n = __hip_atomic_load(xc + j, __ATOMIC_RELAXED, __HIP_MEMORY_SCOPE_AGENT); ok = ok && (n == ((j < 8) ? 32u : 0u)); }
    PeerDeal d; d.xcd_mode = ok && myx < 8u && myrank < 32u; d.x = (int)myx; d.r = (int)myrank; return d;
}
template <int PASS>
__device__ __forceinline__ void peer_pass_phase(const Ctx& c, const PeerDeal& d, const unsigned char* Ts, const unsigned short* IDX, const unsigned char* X8, const unsigned char* W8, const float* WS, void* DST) {
#pragma unroll 1
    for (int i = 0;; ++i) {
        int slice, blk;
        if (d.xcd_mode) { if (i >= 4) break; slice = d.x + 8 * i; blk = d.r; }
        else { const int u = c.bid + i * c.G; if (u >= NSLICE * (T / TOKBLK)) break; slice = u / (T / TOKBLK); blk = u % (T / TOKBLK); }
        const int tok0 = blk * TOKBLK + c.wave * (TOKBLK / 8);
        const bool fill = !(d.xcd_mode && i > 0);
        if (PASS == 1) peer_pass1_unit(c, slice, tok0, Ts, IDX, X8, (unsigned*)DST, fill); else peer_pass2_unit(c, slice, tok0, Ts, IDX, W8, WS, (unsigned*)DST, fill);
    }
}
__device__ __forceinline__ void peer_act_phase(const Ctx& c, const unsigned* __restrict__ PART, const unsigned short* __restrict__ IDX, const float* __restrict__ GATE, const float* __restrict__ SU, const float* __restrict__ SV, const float* __restrict__ XS, unsigned short* __restrict__ W8, float* __restrict__ WS) {
    const size_t n2 = (size_t)T * 64, stride = (size_t)c.G * NTHREADS;
    for (size_t id = (size_t)c.bid * NTHREADS + c.tid; id < n2; id += stride) {
        float s0 = 0.f, s1 = 0.f;
#pragma unroll 8
        for (int j = 0; j < NSLICE; ++j) { const unsigned w = PART[(size_t)j * n2 + id]; s0 += bf_lo(w); s1 += bf_hi(w); }
        const unsigned ee = *(const unsigned*)(IDX + 2 * id); const unsigned e0 = ee & 0xffffu, e1 = ee >> 16;
        const float g0 = GATE[2 * id], g1 = GATE[2 * id + 1];
        const size_t tok = id >> 6; const float xs = XS[tok];
        const float w0 = g0 * gelu_exact(s0 * SU[e0] * xs) * SV[e0], w1 = g1 * gelu_exact(s1 * SU[e1] * xs) * SV[e1];
        const float mx = wave_max(fmaxf(fabsf(w0), fabsf(w1)));
        const bool ok = (mx > 1e-30f) && (mx < 1e30f);
        const float scale = ok ? 127.0f / mx : 0.f;
        if (c.lane == 0) WS[tok] = ok ? mx * (1.0f / 127.0f) : 0.f;
        const int q0 = (int)__builtin_rintf(w0 * scale), q1 = (int)__builtin_rintf(w1 * scale);
        W8[id] = (unsigned short)(((unsigned)q0 & 0xffu) | (((unsigned)q1 & 0xffu) << 8));
    }
}
typedef int mk_i32x4 __attribute__((ext_vector_type(4)));
__device__ __forceinline__ void fox_gate_job(const Ctx& c, const unsigned char* __restrict__ X8, const float* __restrict__ XS, const unsigned char* __restrict__ WG8, const float* __restrict__ SBG, float* __restrict__ FG) {
    const int mt = c.wave & 3, nt = c.wave >> 2;
    for (int blk = c.bid; blk < T / 64; blk += c.G) {
        int lane = c.lane; asm volatile("" : "+v"(lane));
        const int tok0 = blk * 64 + mt * 16;
        const unsigned char* ap = X8 + (size_t)(tok0 + (lane & 15)) * DM + 16 * (lane >> 4);
        const unsigned char* bp = WG8 + (size_t)(nt * 16 + (lane & 15)) * DM + 16 * (lane >> 4);
        mk_i32x4 acc = {0, 0, 0, 0};
#pragma unroll 8
        for (int ks = 0; ks < DM / 64; ++ks) {
            const mk_i32x4 a = *(const mk_i32x4*)(ap + 64 * ks), b = *(const mk_i32x4*)(bp + 64 * ks);
            acc = __builtin_amdgcn_mfma_i32_16x16x64_i8(a, b, acc, 0, 0, 0);
        }
        const float sb = SBG[nt * 16 + (lane & 15)];
#pragma unroll
        for (int r = 0; r < 4; ++r) { const int tok = tok0 + 4 * (lane >> 4) + r; FG[(size_t)tok * 32 + nt * 16 + (lane & 15)] = (float)acc[r] * XS[tok] * sb; }
    }
}
__device__ __forceinline__ void ln_add_phase(const Ctx& c, const bf16_t* Y, const float* __restrict__ g1, const float* __restrict__ b1, const bf16_t* __restrict__ ADD, float* dst, bf16_t* Hb, const float* __restrict__ g, const float* __restrict__ b, unsigned char* X8 = nullptr, float* XS = nullptr) {
    for (int row = c.bid * 8 + c.wave; row < T; row += c.G * 8) {
        int ln = c.lane; asm volatile("" : "+v"(ln));
        const size_t off = (size_t)row * DM + 4 * ln;
        f32x4 v[16]; float s = 0.f;
#pragma unroll
        for (int j = 0; j < 16; ++j) { const u32x2 hw = *(const u32x2*)(Y + off + 256 * j); v[j] = (f32x4){bf_lo(hw[0]), bf_hi(hw[0]), bf_lo(hw[1]), bf_hi(hw[1])}; s += (v[j][0] + v[j][1]) + (v[j][2] + v[j][3]); }
        float mean = wave_sum(s) * (1.f / DM), qq = 0.f;
#pragma unroll
        for (int j = 0; j < 16; ++j) { v[j] = v[j] - mean; qq += (v[j][0] * v[j][0] + v[j][1] * v[j][1]) + (v[j][2] * v[j][2] + v[j][3] * v[j][3]); }
        float rstd = 1.0f / sqrtf(wave_sum(qq) * (1.f / DM) + LN_EPS);
        s = 0.f;
#pragma unroll
        for (int j = 0; j < 16; ++j) { if ((j & 1) == 0) asm volatile("" ::: "memory");
            const f32x4 gg = *(const f32x4*)(g1 + 4 * ln + 256 * j), bb = *(const f32x4*)(b1 + 4 * ln + 256 * j);
            const u32x2 aw = *(const u32x2*)(ADD + off + 256 * j); const f32x4 av = {bf_lo(aw[0]), bf_hi(aw[0]), bf_lo(aw[1]), bf_hi(aw[1])};
            v[j] = (v[j] * rstd * gg + bb) * DN_ALPHA + av; s += (v[j][0] + v[j][1]) + (v[j][2] + v[j][3]); }
        mean = wave_sum(s) * (1.f / DM); qq = 0.f;
#pragma unroll
        for (int j = 0; j < 16; ++j) { v[j] = v[j] - mean; qq += (v[j][0] * v[j][0] + v[j][1] * v[j][1]) + (v[j][2] * v[j][2] + v[j][3] * v[j][3]); }
        rstd = 1.0f / sqrtf(wave_sum(qq) * (1.f / DM) + LN_EPS);
#pragma unroll
        for (int j = 0; j < 16; ++j) { if ((j & 1) == 0) asm volatile("" ::: "memory");
            const f32x4 gg = *(const f32x4*)(g + 4 * ln + 256 * j), bb = *(const f32x4*)(b + 4 * ln + 256 * j);
            const f32x4 o = v[j] * rstd * gg + bb; if (dst) *(f32x4*)(dst + off + 256 * j) = o; v[j] = o;
            if (Hb) { u32x2 w = {pk2(o[0], o[1]), pk2(o[2], o[3])}; *(u32x2*)(Hb + off + 256 * j) = w; } }
        if (X8) {
            float mx = 0.f;
#pragma unroll
            for (int j = 0; j < 16; ++j) mx = fmaxf(mx, fmaxf(fmaxf(fabsf(v[j][0]), fabsf(v[j][1])), fmaxf(fabsf(v[j][2]), fabsf(v[j][3]))));
            mx = wave_max(mx);
            const bool ok = (mx > 1e-30f) && (mx < 1e30f);
            const float scale = ok ? 127.0f / mx : 0.f;
            if (ln == 0) XS[row] = ok ? mx * (1.0f / 127.0f) : 0.f;
#pragma unroll
            for (int j = 0; j < 16; ++j) *(unsigned*)(X8 + off + 256 * j) = pack_i8x4(v[j] * scale);
        }
    }
}

__device__ __forceinline__ void peer_select_phase(const Ctx& c, const bf16_t* QP, const float* __restrict__ subk, unsigned short* IDXg, float* GATEg) {
    for (int i = c.tid; i < 2 * 128 * 16; i += NTHREADS) { const int row = i >> 4, ch = i & 15;
        const f32x4 a = *(const f32x4*)(subk + row * 128 + ch * 8), bq = *(const f32x4*)(subk + row * 128 + ch * 8 + 4);
        u32x4 w = {pk2(a[0], a[1]), pk2(a[2], a[3]), pk2(bq[0], bq[1]), pk2(bq[2], bq[3])};
        *(LAS u32x4*)(c.lds + row * SK_PITCH + ch * 16) = w; }
    __syncthreads();
#pragma unroll 1
    for (int unit = c.bid; unit < T / 32; unit += c.G) peer_select(c, QP, unit * 32, IDXg, GATEg);
    __syncthreads();
}

constexpr int NPHASES = 27;
struct Args { const float* in[14]; float* out; unsigned char* ws; int ph_lo, ph_hi, li, pad; };

__global__ void __launch_bounds__(NTHREADS, 2) mk_fwd(Args args) {
    extern __shared__ __attribute__((aligned(16))) unsigned char lds_raw[];
    Ctx c; c.lds = (LAS unsigned char*)lds_raw; c.wave = __builtin_amdgcn_readfirstlane((int)(threadIdx.x >> 6)); c.G = gridDim.x; c.bid = blockIdx.x; c.lane = mk_hw_lane(); c.tid = c.wave * 64 + c.lane;
#define RELANE() do { c.lane = mk_hw_lane(); c.tid = c.wave * 64 + c.lane; } while (0)
    if (c.tid < 4) ((LAS unsigned*)(c.lds + LDS_BARW))[c.tid] = 0u;
    __syncthreads();
    unsigned char* ws = args.ws;
    XcdBarrier bar = xcd_barrier_post((unsigned*)(ws + WS_CTL) + (size_t)args.li * BAR_REGION_WORDS, (volatile LAS unsigned*)(c.lds + LDS_BARW), c.wave);
    const int lo = args.ph_lo, hi = args.ph_hi; const int rep_ = 1; (void)rep_;
#ifndef MK_ONLY
#define MK_ONLY -1
#endif
#define IN(k) ((MK_ONLY < 0 || MK_ONLY == (k)) && lo <= (k) && (k) < hi)
#define SEAM(k) do { if (IN((k) + 1) && !((MK_DUP == (k) || MK_DUP2 == (k)) && rep_ == 0)) xcd_barrier(bar); } while (0)
#ifndef MK_DUP
#define MK_DUP -1
#endif
#ifndef MK_DUPS
#define MK_DUPS -1
#endif
#ifndef MK_FOXVAR
#define MK_FOXVAR 0
#endif
#ifndef MK_DUP2
#define MK_DUP2 -1
#endif
#define REP(k) for (int rep_ = 0; rep_ < ((MK_DUP == (k) || MK_DUP2 == (k)) ? 2 : 1); ++rep_)
#define INP(k) ([&]() { int k_ = (k); asm volatile("" : "+s"(k_)); return args.in[k_]; }())
#define x INP(0)
#define a_w_in INP(1)
#define a_w_out INP(2)
#define b_w_in INP(3)
#define b_f_bias INP(4)
#define b_w_out INP(5)
#define peer_w_q INP(6)
#define peer_sk INP(7)
#define peer_u INP(8)
#define peer_v INP(9)
#define ln_mix_g INP(10)
#define ln_mix_b INP(11)
#define ln_ffn_g INP(12)
#define ln_ffn_b INP(13)
    bf16_t* W_IN = (bf16_t*)(ws + WS_WIN); bf16_t* W_OUT = (bf16_t*)(ws + WS_WOUT); bf16_t* W_Q = (bf16_t*)(ws + WS_WQ); unsigned char* UB = ws + WS_U; unsigned char* VB = ws + WS_V; float* SU = (float*)(ws + WS_SC); float* SV = SU + 16384;
    bf16_t* HF = (bf16_t*)(ws + WS_HF);     bf16_t* HB = (bf16_t*)(ws + WS_HB); bf16_t* QKV = (bf16_t*)(ws + WS_QKV); bf16_t* OG = (bf16_t*)(ws + WS_OG);
    float* LSE = (float*)(ws + WS_LSE); float* FG = (float*)(ws + WS_FG); float* C2 = (float*)(ws + WS_C2); bf16_t* A2 = (bf16_t*)(ws + WS_A2); bf16_t* QP = (bf16_t*)(ws + WS_QP);
    const size_t EU = (size_t)16384 * DM;

    unsigned* XC = (unsigned*)(ws + WS_CTL) + (MAX_LAUNCHES * BAR_REGION_WORDS) + (size_t)args.li * 64;
    const unsigned myx = xb_xcc_id(); unsigned myrank = 0;
    { unsigned r0 = 0; if (c.tid == 0) r0 = __hip_atomic_fetch_add(XC + myx, 1u, __ATOMIC_RELAXED, __HIP_MEMORY_SCOPE_AGENT); myrank = (unsigned)__builtin_amdgcn_readfirstlane((int)r0); }
    if (c.tid == 0) ((LAS unsigned*)(c.lds + LDS_BARW))[2] = myrank;
    __syncthreads();
    myrank = (unsigned)__builtin_amdgcn_readfirstlane((int)((LAS unsigned*)(c.lds + LDS_BARW))[2]);
    unsigned short* PIDX = (unsigned short*)(ws + WS_PIDX); float* PGATE = (float*)(ws + WS_PGATE); unsigned short* PW = (unsigned short*)(ws + WS_PW); float* WSC = (float*)(ws + WS_WS); unsigned char* WQ8 = ws + WS_WQ8; unsigned* PART = (unsigned*)(ws + WS_PART); bf16_t* POUT = (bf16_t*)(ws + WS_POUT); unsigned char* X8 = ws + WS_X8; float* XS = (float*)(ws + WS_XS);

    unsigned char* WIN8 = ws + WS_WIN8; unsigned char* WOUT8 = ws + WS_WOUT8; unsigned char* X8A = ws + WS_X8A; unsigned char* X8B = ws + WS_X8B; unsigned char* A28 = ws + WS_A28; unsigned char* OG8 = ws + WS_OG8;
    float* SBIN = (float*)(ws + WS_SC2); float* SBOUT = SBIN + 32768; float* SBQ = SBOUT + 8192; float* XSA = SBQ + 8192; float* XSB = XSA + 16384; float* SA2 = XSB + 16384; float* SOG = SA2 + 16384;

    if (IN(0)) { RELANE();
        const int r1 = (A_COLS / 32) % c.G, r2 = (A_COLS / 32 + DM / 32) % c.G;
        transpose_quant<4096>(c, a_w_in, A_COLS, WIN8, SBIN, 0); transpose_quant<2048>(c, a_w_out, DM, WOUT8, SBOUT, r1); transpose_quant<4096>(c, peer_w_q, 2048, WQ8, SBQ, r2);
        RELANE();
        const ConvDeal cd = conv_deal(c.G, c.bid, A_COLS / 32, 32, DM / 32, r1, 16, 2048 / 32, r2, 32, 16384);
        convert_rows_i8(c, peer_u, UB, SU, cd.lo + c.wave, cd.hi, 8); convert_rows_i8(c, peer_u, UB, SU, cd.covered + c.bid * 8 + c.wave, 16384, c.G * 8);
        convert_rows_i8(c, peer_v, VB, SV, c.bid * 8 + c.wave, 16384, c.G * 8); quant_rows_f32_i8(c, x, X8A, XSA, T);
        SEAM(0);
    }
    if (IN(2)) { RELANE();
        pg8::Gemm g{(const bf16_t*)X8A, (const bf16_t*)WIN8, T, A_COLS, DM / 2, c.wave, XSA, SBIN}; pg8::StaticOrder S; S.init(T, A_COLS, c.G, c.bid);
        pg8::EpiBf16<0> E{QKV, A_COLS, nullptr, 0, 0};
        pg8::gemm_phase<pg8::EpiBf16<0>, pg8::StaticOrder, false, true>(c.lds, g, S, E, nullptr);
        SEAM(2);
    }
    if (IN(3)) { RELANE(); dil_attn_phase(c, QKV, OG, LSE); SEAM(3); }
    if (IN(4)) { RELANE(); merge_phase(c, OG, LSE, A28, SA2); SEAM(4); }
    if (IN(5)) { RELANE();
        pg8::Gemm g{(const bf16_t*)A28, (const bf16_t*)WOUT8, T, DM, 2048 / 2, c.wave, SA2, SBOUT}; pg8::StaticOrder S; S.init(T, DM, c.G, c.bid);
        EpiRes<true> E{x, HF, DM, DN_ALPHA};
        pg8::gemm_phase<EpiRes<true>, pg8::StaticOrder, false, true>(c.lds, g, S, E, nullptr);
        SEAM(5);
    }
    if (IN(6)) { RELANE(); ln_phase(c, HF, nullptr, nullptr, ln_mix_g, ln_mix_b, X8, XS); SEAM(6);     }
    if (IN(7)) { RELANE();
        pg8::Gemm g{(const bf16_t*)X8, (const bf16_t*)WQ8, T, 2048, DM / 2, c.wave, XS, SBQ}; pg8::StaticOrder S; S.init(T, 2048, c.G, c.bid);
        pg8::EpiBf16<0> E{QP, 2048, nullptr, 0, 0};
        pg8::gemm_phase<pg8::EpiBf16<0>, pg8::StaticOrder, false, true>(c.lds, g, S, E, nullptr);
        SEAM(7);
    }
    if (IN(8)) { RELANE(); peer_select_phase(c, QP, peer_sk, PIDX, PGATE); SEAM(8); }
    if (IN(9)) { RELANE(); const PeerDeal d = peer_deal(c, XC, myx, myrank, IN(8)); peer_pass_phase<1>(c, d, UB, PIDX, X8, nullptr, nullptr, PART);
#if MK_DUPS == 9
        peer_pass_phase<1>(c, d, UB, PIDX, X8, nullptr, nullptr, PART);
#endif
        SEAM(9); }
    if (IN(10)) { RELANE(); peer_act_phase(c, PART, PIDX, PGATE, SU, SV, XS, PW, WSC); SEAM(10); }
    if (IN(11)) { RELANE(); const PeerDeal d = peer_deal(c, XC, myx, myrank, IN(10)); peer_pass_phase<2>(c, d, VB, PIDX, nullptr, (const unsigned char*)PW, WSC, POUT);
#if MK_DUPS == 11
        peer_pass_phase<2>(c, d, VB, PIDX, nullptr, (const unsigned char*)PW, WSC, POUT);
#endif
        SEAM(11); }
    if (IN(12)) { RELANE(); ln_add_phase(c, HF, ln_mix_g, ln_mix_b, POUT, nullptr, HF, ln_ffn_g, ln_ffn_b, X8B, XSB);   }
    if (IN(13)) { RELANE();
        const int r1 = (B_COLS / 32) % c.G, r2 = (B_COLS / 32 + DM / 32) % c.G;
        transpose_quant<4096>(c, b_w_in, B_COLS, WIN8, SBIN, 0); transpose_quant<4096>(c, b_w_out, DM, WOUT8, SBOUT, r1); transpose_quant<4096>(c, peer_w_q + (size_t)DM * 2048, 2048, WQ8, SBQ, r2);
        RELANE();
        zero_flat16(c, WIN8 + (size_t)B_COLS * DM, (size_t)(B_COLS_PAD - B_COLS) * DM);
        for (int i = c.bid * NTHREADS + c.tid; i < B_COLS_PAD - B_COLS; i += c.G * NTHREADS) SBIN[B_COLS + i] = 0.f;
        const ConvDeal cd = conv_deal(c.G, c.bid, B_COLS / 32, 32, DM / 32, r1, 32, 2048 / 32, r2, 32, 16384);
        convert_rows_i8(c, peer_u + EU, UB, SU, cd.lo + c.wave, cd.hi, 8); convert_rows_i8(c, peer_u + EU, UB, SU, cd.covered + c.bid * 8 + c.wave, 16384, c.G * 8);
        convert_rows_i8(c, peer_v + EU, VB, SV, c.bid * 8 + c.wave, 16384, c.G * 8);
        SEAM(13);
    }
    if (IN(15)) { RELANE();
        fox_gate_job(c, X8B, XSB, WIN8 + (size_t)FOXW * DM, SBIN + FOXW, FG); RELANE();
        pg8::Gemm g{(const bf16_t*)X8B, (const bf16_t*)WIN8, T, FOXW, DM / 2, c.wave, XSB, SBIN}; pg8::StaticOrder S; S.init(T, FOXW, c.G, c.bid);
        EpiFox E{QKV, FG};
        pg8::gemm_phase<EpiFox, pg8::StaticOrder, false, true>(c.lds, g, S, E, nullptr);
        SEAM(15);
    }
    if (IN(16)) { RELANE(); cumsum_phase(c, FG, b_f_bias, C2, LSE  ); SEAM(16); }
    if (IN(17)) { RELANE(); const PeerDeal d = peer_deal(c, XC, myx, myrank, IN(16));
#if MK_DUPS == 17
        fox_attn_phase<MK_FOXVAR>(c, QKV, C2, LSE, OG, d.xcd_mode, deal_xcd(d), deal_rank(d));
#endif
        fox_attn_phase<0>(c, QKV, C2, LSE, OG, d.xcd_mode, deal_xcd(d), deal_rank(d));
        SEAM(17); }
    if (IN(18)) { RELANE(); quant_rows_bf16_i8<4096>(c, OG, OG8, SOG, T); SEAM(18); }
    if (IN(19)) { RELANE();
        pg8::Gemm g{(const bf16_t*)OG8, (const bf16_t*)WOUT8, T, DM, DM / 2, c.wave, SOG, SBOUT}; pg8::StaticOrder S; S.init(T, DM, c.G, c.bid);
        EpiRes<false> E{HF, HF, DM, DN_ALPHA};
        pg8::gemm_phase<EpiRes<false>, pg8::StaticOrder, false, true>(c.lds, g, S, E, nullptr);
        SEAM(19);
    }
    if (IN(20)) { RELANE(); ln_phase(c, HF, nullptr, nullptr, ln_mix_g + DM, ln_mix_b + DM, X8, XS); SEAM(20); }
    if (IN(21)) { RELANE();
        pg8::Gemm g{(const bf16_t*)X8, (const bf16_t*)WQ8, T, 2048, DM / 2, c.wave, XS, SBQ}; pg8::StaticOrder S; S.init(T, 2048, c.G, c.bid);
        pg8::EpiBf16<0> E{QP, 2048, nullptr, 0, 0};
        pg8::gemm_phase<pg8::EpiBf16<0>, pg8::StaticOrder, false, true>(c.lds, g, S, E, nullptr);
        SEAM(21);
    }
    if (IN(22)) { RELANE(); peer_select_phase(c, QP, peer_sk + 2 * 128 * 128, PIDX, PGATE); SEAM(22); }
    if (IN(23)) { RELANE(); const PeerDeal d = peer_deal(c, XC, myx, myrank, IN(22)); peer_pass_phase<1>(c, d, UB, PIDX, X8, nullptr, nullptr, PART); SEAM(23); }
    if (IN(24)) { RELANE(); peer_act_phase(c, PART, PIDX, PGATE, SU, SV, XS, PW, WSC); SEAM(24); }
    if (IN(25)) { RELANE(); const PeerDeal d = peer_deal(c, XC, myx, myrank, IN(24)); peer_pass_phase<2>(c, d, VB, PIDX, nullptr, (const unsigned char*)PW, WSC, POUT); SEAM(25); }
    if (IN(26)) { RELANE(); ln_add_phase(c, HF, ln_mix_g + DM, ln_mix_b + DM, POUT, args.out, nullptr, ln_ffn_g + DM, ln_ffn_b + DM); }
#undef IN
#undef SEAM
#undef x
#undef a_w_in
#undef a_w_out
#undef b_w_in
#undef b_f_bias
#undef b_w_out
#undef peer_w_q
#undef peer_sk
#undef peer_u
#undef peer_v
#undef ln_mix_g
#undef ln_mix_b
#undef ln_ffn_g
#undef ln_ffn_b
#undef INP
}
}

extern "C" void kernel_launch(void* const* d_in, const int* in_sizes, int n_in, void* d_out, int out_size, void* d_ws, size_t ws_size, hipStream_t stream) {
    using namespace mk;
    static int grid = 0;
    if (grid == 0) {
        if (n_in != 14 || out_size != T * DM || ws_size < WS_END2) { fprintf(stderr, "kernel_launch: unexpected shapes (n_in %d out %d ws %zu need %zu); nothing launched\n", n_in, out_size, ws_size, (size_t)WS_END2); grid = -1; return; }
        int dev = 0, cus = 0, per_cu = 0;
        if (hipGetDevice(&dev) != hipSuccess || hipDeviceGetAttribute(&cus, hipDeviceAttributeMultiprocessorCount, dev) != hipSuccess) { grid = -1; return; }
        if (hipFuncSetAttribute((const void*)mk_fwd, hipFuncAttributeMaxDynamicSharedMemorySize, LDS_BYTES) != hipSuccess) { fprintf(stderr, "kernel_launch: hipFuncSetAttribute failed\n"); grid = -1; return; }
        if (hipOccupancyMaxActiveBlocksPerMultiprocessor(&per_cu, (const void*)mk_fwd, NTHREADS, LDS_BYTES) != hipSuccess || per_cu < 1) { fprintf(stderr, "kernel_launch: occupancy query says %d\n", per_cu); per_cu = 1; }
        (void)hipGetLastError();
        grid = cus;
    }
    if (grid < 0) return;
    if (hipMemsetAsync((char*)d_ws + WS_CTL, 0, (size_t)MAX_LAUNCHES * BAR_REGION_WORDS * 4 + MAX_LAUNCHES * 256, stream) != hipSuccess) return;
    Args a{};
    for (int i = 0; i < 14; ++i) a.in[i] = (const float*)d_in[i];
    a.out = (float*)d_out; a.ws = (unsigned char*)d_ws; a.pad = 0;
#if MK_N_LAUNCHES == 1
    a.ph_lo = 0; a.ph_hi = NPHASES; a.li = 0;
    hipLaunchKernelGGL(mk_fwd, dim3(grid), dim3(NTHREADS), LDS_BYTES, stream, a);
#else
    for (int p = 0; p < NPHASES; ++p) { a.ph_lo = p; a.ph_hi = p + 1; a.li = p; hipLaunchKernelGGL(mk_fwd, dim3(grid), dim3(NTHREADS), LDS_BYTES, stream, a); }
#endif
}
```
